# Optimizing an MI355X kernel written in HIP

```python
import math
import jax
import jax.numpy as jnp
from jax import lax
import numpy as np

D_MODEL = 1024
BATCH = 8
SEQ = 4096
DEPTH = 4

N_HEADS = 8
HEAD_DIM = 64
ATTN_WIDTH = N_HEADS * HEAD_DIM
CONV_WIDTH = 512
CONV_KERNEL = 31
MOBA_BLOCK = 256
MOBA_TOPK = 3
Q_CHUNK = 32
REL_BUCKETS = 32
REL_MAX_DIST = 128
D_FF = 3584
N_EXPERTS = 8
TOP_K = 2
PLE_DIM = 256
LN_EPS = 1e-5
DEEPNORM_ALPHA = (2 * DEPTH) ** 0.25
DEEPNORM_BETA = (8 * DEPTH) ** -0.25

kernel_name = 'hybrid_conv_moba_moe_deepnorm'


def layer_norm(x, g, b):
    xf = x.astype(jnp.float32)
    mu = jnp.mean(xf, axis=-1, keepdims=True)
    var = jnp.mean(jnp.square(xf - mu), axis=-1, keepdims=True)
    y = (xf - mu) * lax.rsqrt(var + LN_EPS) * g.astype(jnp.float32) + b.astype(jnp.float32)
    return y.astype(x.dtype)


def rel_bucket(dist):
    n = jnp.maximum(dist, 0)
    max_exact = REL_BUCKETS // 2
    nf = jnp.maximum(n, 1).astype(jnp.float32)
    large = max_exact + (jnp.log(nf / max_exact) / math.log(REL_MAX_DIST / max_exact)
                         * (REL_BUCKETS - max_exact)).astype(jnp.int32)
    large = jnp.minimum(large, REL_BUCKETS - 1)
    return jnp.where(n < max_exact, n, large)


def conv_branch(a, w_dw, b_dw, g, b, w_proj):
    h = a[..., :CONV_WIDTH] * jax.nn.sigmoid(a[..., CONV_WIDTH:])
    h = lax.conv_general_dilated(h, w_dw[:, None, :], window_strides=(1,),
                                 padding=[(CONV_KERNEL - 1, 0)],
                                 dimension_numbers=('NWC', 'WIO', 'NWC'),
                                 feature_group_count=CONV_WIDTH) + b_dw
    h = jax.nn.silu(layer_norm(h, g, b))
    return h @ w_proj


def moba_attention(q, k, v, rel_bias):
    bsz, nh, s, dh = q.shape
    nb = -(-s // MOBA_BLOCK)
    pad = ((0, 0), (0, 0), (0, nb * MOBA_BLOCK - s), (0, 0))
    k_blk = jnp.pad(k, pad).reshape(bsz, nh, nb, MOBA_BLOCK, dh)
    v_blk = jnp.pad(v, pad).reshape(bsz, nh, nb, MOBA_BLOCK, dh)
    k_mean = jnp.mean(k_blk.astype(jnp.float32), axis=3)
    k_sel = min(MOBA_TOPK, nb - 1)
    scale = HEAD_DIM ** -0.5
    bias_t = rel_bias.T
    b_i = jnp.arange(bsz)[:, None, None, None]
    h_i = jnp.arange(nh)[None, :, None, None]
    h_i5 = jnp.arange(nh)[None, :, None, None, None]
    blk_ar = jnp.arange(MOBA_BLOCK)

    def chunk(c):
        q0 = c * Q_CHUNK
        qc = lax.dynamic_slice_in_dim(q, q0, Q_CHUNK, axis=2)
        qpos = q0 + jnp.arange(Q_CHUNK)
        own = q0 // MOBA_BLOCK
        k_own = lax.dynamic_index_in_dim(k_blk, own, axis=2, keepdims=False)
        v_own = lax.dynamic_index_in_dim(v_blk, own, axis=2, keepdims=False)
        dist_own = qpos[:, None] - (own * MOBA_BLOCK + blk_ar)[None, :]
        logit_own = (jnp.einsum('bhqd,bhkd->bhqk', qc, k_own).astype(jnp.float32) * scale
                     + bias_t[:, rel_bucket(dist_own)].astype(jnp.float32))
        logit_own = jnp.where(dist_own >= 0, logit_own, -jnp.inf)
        if k_sel == 0:
            probs = jax.nn.softmax(logit_own, axis=-1)
            return jnp.einsum('bhqk,bhkd->bhqd', probs.astype(v.dtype), v_own)
        score = jnp.einsum('bhqd,bhnd->bhqn', qc.astype(jnp.float32), k_mean)
        score = jnp.where(jnp.arange(nb) < own, score, -jnp.inf)
        _, idx = lax.top_k(score, k_sel)
        valid = jnp.arange(k_sel) < own
        k_g = k_blk[b_i, h_i, idx]
        v_g = v_blk[b_i, h_i, idx]
        kpos_sel = idx[..., None] * MOBA_BLOCK + blk_ar
        dist_sel = qpos[:, None, None] - kpos_sel
        logit_sel = (jnp.einsum('bhqd,bhqnkd->bhqnk', qc, k_g).astype(jnp.float32) * scale
                     + bias_t[h_i5, rel_bucket(dist_sel)].astype(jnp.float32))
        logit_sel = jnp.where(valid[:, None], logit_sel, -jnp.inf)
        logits = jnp.concatenate(
            [logit_own, logit_sel.reshape(bsz, nh, Q_CHUNK, k_sel * MOBA_BLOCK)], axis=-1)
        probs = jax.nn.softmax(logits, axis=-1).astype(v.dtype)
        p_own = probs[..., :MOBA_BLOCK]
        p_sel = probs[..., MOBA_BLOCK:].reshape(bsz, nh, Q_CHUNK, k_sel, MOBA_BLOCK)
        return (jnp.einsum('bhqk,bhkd->bhqd', p_own, v_own)
                + jnp.einsum('bhqnk,bhqnkd->bhqd', p_sel, v_g))

    outs = lax.map(chunk, jnp.arange(s // Q_CHUNK))
    return jnp.transpose(outs, (1, 2, 0, 3, 4)).reshape(bsz, nh, s, dh)


def swiglu(x, wg, wu, wd):
    return (jax.nn.silu(x @ wg) * (x @ wu)) @ wd


def moe_swiglu(x, router_w, wg, wu, wd):
    logits = (x @ router_w).astype(jnp.float32)
    top_v, top_i = lax.top_k(logits, TOP_K)
    top_p = jax.nn.softmax(top_v, axis=-1)
    gates = jnp.sum(jax.nn.one_hot(top_i, N_EXPERTS, dtype=jnp.float32) * top_p[..., None], axis=-2)
    out = jnp.zeros_like(x)
    for e in range(N_EXPERTS):
        out = out + gates[..., e:e + 1].astype(x.dtype) * swiglu(x, wg[e], wu[e], wd[e])
    return out


def _normal(key, shape, scale):
    return jax.random.normal(key, shape, jnp.float32) * scale


def setup_inputs(seed: int = 0) -> dict:
    key = jax.random.key(seed)
    k = jax.random.split(key, 28)
    L = DEPTH
    LD = (DEPTH + 1) // 2
    LM = DEPTH // 2
    D = D_MODEL
    C = CONV_WIDTH
    A = ATTN_WIDTH
    F = D_FF
    E = N_EXPERTS
    s_d = D ** -0.5
    beta = DEEPNORM_BETA
    x = _normal(k[0], (BATCH, SEQ, D), 1.0)
    p = _normal(k[1], (DEPTH, BATCH, SEQ, PLE_DIM), 1.0)
    rel_bias = _normal(k[2], (REL_BUCKETS, N_HEADS), 0.5)
    w_in = jnp.concatenate([
        _normal(k[3], (L, D, 2 * C), s_d),
        _normal(k[4], (L, D, 2 * A), s_d),
        _normal(k[5], (L, D, A), s_d * beta),
        _normal(k[6], (L, D, 2 * D), s_d),
    ], axis=-1)
    conv_w = _normal(k[7], (L, CONV_KERNEL, C), CONV_KERNEL ** -0.5)
    conv_b = _normal(k[8], (L, C), 0.02)
    conv_ln_g = 1.0 + _normal(k[9], (L, C), 0.02)
    conv_ln_b = _normal(k[10], (L, C), 0.02)
    w_conv_proj = _normal(k[11], (L, C, D), beta * C ** -0.5)
    w_attn_proj = _normal(k[12], (L, A, D), beta * A ** -0.5)
    w_out = _normal(k[13], (L, D, D), beta * s_d)
    ln1_g = 1.0 + _normal(k[14], (L, D), 0.02)
    ln1_b = _normal(k[15], (L, D), 0.02)
    w_ple_gate = _normal(k[16], (L, D, D), s_d)
    w_ple_proj = _normal(k[17], (L, PLE_DIM, D), beta * PLE_DIM ** -0.5)
    ln2_g = 1.0 + _normal(k[18], (L, D), 0.02)
    ln2_b = _normal(k[19], (L, D), 0.02)
    ffn_w_gate = _normal(k[20], (LD, D, F), s_d)
    ffn_w_up = _normal(k[21], (LD, D, F), s_d)
    ffn_w_down = _normal(k[22], (LD, F, D), beta * F ** -0.5)
    router_w = _normal(k[23], (LM, D, E), s_d)
    exp_w_gate = _normal(k[24], (LM, E, D, F), s_d)
    exp_w_up = _normal(k[25], (LM, E, D, F), s_d)
    exp_w_down = _normal(k[26], (LM, E, F, D), beta * F ** -0.5)
    return {'x': x, 'p': p, 'rel_bias': rel_bias, 'w_in': w_in, 'conv_w': conv_w,
            'conv_b': conv_b, 'conv_ln_g': conv_ln_g, 'conv_ln_b': conv_ln_b,
            'w_conv_proj': w_conv_proj, 'w_attn_proj': w_attn_proj, 'w_out': w_out,
            'ln1_g': ln1_g, 'ln1_b': ln1_b, 'w_ple_gate': w_ple_gate, 'w_ple_proj': w_ple_proj,
            'ln2_g': ln2_g, 'ln2_b': ln2_b, 'ffn_w_gate': ffn_w_gate, 'ffn_w_up': ffn_w_up,
            'ffn_w_down': ffn_w_down, 'router_w': router_w, 'exp_w_gate': exp_w_gate,
            'exp_w_up': exp_w_up, 'exp_w_down': exp_w_down}


def reference(x, p, rel_bias, w_in, conv_w, conv_b, conv_ln_g, conv_ln_b, w_conv_proj,
              w_attn_proj, w_out, ln1_g, ln1_b, w_ple_gate, w_ple_proj, ln2_g, ln2_b,
              ffn_w_gate, ffn_w_up, ffn_w_down, router_w, exp_w_gate, exp_w_up, exp_w_down):
    bsz, s, _ = x.shape
    C = CONV_WIDTH
    A = ATTN_WIDTH
    splits = [2 * C, 2 * C + A, 2 * C + 2 * A, 2 * C + 3 * A, 2 * C + 3 * A + D_MODEL]

    def heads(t):
        return jnp.transpose(t.reshape(bsz, s, N_HEADS, HEAD_DIM), (0, 2, 1, 3))

    for i in range(DEPTH):
        u = x @ w_in[i]
        a_conv, q, kk, vv, g_conv, g_attn = jnp.split(u, splits, axis=-1)
        y_conv = conv_branch(a_conv, conv_w[i], conv_b[i], conv_ln_g[i], conv_ln_b[i],
                             w_conv_proj[i])
        o = moba_attention(heads(q), heads(kk), heads(vv), rel_bias)
        o = jnp.transpose(o, (0, 2, 1, 3)).reshape(bsz, s, A)
        y_attn = o @ w_attn_proj[i]
        mixed = jax.nn.sigmoid(g_conv) * y_conv + jax.nn.sigmoid(g_attn) * y_attn
        x = layer_norm(DEEPNORM_ALPHA * x + mixed @ w_out[i], ln1_g[i], ln1_b[i])
        if i % 2 == 0:
            f = swiglu(x, ffn_w_gate[i // 2], ffn_w_up[i // 2], ffn_w_down[i // 2])
        else:
            f = moe_swiglu(x, router_w[i // 2], exp_w_gate[i // 2], exp_w_up[i // 2],
                           exp_w_down[i // 2])
        ple = jax.nn.sigmoid(x @ w_ple_gate[i]) * (p[i] @ w_ple_proj[i])
        x = layer_norm(DEEPNORM_ALPHA * x + f + ple, ln2_g[i], ln2_b[i])
    return x
```

```cpp
#include <hip/hip_runtime.h>
#include <cstdio>
#include <cstdint>

#ifndef MK_SINGLE
#define MK_SINGLE 0
#endif
#ifndef DBG_CHECK
#define DBG_CHECK 0
#endif

#define LAS __attribute__((address_space(3)))
#define GAS __attribute__((address_space(1)))
typedef unsigned short bf16_t;
typedef short bf16x8 __attribute__((ext_vector_type(8)));
typedef short s16x4 __attribute__((ext_vector_type(4)));
typedef float f32x2 __attribute__((ext_vector_type(2)));
typedef float f32x4 __attribute__((ext_vector_type(4)));
typedef float f32x16 __attribute__((ext_vector_type(16)));
typedef unsigned u32x2 __attribute__((ext_vector_type(2)));
typedef unsigned u32x4 __attribute__((ext_vector_type(4)));
typedef __bf16 bf16x2_t __attribute__((ext_vector_type(2)));

constexpr int D = 1024, BATCH = 8, SEQ = 4096, M = BATCH * SEQ, DEPTH = 4;
constexpr int NH = 8, HD = 64, AW = 512, CW = 512, CKW = 31, MOBA = 256, NBLK = SEQ / MOBA;
constexpr int FF = 3584, NE = 8, PLED = 256, NIN = 4608;
constexpr float LN_EPS = 1e-5f;
constexpr float ALPHA = 1.6817928305074290f;
constexpr float LOG2E = 1.4426950408889634f;
constexpr float QSCALE = 0.125f * LOG2E;
constexpr int NWAVES = 8, NTHR = 512;
constexpr int MAXPANEL = 264;
constexpr int MAXROWS = MAXPANEL * 256;

constexpr size_t MiB = 1u << 20;
constexpr size_t WS_CTL = 0, CTL_ZERO_BYTES = 1 * MiB;
constexpr size_t SZ_WIN = (size_t)NIN * D * 2, SZ_WC = (size_t)D * CW * 2, SZ_WA = (size_t)D * AW * 2, SZ_WOUT = (size_t)D * D * 2, SZ_WPG = (size_t)D * D * 2, SZ_WPP = (size_t)D * PLED * 2;
constexpr size_t SZ_WGU = (size_t)2 * FF * D * 2, SZ_WD = (size_t)D * FF * 2;
constexpr size_t WS_WIN = 2 * MiB;
constexpr size_t WS_WC = WS_WIN + DEPTH * SZ_WIN;
constexpr size_t WS_WA = WS_WC + DEPTH * SZ_WC;
constexpr size_t WS_WOUT = WS_WA + DEPTH * SZ_WA;
constexpr size_t WS_WPG = WS_WOUT + DEPTH * SZ_WOUT;
constexpr size_t WS_WPP = WS_WPG + DEPTH * SZ_WPG;
constexpr size_t WS_WGU = WS_WPP + DEPTH * SZ_WPP;
constexpr size_t WS_WD = WS_WGU + 2 * SZ_WGU;
constexpr size_t WS_EWGU = WS_WD + 2 * SZ_WD;
constexpr size_t WS_EWD = WS_EWGU + NE * SZ_WGU;
constexpr size_t WS_XB = WS_EWD + NE * SZ_WD;
constexpr size_t WS_YB = WS_XB + (size_t)M * D * 2;
constexpr size_t WS_PB = WS_YB + (size_t)M * D * 4;
constexpr size_t WS_PLE = WS_PB + (size_t)M * PLED * 2;
constexpr size_t WS_KM = WS_PLE + (size_t)M * D * 2;
constexpr size_t WS_ROUTE = WS_KM + (size_t)128 * 512 * 4;
constexpr size_t WS_RTOK = WS_ROUTE + (size_t)M * 32;
constexpr size_t WS_RDST = WS_RTOK + (size_t)MAXROWS * 4;
constexpr size_t WS_RGATE = WS_RDST + (size_t)MAXROWS * 4;
constexpr size_t WS_U = ((WS_RGATE + (size_t)MAXROWS * 4 + 4095) / 4096) * 4096;
constexpr size_t WS_H0 = WS_U;
constexpr size_t WS_Q = WS_H0 + (size_t)M * 512 * 2;
constexpr size_t WS_K = WS_Q + (size_t)M * 512 * 2;
constexpr size_t WS_VT = WS_K + (size_t)M * 512 * 2;
constexpr size_t WS_SG = WS_VT + (size_t)M * 512 * 2;
constexpr size_t WS_HC = WS_SG + (size_t)M * 2048 * 2;
constexpr size_t WS_HA = WS_HC + (size_t)M * 512 * 2;
constexpr size_t WS_MIX = WS_HA + (size_t)M * 512 * 2;
constexpr size_t WS_U_END_TM = WS_MIX + (size_t)M * D * 2;
constexpr size_t WS_H = WS_U;
constexpr size_t WS_U_END_FF = WS_H + (size_t)MAXROWS * FF * 2;
constexpr size_t WS_END = WS_U_END_FF > WS_U_END_TM ? WS_U_END_FF : WS_U_END_TM;

constexpr int CW_BAR = 4096;
constexpr int CW_GCNT = 16384;
constexpr int CW_DBG = 32768;

constexpr int RING_BYTES = 131072;
constexpr int LDSCTL_OFF = RING_BYTES, MISC_OFF = LDSCTL_OFF + 320;
constexpr int LDS_BYTES = 147456;

#define RLX_AGENT __ATOMIC_RELAXED, __HIP_MEMORY_SCOPE_AGENT
#define LDS_WAIT() asm volatile("s_waitcnt lgkmcnt(0)" ::: "memory")
#define VM_WAIT() asm volatile("s_waitcnt vmcnt(0)" ::: "memory")

__device__ __forceinline__ unsigned cvtpk(float lo, float hi) { f32x2 v = {lo, hi}; bf16x2_t b = __builtin_convertvector(v, bf16x2_t); return __builtin_bit_cast(unsigned, b); }
__device__ __forceinline__ float bf_lo(unsigned w) { return __uint_as_float(w << 16); }
__device__ __forceinline__ float bf_hi(unsigned w) { return __uint_as_float(w & 0xffff0000u); }
__device__ __forceinline__ float sigmoidf_(float x) { return __builtin_amdgcn_rcpf(1.0f + __builtin_amdgcn_exp2f(-x * LOG2E)); }

__device__ __forceinline__ int phase_tid(int wv) {
    int w = wv, ln; asm volatile("v_mbcnt_lo_u32_b32 %1, -1, 0\n\tv_mbcnt_hi_u32_b32 %1, -1, %1" : "+s"(w), "=&v"(ln));
    return w * 64 + ln;
}
namespace pg8 {
constexpr int BM = 256, BK = 64, HALF = 128, HTB = HALF * BK * 2, STAGE_BYTES = 8 * HTB, NXCD = 8, WGM = 8;
__host__ __device__ __forceinline__ int lds_byte(int r, int c) { const int st = (r >> 4) * 2 + (c >> 5), rr = r & 15, cc = c & 31, ob = rr * 64 + cc * 2; return st * 1024 + (ob ^ (((ob >> 9) & 1) << 5)); }
__host__ __device__ __forceinline__ void stage_rc(int b, int& R, int& C) { const int st = b / 1024, sb = b % 1024, swz = sb ^ (((sb >> 9) & 1) << 5); R = (st >> 1) * 16 + swz / 64; C = (st & 1) * 32 + (swz % 64) / 2; }
__host__ __device__ __forceinline__ int perm32(int rho) { const int n = rho >> 4, i = rho & 15; return 8 * (i >> 2) + 4 * n + (i & 3); }

struct Unit { const char* a; const char* b; int pm, pn, ty; };

__device__ __forceinline__ bool static_order(int i, int G, int c, int nM, int nN, int& pm, int& pn) {
    const int nwg = nM * nN; const long L = (long)i * G + c; if (L >= nwg) return false;
    int wgid = (int)L; { const int q = nwg / NXCD, r = nwg % NXCD, xcd = wgid % NXCD, off = wgid / NXCD; wgid = (xcd < r ? xcd * (q + 1) : r * (q + 1) + (xcd - r) * q) + off; }
    const int nig = WGM * nN, gid = wgid / nig, fm = gid * WGM, gsz = (nM - fm) < WGM ? (nM - fm) : WGM;
    pm = fm + ((wgid % nig) % gsz); pn = (wgid % nig) / gsz; return true;
}

template <class Epi, class Sched, bool GATHER>
__device__ __forceinline__ void gemm_phase(LAS unsigned char* lds, const int wv, const int K, const Sched& S, const Epi& E, const int* gidx) {
    const int tid = phase_tid(wv),
              wid = __builtin_amdgcn_readfirstlane(tid >> 6), lane = tid & 63, wr = wid >> 2, wc = wid & 3, fr = lane & 15, fq = lane >> 4;
    const int nt = K / BK;
    const size_t kstep = (size_t)(BK * 2);
    const size_t hstep = (size_t)HALF * K * 2;
    unsigned vA0[2], vA1[2], voffB[2];
#pragma unroll
    for (int i = 0; i < 2; ++i) { int R, C; stage_rc(tid * 16 + i * 8192, R, C); const int Rb = Epi::PERM ? ((R & ~31) + perm32(R & 31)) : R;
        vA0[i] = (unsigned)(R * K + C) * 2u; vA1[i] = vA0[i] + (unsigned)hstep; voffB[i] = (unsigned)(Rb * K + C) * 2u; }
    const unsigned ldsw = (unsigned)wid * 1024u;
    const int aoff = lds_byte(wr * 64 + fr, fq * 8), boff = lds_byte(wc * 32 + fr, fq * 8);
#define PG8_SA(b, h) (((b) * 2 + (h)) * HTB)
#define PG8_SB(b, h) ((4 + (b) * 2 + (h)) * HTB)
#define PG8_STAGE(bufoff, gbase, voff) do { _Pragma("unroll") for (int _i = 0; _i < 2; ++_i) \
        __builtin_amdgcn_global_load_lds((const unsigned*)((const char*)(gbase) + (voff)[_i]), (LAS unsigned*)(lds + (bufoff) + ldsw + _i * 8192), 16, 0, 0); } while (0)
#define PG8_LDA(dst, b, h) do { _Pragma("unroll") for (int m = 0; m < 4; ++m) _Pragma("unroll") for (int k = 0; k < 2; ++k) dst[m][k] = *(const LAS bf16x8*)(lds + PG8_SA(b, h) + aoff + m * 2048 + k * 1024); } while (0)
#define PG8_LDB(dst, b, h) do { _Pragma("unroll") for (int n = 0; n < 2; ++n) _Pragma("unroll") for (int k = 0; k < 2; ++k) dst[n][k] = *(const LAS bf16x8*)(lds + PG8_SB(b, h) + boff + n * 2048 + k * 1024); } while (0)
#define PG8_MMA(ai, bj, At, Bt) do { __builtin_amdgcn_s_setprio(1); _Pragma("unroll") for (int m = 0; m < 4; ++m) _Pragma("unroll") for (int n = 0; n < 2; ++n) _Pragma("unroll") for (int k = 0; k < 2; ++k) \
        acc[ai][bj][m][n] = __builtin_amdgcn_mfma_f32_16x16x32_bf16(Bt[n][k], At[m][k], acc[ai][bj][m][n], 0, 0, 0); __builtin_amdgcn_s_setprio(0); } while (0)
#define PG8_WAIT_V(n) asm volatile("s_waitcnt vmcnt(" #n ")" ::: "memory")
#define PG8_WAIT_L(n) asm volatile("s_waitcnt lgkmcnt(" #n ")" ::: "memory")
#define PG8_BAR __builtin_amdgcn_s_barrier()
#define PG8_SCHED __builtin_amdgcn_sched_barrier(0)
    Unit cur, nxt; int ui = 0;
    if (!S.next(0, cur)) return;
#define PG8_GATHER(pm_, o0, o1) do { int t_ = tid; asm volatile("" : "+v"(t_)); _Pragma("unroll") for (int i = 0; i < 2; ++i) { int R, C; stage_rc(t_ * 16 + i * 8192, R, C); const int* gp_ = gidx + (pm_) * BM + R; \
        o0[i] = (unsigned)(gp_[0] * K + C) * 2u; o1[i] = (unsigned)(gp_[HALF] * K + C) * 2u; } } while (0)
    if constexpr (GATHER) PG8_GATHER(cur.pm, vA0, vA1);
    unsigned nA0[2] = {vA0[0], vA0[1]}, nA1[2] = {vA1[0], vA1[1]};
    f32x4 acc[2][2][4][2];
#pragma unroll
    for (int a = 0; a < 2; ++a)
#pragma unroll
        for (int b = 0; b < 2; ++b)
#pragma unroll
            for (int m = 0; m < 4; ++m)
#pragma unroll
                for (int n = 0; n < 2; ++n) acc[a][b][m][n] = (f32x4){0.f, 0.f, 0.f, 0.f};
    bf16x8 At[4][2], B0[2][2], B1[2][2];
    const char* cA = cur.a; const char* cB = cur.b;
    PG8_STAGE(PG8_SB(0, 0), cB, voffB); PG8_STAGE(PG8_SB(0, 1), cB + hstep, voffB); PG8_STAGE(PG8_SA(0, 0), cA, vA0); PG8_STAGE(PG8_SA(0, 1), cA, vA1);
    if (wr == 1) PG8_BAR;
    PG8_WAIT_V(2); PG8_BAR;
    PG8_STAGE(PG8_SB(1, 0), cB + kstep, voffB); PG8_STAGE(PG8_SA(1, 0), cA + kstep, vA0); PG8_STAGE(PG8_SB(1, 1), cB + hstep + kstep, voffB);
    PG8_WAIT_V(6); PG8_BAR;
    for (;;) {
        const bool has_next = S.next(ui + 1, nxt);
        const char* nA = has_next ? nxt.a : cA; const char* nB = has_next ? nxt.b : cB;
        if constexpr (GATHER) {
            if (has_next) PG8_GATHER(nxt.pm, nA0, nA1);
        }
        for (int t = 0; t < nt; t += 2) {
            const bool last = (t == nt - 2);
            const char* a1 = cA + (size_t)(t + 1) * kstep;
            const char* a2 = last ? nA : cA + (size_t)(t + 2) * kstep; const char* b2 = last ? nB : cB + (size_t)(t + 2) * kstep;
            const char* a3 = a2 + kstep; const char* b3 = b2 + kstep;
            unsigned w0[2], w1[2];
            if constexpr (GATHER) { w0[0] = last ? nA0[0] : vA0[0]; w0[1] = last ? nA0[1] : vA0[1]; w1[0] = last ? nA1[0] : vA1[0]; w1[1] = last ? nA1[1] : vA1[1]; }
            else { w0[0] = vA0[0]; w0[1] = vA0[1]; w1[0] = vA1[0]; w1[1] = vA1[1]; }
            PG8_LDB(B0, 0, 0); PG8_LDB(B1, 0, 1); PG8_SCHED; PG8_LDA(At, 0, 0); PG8_STAGE(PG8_SA(1, 1), a1, vA1);
            PG8_WAIT_V(8); PG8_WAIT_L(0); PG8_BAR; PG8_MMA(0, 0, At, B0); PG8_MMA(0, 1, At, B1); PG8_BAR; PG8_SCHED;
            PG8_LDA(At, 0, 1); PG8_STAGE(PG8_SB(0, 0), b2, voffB); PG8_STAGE(PG8_SB(0, 1), b2 + hstep, voffB); PG8_STAGE(PG8_SA(0, 0), a2, w0);
            PG8_WAIT_V(8); PG8_WAIT_L(0); PG8_BAR; PG8_MMA(1, 0, At, B0); PG8_MMA(1, 1, At, B1); PG8_BAR; PG8_SCHED;
            PG8_LDB(B0, 1, 0); PG8_LDB(B1, 1, 1); PG8_SCHED; PG8_LDA(At, 1, 0); PG8_STAGE(PG8_SA(0, 1), a2, w1);
            PG8_WAIT_V(8); PG8_WAIT_L(0); PG8_BAR; PG8_MMA(0, 0, At, B0); PG8_MMA(0, 1, At, B1); PG8_BAR; PG8_SCHED;
            PG8_LDA(At, 1, 1); PG8_STAGE(PG8_SB(1, 0), b3, voffB); PG8_STAGE(PG8_SB(1, 1), b3 + hstep, voffB); PG8_STAGE(PG8_SA(1, 0), a3, w0);
            PG8_WAIT_V(8); PG8_WAIT_L(0); PG8_BAR; PG8_MMA(1, 0, At, B0); PG8_MMA(1, 1, At, B1); PG8_BAR; PG8_SCHED;
        }
        if (wr == 0) PG8_BAR;
        E(acc, cur, wr, wc, fr, fq);
        if (!has_next) break;
#pragma unroll
        for (int a = 0; a < 2; ++a)
#pragma unroll
            for (int b = 0; b < 2; ++b)
#pragma unroll
                for (int m = 0; m < 4; ++m)
#pragma unroll
                    for (int n = 0; n < 2; ++n) acc[a][b][m][n] = (f32x4){0.f, 0.f, 0.f, 0.f};
        cur = nxt; cA = nA; cB = nB; ++ui;
        if constexpr (GATHER) { vA0[0] = nA0[0]; vA0[1] = nA0[1]; vA1[0] = nA1[0]; vA1[1] = nA1[1]; }
        if (wr == 1) PG8_BAR;
    }
    PG8_WAIT_V(0);
    PG8_BAR;
#undef PG8_GATHER
#undef PG8_SA
#undef PG8_SB
#undef PG8_STAGE
#undef PG8_LDA
#undef PG8_LDB
#undef PG8_MMA
#undef PG8_WAIT_V
#undef PG8_WAIT_L
#undef PG8_BAR
#undef PG8_SCHED
}
}

#define XB_TMO      128
#define XB_XCNT(j)  (256  + 64 * (j))
#define XB_XSUB(j)  (1280 + 64 * (j))
#define XB_XGEN(j)  (2304 + 64 * (j))
#define XB_TOP      3328
#define XB_TOPGEN   3392
#define XCD_BAR_WORDS 3456
#define XB_SPIN_CAP (1u << 22)
__device__ __forceinline__ unsigned xb_ld(unsigned* p)              { return __hip_atomic_load(p, __ATOMIC_RELAXED, __HIP_MEMORY_SCOPE_AGENT); }
__device__ __forceinline__ unsigned xb_add(unsigned* p, unsigned v) { return __hip_atomic_fetch_add(p, v, __ATOMIC_RELAXED, __HIP_MEMORY_SCOPE_AGENT); }
__device__ __forceinline__ unsigned xb_xcc_id() { return (unsigned)__builtin_amdgcn_s_getreg((3 << 11) | 20) & 0xFu; }
#define XB_SPIN(cond, bar) do { unsigned _sp = 0; while (cond) { __builtin_amdgcn_s_sleep(1); \
    if ((++_sp & 255u) == 0u) { if (xb_ld(&(bar)[XB_TMO])) break; if (_sp > XB_SPIN_CAP) { atomicAdd(&(bar)[XB_TMO], 1u); break; } } } } while (0)
struct XcdBarrier { unsigned* bar; unsigned x; volatile LAS unsigned* st; };
__device__ __forceinline__ XcdBarrier xcd_barrier_post(unsigned* bar, volatile LAS unsigned* st, int tid) {
    XcdBarrier b; b.bar = bar; b.x = xb_xcc_id(); b.st = st;
    if (tid == 0) (void)xb_add(&bar[XB_XCNT(b.x)], 1u);
    return b;
}
__device__ __forceinline__ void xcd_barrier_complete(unsigned* bar, unsigned x, unsigned& nloc, unsigned& nx) {
    const unsigned G = gridDim.x * gridDim.y * gridDim.z;
    unsigned sum, cnt, mine, sp = 0u;
    for (;;) {
        sum = 0u; cnt = 0u; mine = 0u;
#pragma unroll
        for (unsigned j = 0; j < 16; ++j) { const unsigned c = xb_ld(&bar[XB_XCNT(j)]); sum += c; cnt += (c > 0u) ? 1u : 0u; mine = (j == x) ? c : mine; }
        if (sum == G) break;
        __builtin_amdgcn_s_sleep(1);
        if ((++sp & 255u) == 0u) { if (xb_ld(&bar[XB_TMO])) break; if (sp > XB_SPIN_CAP) { atomicAdd(&bar[XB_TMO], 1u); break; } }
    }
    nloc = mine > 0u ? mine : 1u; nx = cnt > 0u ? cnt : 1u;
}
__device__ __forceinline__ void xcd_barrier(const XcdBarrier& b, int tid) {
    asm volatile("s_waitcnt vmcnt(0)" ::: "memory");
    __syncthreads();
    if (tid == 0) {
        unsigned* bar = b.bar;
        __builtin_amdgcn_s_waitcnt(0);
        unsigned nloc = b.st[0], nx = b.st[1];
        if (nloc == 0u) { xcd_barrier_complete(bar, b.x, nloc, nx); b.st[0] = nloc; b.st[1] = nx; }
        const unsigned old = xb_add(&bar[XB_XSUB(b.x)], 1u);
        const unsigned gen = old / nloc;
        if (old + 1u == (gen + 1u) * nloc) {
            __builtin_amdgcn_fence(__ATOMIC_RELEASE, "agent");
            asm volatile("s_waitcnt vmcnt(0)" ::: "memory");
            const unsigned og = xb_add(&bar[XB_TOP], 1u);
            const unsigned tg = og / nx;
            if (og + 1u == (tg + 1u) * nx) xb_add(&bar[XB_TOPGEN], 1u);
            else XB_SPIN(xb_ld(&bar[XB_TOPGEN]) == tg, bar);
            __builtin_amdgcn_fence(__ATOMIC_ACQUIRE, "agent");
            xb_add(&bar[XB_XGEN(b.x)], 1u);
            asm volatile("s_waitcnt vmcnt(0)" ::: "memory");
        } else {
            XB_SPIN(xb_ld(&bar[XB_XGEN(b.x)]) == gen, bar);
            __builtin_amdgcn_fence(__ATOMIC_ACQUIRE, "agent");
            asm volatile("s_waitcnt vmcnt(0)" ::: "memory");
        }
    }
    __syncthreads();
}

struct Frame {
    LAS unsigned char* lds;
    volatile LAS unsigned* MISC;
    unsigned* ctl;
    int tid, lane, wave, G, vcu, bx;
    unsigned char* ws;
    float* out;
};
#define INP(i) in_ptr<(i)>()
template <int I> __device__ __forceinline__ const float* in_ptr() {
    const float* p; auto ka = __builtin_amdgcn_kernarg_segment_ptr();
    asm volatile("s_load_dwordx2 %0, %1, %2\n\ts_waitcnt lgkmcnt(0)" : "=s"(p) : "s"(ka), "i"(I * 8) : "memory");
    return p;
}

__device__ __forceinline__ float wave_sum(float v) {
#pragma unroll
    for (int o = 1; o < 64; o <<= 1) v += __shfl_xor(v, o);
    return v;
}

using pg8::Unit;
struct EpiInProj {
    static constexpr bool PERM = true;
    bf16_t *H0, *Q, *Kb, *VT, *SG;
    __device__ __forceinline__ void operator()(const f32x4 (&acc)[2][2][4][2], const Unit& u, int wr, int wc, int fr, int fq) const {
        int r0 = wr * 64 + fr, c0 = wc * 32 + 8 * fq; asm volatile("" : "+v"(r0), "+v"(c0));
        if (u.ty == 0) {
#pragma unroll
            for (int ai = 0; ai < 2; ++ai)
#pragma unroll
                for (int m = 0; m < 4; ++m) { const size_t row = (size_t)u.pm * 256 + ai * 128 + m * 16 + r0;
                    f32x4 a0 = acc[ai][0][m][0], a1 = acc[ai][0][m][1], g0 = acc[ai][1][m][0], g1 = acc[ai][1][m][1];
                    u32x4 w; w.x = cvtpk(a0[0] * sigmoidf_(g0[0]), a0[1] * sigmoidf_(g0[1])); w.y = cvtpk(a0[2] * sigmoidf_(g0[2]), a0[3] * sigmoidf_(g0[3]));
                    w.z = cvtpk(a1[0] * sigmoidf_(g1[0]), a1[1] * sigmoidf_(g1[1])); w.w = cvtpk(a1[2] * sigmoidf_(g1[2]), a1[3] * sigmoidf_(g1[3]));
                    *(u32x4*)(H0 + row * 512 + u.pn * 128 + c0) = w; }
        } else if (u.ty == 3) {
            const int cpan = u.pn - 8;
#pragma unroll
            for (int ai = 0; ai < 2; ++ai)
#pragma unroll
                for (int m = 0; m < 4; ++m) { const size_t ch = (size_t)cpan * 256 + ai * 128 + m * 16 + r0;
#pragma unroll
                    for (int bj = 0; bj < 2; ++bj) { const f32x4 v0 = acc[ai][bj][m][0], v1 = acc[ai][bj][m][1];
                        u32x4 w; w.x = cvtpk(v0[0], v0[1]); w.y = cvtpk(v0[2], v0[3]); w.z = cvtpk(v1[0], v1[1]); w.w = cvtpk(v1[2], v1[3]);
                        *(u32x4*)(VT + ch * M + (size_t)u.pm * 256 + bj * 128 + c0) = w; } }
        } else if (u.ty == 4) {
            const int cb = (u.pn - 10) * 256;
#pragma unroll
            for (int ai = 0; ai < 2; ++ai)
#pragma unroll
                for (int m = 0; m < 4; ++m) { const size_t row = (size_t)u.pm * 256 + ai * 128 + m * 16 + r0;
#pragma unroll
                    for (int bj = 0; bj < 2; ++bj) { const f32x4 v0 = acc[ai][bj][m][0], v1 = acc[ai][bj][m][1];
                        u32x4 w; w.x = cvtpk(sigmoidf_(v0[0]), sigmoidf_(v0[1])); w.y = cvtpk(sigmoidf_(v0[2]), sigmoidf_(v0[3])); w.z = cvtpk(sigmoidf_(v1[0]), sigmoidf_(v1[1])); w.w = cvtpk(sigmoidf_(v1[2]), sigmoidf_(v1[3]));
                        *(u32x4*)(SG + row * 2048 + cb + bj * 128 + c0) = w; } }
        } else {
            bf16_t* base = (u.ty == 1) ? Q : Kb; const float sc = (u.ty == 1) ? QSCALE : 1.0f;
            const int cb = ((u.ty == 1) ? (u.pn - 4) : (u.pn - 6)) * 256;
#pragma unroll
            for (int ai = 0; ai < 2; ++ai)
#pragma unroll
                for (int m = 0; m < 4; ++m) { const size_t row = (size_t)u.pm * 256 + ai * 128 + m * 16 + r0;
#pragma unroll
                    for (int bj = 0; bj < 2; ++bj) { const f32x4 v0 = acc[ai][bj][m][0] * sc, v1 = acc[ai][bj][m][1] * sc;
                        u32x4 w; w.x = cvtpk(v0[0], v0[1]); w.y = cvtpk(v0[2], v0[3]); w.z = cvtpk(v1[0], v1[1]); w.w = cvtpk(v1[2], v1[3]);
                        *(u32x4*)(base + row * 512 + cb + bj * 128 + c0) = w; } }
        }
    }
};
template <int MODE> struct EpiBf16Row {
    static constexpr bool PERM = true;
    bf16_t* O; int ldo; const bf16_t* G; int ldg;
    __device__ __forceinline__ void operator()(const f32x4 (&acc)[2][2][4][2], const Unit& u, int wr, int wc, int fr, int fq) const {
        int r0 = wr * 64 + fr, c0 = u.pn * 256 + wc * 32 + 8 * fq; asm volatile("" : "+v"(r0), "+v"(c0));
#pragma unroll
        for (int ai = 0; ai < 2; ++ai)
#pragma unroll
            for (int m = 0; m < 4; ++m) { const size_t row = (size_t)u.pm * 256 + ai * 128 + m * 16 + r0;
#pragma unroll
                for (int bj = 0; bj < 2; ++bj) { f32x4 v0 = acc[ai][bj][m][0], v1 = acc[ai][bj][m][1];
                    bf16_t* op = O + row * ldo + c0 + bj * 128;
                    if (MODE == 0 || MODE == 1) { const u32x4 g = *(const u32x4*)(G + row * ldg + c0 + bj * 128);
                        v0[0] *= bf_lo(g.x); v0[1] *= bf_hi(g.x); v0[2] *= bf_lo(g.y); v0[3] *= bf_hi(g.y); v1[0] *= bf_lo(g.z); v1[1] *= bf_hi(g.z); v1[2] *= bf_lo(g.w); v1[3] *= bf_hi(g.w); }
                    if (MODE == 1) { const u32x4 o = *(const u32x4*)op;
                        v0[0] += bf_lo(o.x); v0[1] += bf_hi(o.x); v0[2] += bf_lo(o.y); v0[3] += bf_hi(o.y); v1[0] += bf_lo(o.z); v1[1] += bf_hi(o.z); v1[2] += bf_lo(o.w); v1[3] += bf_hi(o.w); }
                    if (MODE == 2) { for (int j = 0; j < 4; ++j) { v0[j] = sigmoidf_(v0[j]); v1[j] = sigmoidf_(v1[j]); } }
                    if (MODE == 3) { const u32x4 o = *(const u32x4*)op;
                        v0[0] *= bf_lo(o.x); v0[1] *= bf_hi(o.x); v0[2] *= bf_lo(o.y); v0[3] *= bf_hi(o.y); v1[0] *= bf_lo(o.z); v1[1] *= bf_hi(o.z); v1[2] *= bf_lo(o.w); v1[3] *= bf_hi(o.w); }
                    u32x4 w; w.x = cvtpk(v0[0], v0[1]); w.y = cvtpk(v0[2], v0[3]); w.z = cvtpk(v1[0], v1[1]); w.w = cvtpk(v1[2], v1[3]);
                    *(u32x4*)op = w; } }
    }
};
struct EpiSwiGLU {
    static constexpr bool PERM = true;
    bf16_t* H;
    __device__ __forceinline__ void operator()(const f32x4 (&acc)[2][2][4][2], const Unit& u, int wr, int wc, int fr, int fq) const {
        int r0 = wr * 64 + fr, c0 = u.pn * 128 + wc * 32 + 8 * fq; asm volatile("" : "+v"(r0), "+v"(c0));
#pragma unroll
        for (int ai = 0; ai < 2; ++ai)
#pragma unroll
            for (int m = 0; m < 4; ++m) { const size_t row = (size_t)u.pm * 256 + ai * 128 + m * 16 + r0;
                const f32x4 g0 = acc[ai][0][m][0], g1 = acc[ai][0][m][1], u0 = acc[ai][1][m][0], u1 = acc[ai][1][m][1];
                float h0[4], h1[4];
#pragma unroll
                for (int j = 0; j < 4; ++j) { h0[j] = g0[j] * sigmoidf_(g0[j]) * u0[j]; h1[j] = g1[j] * sigmoidf_(g1[j]) * u1[j]; }
                u32x4 w; w.x = cvtpk(h0[0], h0[1]); w.y = cvtpk(h0[2], h0[3]); w.z = cvtpk(h1[0], h1[1]); w.w = cvtpk(h1[2], h1[3]);
                *(u32x4*)(H + row * FF + c0) = w; }
    }
};
template <int MODE> struct EpiResF32 {
    static constexpr bool PERM = false;
    const float* X; float* Y; const bf16_t* P;
    __device__ __forceinline__ void operator()(const f32x4 (&acc)[2][2][4][2], const Unit& u, int wr, int wc, int fr, int fq) const {
        int r0 = wr * 64 + fr, c0 = u.pn * 256 + wc * 32 + 4 * fq; asm volatile("" : "+v"(r0), "+v"(c0));
#pragma unroll
        for (int ai = 0; ai < 2; ++ai)
#pragma unroll
            for (int m = 0; m < 4; ++m) { const size_t off = ((size_t)u.pm * 256 + ai * 128 + m * 16 + r0) * D + c0;
#pragma unroll
                for (int bj = 0; bj < 2; ++bj)
#pragma unroll
                    for (int n = 0; n < 2; ++n) { const size_t o = off + bj * 128 + n * 16;
                        f32x4 v = acc[ai][bj][m][n] + (*(const f32x4*)(X + o)) * ALPHA;
                        if (MODE == 1) { const u32x2 p = *(const u32x2*)(P + o); v[0] += bf_lo(p.x); v[1] += bf_hi(p.x); v[2] += bf_lo(p.y); v[3] += bf_hi(p.y); }
                        *(f32x4*)(Y + o) = v; } }
    }
};
struct EpiMoeDown {
    static constexpr bool PERM = true;
    bf16_t* Ys; const int* rdst; const float* rgate;
    __device__ __forceinline__ void operator()(const f32x4 (&acc)[2][2][4][2], const Unit& u, int wr, int wc, int fr, int fq) const {
        int r0 = wr * 64 + fr, c0 = u.pn * 256 + wc * 32 + 8 * fq; asm volatile("" : "+v"(r0), "+v"(c0));
#pragma unroll
        for (int ai = 0; ai < 2; ++ai)
#pragma unroll
            for (int m = 0; m < 4; ++m) { const int prow = u.pm * 256 + ai * 128 + m * 16 + r0; const int dst = rdst[prow]; const float gt = rgate[prow];
                if (dst >= 0) {
#pragma unroll
                    for (int bj = 0; bj < 2; ++bj) { const f32x4 v0 = acc[ai][bj][m][0] * gt, v1 = acc[ai][bj][m][1] * gt;
                        u32x4 w; w.x = cvtpk(v0[0], v0[1]); w.y = cvtpk(v0[2], v0[3]); w.z = cvtpk(v1[0], v1[1]); w.w = cvtpk(v1[2], v1[3]);
                        *(u32x4*)(Ys + (size_t)dst * D + c0 + bj * 128) = w; } } }
    }
};

struct SchedGrid {
    const char* A; const char* B; int nM, nN, G, c; size_t tstep;
    __device__ __forceinline__ bool next(int i, Unit& u) const { int pm, pn; if (!pg8::static_order(i, G, c, nM, nN, pm, pn)) return false; u.pm = pm; u.pn = pn; u.ty = 0; u.a = A + (size_t)pm * tstep; u.b = B + (size_t)pn * tstep; return true; }
};
struct SchedInProj {
    const char* X; const char* W; int G, c; size_t tstep;
    __device__ __forceinline__ bool next(int i, Unit& u) const { int pm, pn; if (!pg8::static_order(i, G, c, M / 256, 18, pm, pn)) return false; u.pm = pm; u.pn = pn;
        u.ty = pn < 4 ? 0 : pn < 6 ? 1 : pn < 8 ? 2 : pn < 10 ? 3 : 4;
        const char* xp = X + (size_t)pm * tstep; const char* wp = W + (size_t)pn * tstep;
        if (u.ty == 3) { u.a = wp; u.b = xp; } else { u.a = xp; u.b = wp; } return true; }
};
struct SchedMoe {
    const char* A; const char* B; int npan, nN, G, c; size_t tstepA, tstepB; int pstart[NE + 1]; bool gather;
    __device__ __forceinline__ bool next(int i, Unit& u) const { int pm, pn; if (!pg8::static_order(i, G, c, npan, nN, pm, pn)) return false; u.pm = pm; u.pn = pn; u.ty = 0;
        int e = 0;
#pragma unroll
        for (int j = 1; j < NE; ++j) e += (pm >= pstart[j]) ? 1 : 0;
        u.a = gather ? A : A + (size_t)pm * tstepA; u.b = B + ((size_t)e * nN + pn) * tstepB; return true; }
};

__device__ __forceinline__ void tr_item(const float* W, int ldw, int k0, int c0, bf16_t* WT, int K, int nrow0, LAS float* scr, int lane) {
#pragma unroll 8
    for (int i = 0; i < 32; ++i) { const int kk = 2 * i + (lane >> 5); scr[kk * 33 + (lane & 31)] = W[(size_t)(k0 + kk) * ldw + c0 + (lane & 31)]; }
    LDS_WAIT(); asm volatile("" ::: "memory");
    const int c = lane & 7;
#pragma unroll
    for (int j = 0; j < 4; ++j) { const int n = (lane >> 3) + 8 * j; const LAS float* s = scr + (8 * c) * 33 + n;
        u32x4 o; o.x = cvtpk(s[0 * 33], s[1 * 33]); o.y = cvtpk(s[2 * 33], s[3 * 33]); o.z = cvtpk(s[4 * 33], s[5 * 33]); o.w = cvtpk(s[6 * 33], s[7 * 33]);
        *(u32x4*)(WT + (size_t)(nrow0 + n) * K + k0 + 8 * c) = o; }
    LDS_WAIT(); asm volatile("" ::: "memory");
}
struct Job { const float* s0; const float* s1; bf16_t* dst; int ld, K, N, fam; };
__device__ __forceinline__ void run_job(Frame& F, const Job& jb, int rot) {
    LAS float* scr = (LAS float*)(F.lds + F.wave * 16384);
    const int NGW = F.G * NWAVES; int gw = (F.vcu * NWAVES + F.wave + rot) % NGW;
    const int nblk = jb.N / 32, nitems = (jb.K / 64) * nblk;
    for (int it = gw; it < nitems; it += NGW) {
        const int kb = it / nblk, nb = it - kb * nblk, n0 = nb * 32, k0 = kb * 64;
        const float* src = jb.s0; int c0 = n0;
        if (jb.fam == 0) { if (n0 < 1024) { const int t = n0 >> 8, w = n0 & 255; c0 = (w < 128) ? 128 * t + w : 512 + 128 * t + (w - 128); } }
        else if (jb.fam == 2) { const int t = n0 >> 8, w = n0 & 255; src = (w < 128) ? jb.s0 : jb.s1; c0 = 128 * t + (w & 127); }
        tr_item(src, jb.ld, k0, c0, jb.dst, jb.K, n0, scr, F.lane);
    }
}
__device__ __forceinline__ Job base_job(Frame& F, int j) {
    Job jb; jb.s1 = nullptr; jb.fam = 1;
    if (j < 24) { const int l = j / 6, k = j - l * 6;
        if (k == 0)      { jb.s0 = INP(3) + (size_t)l * D * NIN;  jb.ld = NIN; jb.K = D;    jb.N = NIN; jb.dst = (bf16_t*)(F.ws + WS_WIN + l * SZ_WIN); jb.fam = 0; }
        else if (k == 1) { jb.s0 = INP(8) + (size_t)l * CW * D;   jb.ld = D;   jb.K = CW;   jb.N = D;   jb.dst = (bf16_t*)(F.ws + WS_WC + l * SZ_WC); }
        else if (k == 2) { jb.s0 = INP(9) + (size_t)l * AW * D;   jb.ld = D;   jb.K = AW;   jb.N = D;   jb.dst = (bf16_t*)(F.ws + WS_WA + l * SZ_WA); }
        else if (k == 3) { jb.s0 = INP(10) + (size_t)l * D * D;   jb.ld = D;   jb.K = D;    jb.N = D;   jb.dst = (bf16_t*)(F.ws + WS_WOUT + l * SZ_WOUT); }
        else if (k == 4) { jb.s0 = INP(13) + (size_t)l * D * D;   jb.ld = D;   jb.K = D;    jb.N = D;   jb.dst = (bf16_t*)(F.ws + WS_WPG + l * SZ_WPG); }
        else             { jb.s0 = INP(14) + (size_t)l * PLED * D; jb.ld = D;  jb.K = PLED; jb.N = D;   jb.dst = (bf16_t*)(F.ws + WS_WPP + l * SZ_WPP); }
    } else { const int i = (j - 24) >> 1, k = (j - 24) & 1;
        if (k == 0) { jb.s0 = INP(17) + (size_t)i * D * FF; jb.s1 = INP(18) + (size_t)i * D * FF; jb.ld = FF; jb.K = D; jb.N = 2 * FF; jb.dst = (bf16_t*)(F.ws + WS_WGU + i * SZ_WGU); jb.fam = 2; }
        else        { jb.s0 = INP(19) + (size_t)i * FF * D; jb.ld = D; jb.K = FF; jb.N = D; jb.dst = (bf16_t*)(F.ws + WS_WD + i * SZ_WD); }
    }
    return jb;
}
__device__ __forceinline__ Job expert_job(Frame& F, int mi, int j) {
    Job jb; const int e = j >> 1, k = j & 1; const size_t eo = (size_t)(mi * NE + e) * D * FF;
    if (k == 0) { jb.s0 = INP(21) + eo; jb.s1 = INP(22) + eo; jb.ld = FF; jb.K = D; jb.N = 2 * FF; jb.dst = (bf16_t*)(F.ws + WS_EWGU + e * SZ_WGU); jb.fam = 2; }
    else        { jb.s0 = INP(23) + eo; jb.s1 = nullptr;       jb.ld = D;  jb.K = FF; jb.N = D;     jb.dst = (bf16_t*)(F.ws + WS_EWD + e * SZ_WD);   jb.fam = 1; }
    return jb;
}
__device__ __forceinline__ void cvt_rows(Frame& F, const float* src, bf16_t* dst, size_t n) {
    const size_t nch = n / 8, stride = (size_t)F.G * NTHR;
    for (size_t i = (size_t)F.vcu * NTHR + F.tid; i < nch; i += stride) { const f32x4 a = *(const f32x4*)(src + i * 8), b = *(const f32x4*)(src + i * 8 + 4);
        u32x4 w; w.x = cvtpk(a[0], a[1]); w.y = cvtpk(a[2], a[3]); w.z = cvtpk(b[0], b[1]); w.w = cvtpk(b[2], b[3]); *(u32x4*)(dst + i * 8) = w; }
}
__device__ __forceinline__ void prologue_phase(Frame& F) {
    for (int j = 0; j < 28; ++j) { const Job jb = base_job(F, j); run_job(F, jb, (j * 397) & 2047); }
    for (int j = 0; j < 16; ++j) { const Job jb = expert_job(F, 0, j); run_job(F, jb, (j * 397 + 100) & 2047); }
    cvt_rows(F, INP(0), (bf16_t*)(F.ws + WS_XB), (size_t)M * D);
}

__device__ __forceinline__ void thin_phase(Frame& F, int l) {
    const int tid = F.tid, lane = F.lane, wave = F.wave;
    {   const bf16_t* Kb = (const bf16_t*)(F.ws + WS_K); float* KM = (float*)(F.ws + WS_KM); LAS float* ps = (LAS float*)F.lds;
        for (int u = F.vcu; u < M / 256; u += F.G) {
            float s[8] = {0.f, 0.f, 0.f, 0.f, 0.f, 0.f, 0.f, 0.f};
#pragma unroll 4
            for (int i = 0; i < 32; ++i) { const u32x4 v = *(const u32x4*)(Kb + ((size_t)u * 256 + wave + 8 * i) * 512 + lane * 8);
                s[0] += bf_lo(v.x); s[1] += bf_hi(v.x); s[2] += bf_lo(v.y); s[3] += bf_hi(v.y); s[4] += bf_lo(v.z); s[5] += bf_hi(v.z); s[6] += bf_lo(v.w); s[7] += bf_hi(v.w); }
            __syncthreads();
#pragma unroll
            for (int j = 0; j < 8; ++j) ps[wave * 512 + lane * 8 + j] = s[j];
            __syncthreads();
            float t = 0.f;
#pragma unroll
            for (int w = 0; w < 8; ++w) t += ps[w * 512 + tid];
            KM[(size_t)u * 512 + tid] = t * (1.0f / 256.0f);
        }
        __syncthreads();
    }
    {   const bf16_t* H0 = (const bf16_t*)(F.ws + WS_H0); bf16_t* HC = (bf16_t*)(F.ws + WS_HC);
        LAS float* wl = (LAS float*)F.lds; LAS bf16_t* xt = (LAS bf16_t*)(F.lds + 63488);
        const float* cw = INP(4) + (size_t)l * CKW * CW;
        for (int i = tid; i < CKW * CW / 4; i += NTHR) ((LAS f32x4*)wl)[i] = ((const f32x4*)cw)[i];
        const f32x4 cb0 = *(const f32x4*)(INP(5) + l * CW + lane * 8), cb1 = *(const f32x4*)(INP(5) + l * CW + lane * 8 + 4);
        const f32x4 lg0 = *(const f32x4*)(INP(6) + l * CW + lane * 8), lg1 = *(const f32x4*)(INP(6) + l * CW + lane * 8 + 4);
        const f32x4 lb0 = *(const f32x4*)(INP(7) + l * CW + lane * 8), lb1 = *(const f32x4*)(INP(7) + l * CW + lane * 8 + 4);
        for (int u = F.vcu; u < BATCH * (SEQ / 32); u += F.G) {
            const int b = u / (SEQ / 32), t0 = (u % (SEQ / 32)) * 32;
            __syncthreads();
            for (int i = tid; i < 62 * 64; i += NTHR) { const int row = i >> 6, ch = i & 63, t = t0 - 30 + row; u32x4 v = {0u, 0u, 0u, 0u};
                if (t >= 0) v = *(const u32x4*)(H0 + ((size_t)(b * SEQ + t)) * 512 + ch * 8);
                *(LAS u32x4*)(xt + row * 512 + ch * 8) = v; }
            __syncthreads();
            float acc[4][8];
#pragma unroll
            for (int tt = 0; tt < 4; ++tt)
#pragma unroll
                for (int c = 0; c < 8; ++c) acc[tt][c] = 0.f;
#pragma unroll 1
            for (int j = 0; j < CKW; ++j) {
                const f32x4 w0 = *(const LAS f32x4*)(wl + j * 512 + lane * 8), w1 = *(const LAS f32x4*)(wl + j * 512 + lane * 8 + 4);
#pragma unroll
                for (int tt = 0; tt < 4; ++tt) { const u32x4 xv = *(const LAS u32x4*)(xt + (wave * 4 + tt + j) * 512 + lane * 8);
                    acc[tt][0] += w0[0] * bf_lo(xv.x); acc[tt][1] += w0[1] * bf_hi(xv.x); acc[tt][2] += w0[2] * bf_lo(xv.y); acc[tt][3] += w0[3] * bf_hi(xv.y);
                    acc[tt][4] += w1[0] * bf_lo(xv.z); acc[tt][5] += w1[1] * bf_hi(xv.z); acc[tt][6] += w1[2] * bf_lo(xv.w); acc[tt][7] += w1[3] * bf_hi(xv.w); }
            }
#pragma unroll
            for (int tt = 0; tt < 4; ++tt) {
                float v[8]; float s = 0.f;
#pragma unroll
                for (int c = 0; c < 8; ++c) { v[c] = acc[tt][c] + (c < 4 ? cb0[c] : cb1[c - 4]); s += v[c]; }
                const float mean = wave_sum(s) * (1.0f / CW); float q = 0.f;
#pragma unroll
                for (int c = 0; c < 8; ++c) { v[c] -= mean; q += v[c] * v[c]; }
                const float rstd = 1.0f / sqrtf(wave_sum(q) * (1.0f / CW) + LN_EPS);
#pragma unroll
                for (int c = 0; c < 8; ++c) { const float y = v[c] * rstd * (c < 4 ? lg0[c] : lg1[c - 4]) + (c < 4 ? lb0[c] : lb1[c - 4]); v[c] = y * sigmoidf_(y); }
                u32x4 w; w.x = cvtpk(v[0], v[1]); w.y = cvtpk(v[2], v[3]); w.z = cvtpk(v[4], v[5]); w.w = cvtpk(v[6], v[7]);
                *(u32x4*)(HC + ((size_t)(b * SEQ + t0 + wave * 4 + tt)) * 512 + lane * 8) = w;
            }
        }
        __syncthreads();
    }
    cvt_rows(F, INP(1) + (size_t)l * M * PLED, (bf16_t*)(F.ws + WS_PB), (size_t)M * PLED);
    if (l == 2) { for (int j = 0; j < 16; ++j) { const Job jb = expert_job(F, 1, j); run_job(F, jb, (j * 397) & 2047); } }
}

template <int MODE> __device__ __forceinline__ void ln_phase(Frame& F, int l) {
    const int tid = F.tid, lane = F.lane, wave = F.wave; const bool moe = (l & 1) != 0; const int mi = l >> 1;
    float* YB = (float*)(F.ws + WS_YB); bf16_t* XB = (bf16_t*)(F.ws + WS_XB);
    const float* gp = (MODE == 1 ? INP(11) : INP(15)) + l * D; const float* bp = (MODE == 1 ? INP(12) : INP(16)) + l * D;
    f32x4 g[4], bb[4];
#pragma unroll
    for (int j = 0; j < 4; ++j) { g[j] = *(const f32x4*)(gp + 4 * lane + 256 * j); bb[j] = *(const f32x4*)(bp + 4 * lane + 256 * j); }
    LAS float* wr = (LAS float*)F.lds;
    LAS float* rt = (LAS float*)(F.lds + 32768);
    LAS int* lcnt = (LAS int*)(F.lds + 32768 + 2048);
    LAS int* lrk = (LAS int*)(F.lds + 32768 + 2048 + 64);
    if (MODE == 1 && moe) { const float* rw = INP(20) + (size_t)mi * D * NE; for (int i = tid; i < D * NE / 4; i += NTHR) ((LAS f32x4*)wr)[i] = ((const f32x4*)rw)[i]; if (tid < 8) lcnt[tid] = 0; __syncthreads(); }
    for (int c = F.vcu; c < M / 128; c += F.G) {
        for (int i = 0; i < 16; ++i) {
            const int rl = wave + 8 * i; const size_t row = (size_t)c * 128 + rl;
            f32x4 v[4]; float s = 0.f;
#pragma unroll
            for (int j = 0; j < 4; ++j) v[j] = *(const f32x4*)(YB + row * D + 4 * lane + 256 * j);
            if (MODE == 2 && moe) {
                const bf16_t* P = (const bf16_t*)(F.ws + WS_PLE); const bf16_t* Ys = (const bf16_t*)F.out;
#pragma unroll
                for (int j = 0; j < 4; ++j) { const u32x2 p = *(const u32x2*)(P + row * D + 4 * lane + 256 * j);
                    const u32x2 y0 = *(const u32x2*)(Ys + (2 * row) * D + 4 * lane + 256 * j), y1 = *(const u32x2*)(Ys + (2 * row + 1) * D + 4 * lane + 256 * j);
                    v[j][0] = v[j][0] * ALPHA + bf_lo(p.x) + bf_lo(y0.x) + bf_lo(y1.x); v[j][1] = v[j][1] * ALPHA + bf_hi(p.x) + bf_hi(y0.x) + bf_hi(y1.x);
                    v[j][2] = v[j][2] * ALPHA + bf_lo(p.y) + bf_lo(y0.y) + bf_lo(y1.y); v[j][3] = v[j][3] * ALPHA + bf_hi(p.y) + bf_hi(y0.y) + bf_hi(y1.y); }
                asm volatile("s_waitcnt vmcnt(0)" ::: "memory");
            }
#pragma unroll
            for (int j = 0; j < 4; ++j) s += (v[j][0] + v[j][1]) + (v[j][2] + v[j][3]);
            const float mean = wave_sum(s) * (1.0f / D); float q = 0.f;
#pragma unroll
            for (int j = 0; j < 4; ++j) { v[j] = v[j] - mean; q += (v[j][0] * v[j][0] + v[j][1] * v[j][1]) + (v[j][2] * v[j][2] + v[j][3] * v[j][3]); }
            const float rstd = 1.0f / sqrtf(wave_sum(q) * (1.0f / D) + LN_EPS);
            float* of = (MODE == 1) ? YB : F.out;
#pragma unroll
            for (int j = 0; j < 4; ++j) { v[j] = v[j] * rstd * g[j] + bb[j]; *(f32x4*)(of + row * D + 4 * lane + 256 * j) = v[j];
                u32x2 w; w.x = cvtpk(v[j][0], v[j][1]); w.y = cvtpk(v[j][2], v[j][3]); *(u32x2*)(XB + row * D + 4 * lane + 256 * j) = w; }
            if (MODE == 1 && moe) {
                float lg[NE];
#pragma unroll
                for (int e = 0; e < NE; ++e) lg[e] = 0.f;
#pragma unroll
                for (int j = 0; j < 4; ++j)
#pragma unroll
                    for (int k = 0; k < 4; ++k) { const int kk = 4 * lane + 256 * j + k; const f32x4 w0 = *(const LAS f32x4*)(wr + kk * 8), w1 = *(const LAS f32x4*)(wr + kk * 8 + 4); const float xv = v[j][k];
                        lg[0] += xv * w0[0]; lg[1] += xv * w0[1]; lg[2] += xv * w0[2]; lg[3] += xv * w0[3]; lg[4] += xv * w1[0]; lg[5] += xv * w1[1]; lg[6] += xv * w1[2]; lg[7] += xv * w1[3]; }
#pragma unroll
                for (int e = 0; e < NE; ++e) lg[e] = wave_sum(lg[e]);
                float b1 = lg[0]; int i1 = 0;
#pragma unroll
                for (int e = 1; e < NE; ++e) if (lg[e] > b1) { b1 = lg[e]; i1 = e; }
                float b2 = -INFINITY; int i2 = 0;
#pragma unroll
                for (int e = 0; e < NE; ++e) if (e != i1 && lg[e] > b2) { b2 = lg[e]; i2 = e; }
                const float p1 = 1.0f / (1.0f + __expf(b2 - b1));
                if (lane == 0) { rt[rl * 4 + 0] = __int_as_float(i1); rt[rl * 4 + 1] = __int_as_float(i2); rt[rl * 4 + 2] = p1; rt[rl * 4 + 3] = 1.0f - p1; }
            }
        }
        if (MODE == 1 && moe) {
            __syncthreads();
            int e1 = 0, e2 = 0;
            if (tid < 128) { e1 = __float_as_int(rt[tid * 4 + 0]); e2 = __float_as_int(rt[tid * 4 + 1]); lrk[tid * 2 + 0] = atomicAdd((int*)&lcnt[e1], 1); lrk[tid * 2 + 1] = atomicAdd((int*)&lcnt[e2], 1); }
            __syncthreads();
            if (tid < 8) { const int n = lcnt[tid]; lcnt[8 + tid] = (int)__hip_atomic_fetch_add(F.ctl + CW_GCNT + (mi * NE + tid) * 64, (unsigned)n, RLX_AGENT); }
            __syncthreads();
            if (tid < 128) { int* ro = (int*)(F.ws + WS_ROUTE) + ((size_t)c * 128 + tid) * 8;
                ro[0] = e1; ro[1] = e2; ro[2] = lcnt[8 + e1] + lrk[tid * 2 + 0]; ro[3] = lcnt[8 + e2] + lrk[tid * 2 + 1]; ((float*)ro)[4] = rt[tid * 4 + 2]; ((float*)ro)[5] = rt[tid * 4 + 3]; }
            __syncthreads();
            if (tid < 8) lcnt[tid] = 0;
            __syncthreads();
        }
    }
}
__device__ __forceinline__ void moe_starts(Frame& F, int mi, int (&pstart)[NE + 1]) {
    int acc = 0;
#pragma unroll
    for (int e = 0; e < NE; ++e) { pstart[e] = acc; const int n = (int)__hip_atomic_load(F.ctl + CW_GCNT + (mi * NE + e) * 64, RLX_AGENT); acc += (n + 255) >> 8; }
    pstart[NE] = acc;
}
__device__ __forceinline__ void route_build(Frame& F, int mi) {
    int pstart[NE + 1]; moe_starts(F, mi, pstart);
    int* rtok = (int*)(F.ws + WS_RTOK); int* rdst = (int*)(F.ws + WS_RDST); float* rgate = (float*)(F.ws + WS_RGATE);
    for (int t = F.vcu * NTHR + F.tid; t < M; t += F.G * NTHR) { const int* ro = (const int*)(F.ws + WS_ROUTE) + (size_t)t * 8;
        int e1 = ro[0], e2 = ro[1], r1 = ro[2], r2 = ro[3]; const float p1 = ((const float*)ro)[4], p2 = ((const float*)ro)[5];
        int s1 = 0, s2 = 0;
#pragma unroll
        for (int e = 0; e < NE; ++e) { s1 = (e == e1) ? pstart[e] : s1; s2 = (e == e2) ? pstart[e] : s2; }
        const int q1 = s1 * 256 + r1, q2 = s2 * 256 + r2;
        rtok[q1] = t; rdst[q1] = 2 * t; rgate[q1] = p1; rtok[q2] = t; rdst[q2] = 2 * t + 1; rgate[q2] = p2; }
    if (F.vcu < NE) { const int e = F.vcu; const int n = (int)__hip_atomic_load(F.ctl + CW_GCNT + (mi * NE + e) * 64, RLX_AGENT);
        for (int q = pstart[e] * 256 + n + F.tid; q < pstart[e + 1] * 256; q += NTHR) { rtok[q] = 0; rdst[q] = -1; rgate[q] = 0.f; } }
}

__device__ __forceinline__ int crow(int r, int hi) { return (r & 3) + 8 * (r >> 2) + 4 * hi; }
__device__ __forceinline__ float pl32_max(float m) { auto rr = __builtin_amdgcn_permlane32_swap(__float_as_uint(m), __float_as_uint(m), false, false); return fmaxf(__uint_as_float(rr[0]), __uint_as_float(rr[1])); }
__device__ __forceinline__ float pl32_sum(float m) { auto rr = __builtin_amdgcn_permlane32_swap(__float_as_uint(m), __float_as_uint(m), false, false); return __uint_as_float(rr[0]) + __uint_as_float(rr[1]); }
__device__ __forceinline__ int rel_bucket_dev(int n) {
    if (n < 16) return n;
    const int large = 16 + (int)(__log2f((float)n * (1.0f / 16.0f)) * (16.0f / 3.0f));
    return large < 31 ? large : 31;
}
constexpr int AT_KS = 0, AT_KROW = 144, AT_KBUF = 64 * AT_KROW;
constexpr int AT_VS = 2 * AT_KBUF, AT_VROW = 136, AT_VBUF = 64 * AT_VROW;
constexpr int AT_LUT = AT_VS + 2 * AT_VBUF, AT_WSF = AT_LUT + 512, AT_END = AT_WSF + NWAVES * 256;
__device__ __forceinline__ void attn_phase(Frame& F) {
    const int tid = F.tid, lane = F.lane, wid = F.wave, r = lane & 31, hh = lane >> 5;
    const bf16_t* Q = (const bf16_t*)(F.ws + WS_Q); const bf16_t* Kb = (const bf16_t*)(F.ws + WS_K); const bf16_t* VT = (const bf16_t*)(F.ws + WS_VT);
    const float* KM = (const float*)(F.ws + WS_KM); bf16_t* HA = (bf16_t*)(F.ws + WS_HA); const float* rel_bias = INP(2);
    LAS unsigned char* L = F.lds; LAS float* lut = (LAS float*)(L + AT_LUT); LAS float* wsf = (LAS float*)(L + AT_WSF) + wid * 64;
    const int lrow = tid >> 3, lch = tid & 7;
    for (int n = F.vcu; n < BATCH * NH * NBLK; n += F.G) {
        const int ii = n >> 8, w = n & 255, bh = w >> 2, s4 = w & 3; const int qb = (ii == 0) ? s4 : (ii == 1) ? 7 - s4 : (ii == 2) ? 8 + s4 : 15 - s4;
        const int b = bh >> 3, h = bh & 7;
        const int q0 = qb * 256 + wid * 32;
        const bf16_t* Kh = Kb + (size_t)b * SEQ * 512 + h * 64; const bf16_t* Vh = VT + (size_t)(h * 64) * M + (size_t)b * SEQ;
#define AT_LOAD(i, kreg, vreg) do { const int kp_ = ((i) < 4) ? qb * 256 + (i) * 64 : ((i) - 4) * 64; \
            kreg = *(const u32x4*)(Kh + (size_t)(kp_ + lrow) * 512 + lch * 8); vreg = *(const u32x4*)(Vh + (size_t)lrow * M + kp_ + lch * 8); } while (0)
#define AT_STORE(buf, kreg, vreg) do { *(LAS u32x4*)(L + AT_KS + (buf) * AT_KBUF + lrow * AT_KROW + lch * 16) = kreg; \
            *(LAS u32x2*)(L + AT_VS + (buf) * AT_VBUF + lrow * AT_VROW + lch * 16) = (u32x2){vreg.x, vreg.y}; *(LAS u32x2*)(L + AT_VS + (buf) * AT_VBUF + lrow * AT_VROW + lch * 16 + 8) = (u32x2){vreg.z, vreg.w}; } while (0)
        u32x4 kreg, vreg;
        AT_LOAD(0, kreg, vreg);
        bf16x8 qf[4];
#pragma unroll
        for (int d0 = 0; d0 < 4; ++d0) qf[d0] = *(const bf16x8*)(Q + ((size_t)(b * SEQ + q0 + r)) * 512 + h * 64 + d0 * 16 + hh * 8);
        unsigned selmask = 0u;
        if (qb > 0) {
            f32x16 sc;
#pragma unroll
            for (int i = 0; i < 16; ++i) sc[i] = 0.f;
#pragma unroll
            for (int d0 = 0; d0 < 4; ++d0) {
                f32x4 k0 = {0.f, 0.f, 0.f, 0.f}, k1 = {0.f, 0.f, 0.f, 0.f};
                if (r < 16) { const float* kp = KM + ((size_t)(b * NBLK + r)) * 512 + h * 64 + d0 * 16 + hh * 8; k0 = *(const f32x4*)kp; k1 = *(const f32x4*)(kp + 4); }
                u32x4 hi4, lo4;
                hi4.x = cvtpk(k0[0], k0[1]); hi4.y = cvtpk(k0[2], k0[3]); hi4.z = cvtpk(k1[0], k1[1]); hi4.w = cvtpk(k1[2], k1[3]);
                lo4.x = cvtpk(k0[0] - bf_lo(hi4.x), k0[1] - bf_hi(hi4.x)); lo4.y = cvtpk(k0[2] - bf_lo(hi4.y), k0[3] - bf_hi(hi4.y));
                lo4.z = cvtpk(k1[0] - bf_lo(hi4.z), k1[1] - bf_hi(hi4.z)); lo4.w = cvtpk(k1[2] - bf_lo(hi4.w), k1[3] - bf_hi(hi4.w));
                sc = __builtin_amdgcn_mfma_f32_32x32x16_bf16(__builtin_bit_cast(bf16x8, hi4), qf[d0], sc, 0, 0, 0);
                sc = __builtin_amdgcn_mfma_f32_32x32x16_bf16(__builtin_bit_cast(bf16x8, lo4), qf[d0], sc, 0, 0, 0);
            }
            float full[16];
#pragma unroll
            for (int g = 0; g < 8; ++g) { const float mine = sc[g], other = __shfl_xor(mine, 32);
                full[crow(g, 0)] = hh ? other : mine; full[crow(g, 1)] = hh ? mine : other; }
#pragma unroll
            for (int p = 0; p < 3; ++p) { float best = -INFINITY; int bi = -1;
#pragma unroll
                for (int j = 0; j < 16; ++j) { const bool ok = (j < qb) && !((selmask >> j) & 1u) && (full[j] > best); best = ok ? full[j] : best; bi = ok ? j : bi; }
                if (bi >= 0) selmask |= 1u << bi; }
        }
        float m_run = -INFINITY, l_run = 0.f; f32x16 o0, o1;
#pragma unroll
        for (int i = 0; i < 16; ++i) { o0[i] = 0.f; o1[i] = 0.f; }
        __syncthreads();
        if (tid < 128) lut[tid] = rel_bias[rel_bucket_dev(tid) * NH + h] * LOG2E;
        AT_STORE(0, kreg, vreg);
        __syncthreads();
        const int NT = 4 * (qb + 1);
        for (int i = 0; i < NT; ++i) {
            if (i + 1 < NT) AT_LOAD(i + 1, kreg, vreg);
            const int buf = i & 1; const bool own = i < 4; const int kp0 = own ? qb * 256 + i * 64 : (i - 4) * 64; const int jblk = (i - 4) >> 2;
            const bool sel = own ? true : (((selmask >> jblk) & 1u) != 0u);
            const bool skip = own ? (i * 64 > wid * 32 + 31) : !__any(sel);
            if (!skip) {
                f32x16 p0, p1;
#pragma unroll
                for (int x = 0; x < 16; ++x) { p0[x] = 0.f; p1[x] = 0.f; }
                const LAS unsigned char* kb = L + AT_KS + buf * AT_KBUF + r * AT_KROW + hh * 16;
#pragma unroll
                for (int d0 = 0; d0 < 4; ++d0) {
                    const bf16x8 a0 = *(const LAS bf16x8*)(kb + d0 * 32), a1 = *(const LAS bf16x8*)(kb + 32 * AT_KROW + d0 * 32);
                    p0 = __builtin_amdgcn_mfma_f32_32x32x16_bf16(a0, qf[d0], p0, 0, 0, 0);
                    p1 = __builtin_amdgcn_mfma_f32_32x32x16_bf16(a1, qf[d0], p1, 0, 0, 0);
                }
                const int qpos = q0 + r;
                if (own || (q0 - (kp0 + 63) < 113)) {
#pragma unroll
                    for (int x = 0; x < 16; ++x) { const int d0_ = qpos - (kp0 + crow(x, hh)), d1_ = d0_ - 32;
                        const float b0 = lut[d0_ < 0 ? 0 : (d0_ > 127 ? 127 : d0_)], b1 = lut[d1_ < 0 ? 0 : (d1_ > 127 ? 127 : d1_)];
                        p0[x] = (d0_ < 0) ? -INFINITY : p0[x] + b0; p1[x] = (d1_ < 0) ? -INFINITY : p1[x] + b1; }
                } else { const float bc = lut[127];
#pragma unroll
                    for (int x = 0; x < 16; ++x) { p0[x] += bc; p1[x] += bc; } }
                if (!sel) {
#pragma unroll
                    for (int x = 0; x < 16; ++x) { p0[x] = -INFINITY; p1[x] = -INFINITY; } }
                float mt = fmaxf(p0[0], p1[0]);
#pragma unroll
                for (int x = 1; x < 16; ++x) mt = fmaxf(mt, fmaxf(p0[x], p1[x]));
                mt = pl32_max(mt);
                const float m_new = fmaxf(m_run, mt);
                if (__any(m_new > m_run)) {
                    const float alpha = (m_new > m_run) ? __builtin_amdgcn_exp2f(m_run - m_new) : 1.0f;
                    l_run *= alpha;
                    if (hh == 0) wsf[r] = alpha;
#pragma unroll
                    for (int x = 0; x < 16; ++x) { const float a = wsf[crow(x, hh)]; o0[x] *= a; o1[x] *= a; }
                    m_run = m_new;
                }
                float ls = 0.f;
#pragma unroll
                for (int x = 0; x < 16; ++x) { p0[x] = __builtin_amdgcn_exp2f(p0[x] - m_run); p1[x] = __builtin_amdgcn_exp2f(p1[x] - m_run); ls += p0[x] + p1[x]; }
                l_run += ls;
                const LAS unsigned char* vb = L + AT_VS + buf * AT_VBUF + r * AT_VROW + hh * 8;
#pragma unroll
                for (int kh = 0; kh < 2; ++kh)
#pragma unroll
                    for (int s = 0; s < 2; ++s) {
                        u32x4 pa;
                        if (kh == 0) { pa.x = cvtpk(p0[8 * s + 0], p0[8 * s + 1]); pa.y = cvtpk(p0[8 * s + 2], p0[8 * s + 3]); pa.z = cvtpk(p0[8 * s + 4], p0[8 * s + 5]); pa.w = cvtpk(p0[8 * s + 6], p0[8 * s + 7]); }
                        else         { pa.x = cvtpk(p1[8 * s + 0], p1[8 * s + 1]); pa.y = cvtpk(p1[8 * s + 2], p1[8 * s + 3]); pa.z = cvtpk(p1[8 * s + 4], p1[8 * s + 5]); pa.w = cvtpk(p1[8 * s + 6], p1[8 * s + 7]); }
                        const int ko = (32 * kh + 16 * s) * 2;
                        const u32x2 va0 = *(const LAS u32x2*)(vb + ko), va1 = *(const LAS u32x2*)(vb + ko + 16);
                        const u32x2 vb0 = *(const LAS u32x2*)(vb + 32 * AT_VROW + ko), vb1 = *(const LAS u32x2*)(vb + 32 * AT_VROW + ko + 16);
                        const u32x4 fa = {va0.x, va0.y, va1.x, va1.y}, fb = {vb0.x, vb0.y, vb1.x, vb1.y};
                        o0 = __builtin_amdgcn_mfma_f32_32x32x16_bf16(__builtin_bit_cast(bf16x8, pa), __builtin_bit_cast(bf16x8, fa), o0, 0, 0, 0);
                        o1 = __builtin_amdgcn_mfma_f32_32x32x16_bf16(__builtin_bit_cast(bf16x8, pa), __builtin_bit_cast(bf16x8, fb), o1, 0, 0, 0);
                    }
            }
            if (i + 1 < NT) AT_STORE((i + 1) & 1, kreg, vreg);
            __syncthreads();
        }
        const float lt = pl32_sum(l_run);
        if (hh == 0) wsf[r] = 1.0f / lt;
        bf16_t* Ow = HA + ((size_t)(b * SEQ + q0)) * 512 + h * 64 + r;
#pragma unroll
        for (int x = 0; x < 16; ++x) { const int qq = crow(x, hh); const float a = wsf[qq];
            const unsigned w0 = cvtpk(o0[x] * a, 0.f), w1 = cvtpk(o1[x] * a, 0.f);
            Ow[(size_t)qq * 512] = (bf16_t)(w0 & 0xffffu); Ow[(size_t)qq * 512 + 32] = (bf16_t)(w1 & 0xffffu); }
#undef AT_LOAD
#undef AT_STORE
    }
    __syncthreads();
}

constexpr int NPH = 12, N_PHASES = 1 + DEPTH * NPH;
struct Args { const float* in[24]; float* out; unsigned char* ws; int ph; int pad; };
#ifndef PH_NOINLINE
#define PH_NOINLINE 0
#endif
#if PH_NOINLINE
#define PHASE_FN __device__ __noinline__
#else
#define PHASE_FN __device__ __forceinline__
#endif
__device__ __forceinline__ Frame make_frame(unsigned char* ws, float* out, LAS unsigned char* lds, int wv) {
    Frame F; F.lds = lds; F.MISC = (volatile LAS unsigned*)(lds + MISC_OFF);
    F.tid = phase_tid(wv); F.lane = F.tid & 63; F.wave = __builtin_amdgcn_readfirstlane(F.tid >> 6);
    F.G = gridDim.x; F.bx = blockIdx.x; F.vcu = (F.G % 8 == 0) ? (F.bx % 8) * (F.G / 8) + F.bx / 8 : F.bx;
    F.ws = ws; F.ctl = (unsigned*)(ws + WS_CTL); F.out = out; return F;
}
constexpr size_t T1024 = (size_t)256 * 1024 * 2, T512 = (size_t)256 * 512 * 2, T256 = (size_t)256 * 256 * 2, T3584 = (size_t)256 * 3584 * 2;
PHASE_FN void ph_prologue(unsigned char* ws, float* out, LAS unsigned char* lds, int wv) { Frame F = make_frame(ws, out, lds, wv); prologue_phase(F); }
PHASE_FN void ph_inproj(unsigned char* ws, float* out, LAS unsigned char* lds, int wv, int l) { Frame F = make_frame(ws, out, lds, wv);
    SchedInProj S{(const char*)(ws + WS_XB), (const char*)(ws + WS_WIN + l * SZ_WIN), F.G, F.bx, T1024};
    EpiInProj E{(bf16_t*)(ws + WS_H0), (bf16_t*)(ws + WS_Q), (bf16_t*)(ws + WS_K), (bf16_t*)(ws + WS_VT), (bf16_t*)(ws + WS_SG)};
    pg8::gemm_phase<EpiInProj, SchedInProj, false>(lds, wv, D, S, E, nullptr); }
PHASE_FN void ph_thin(unsigned char* ws, float* out, LAS unsigned char* lds, int wv, int l) { Frame F = make_frame(ws, out, lds, wv); thin_phase(F, l); }
PHASE_FN void ph_attn(unsigned char* ws, float* out, LAS unsigned char* lds, int wv) { Frame F = make_frame(ws, out, lds, wv); attn_phase(F); }
PHASE_FN void ph_mixc(unsigned char* ws, float* out, LAS unsigned char* lds, int wv, int l) { Frame F = make_frame(ws, out, lds, wv);
    SchedGrid S{(const char*)(ws + WS_HC), (const char*)(ws + WS_WC + l * SZ_WC), M / 256, D / 256, F.G, F.bx, T512};
    EpiBf16Row<0> E{(bf16_t*)(ws + WS_MIX), D, (const bf16_t*)(ws + WS_SG), 2048};
    pg8::gemm_phase<EpiBf16Row<0>, SchedGrid, false>(lds, wv, CW, S, E, nullptr); }
PHASE_FN void ph_mixa(unsigned char* ws, float* out, LAS unsigned char* lds, int wv, int l) { Frame F = make_frame(ws, out, lds, wv);
    SchedGrid S{(const char*)(ws + WS_HA), (const char*)(ws + WS_WA + l * SZ_WA), M / 256, D / 256, F.G, F.bx, T512};
    EpiBf16Row<1> E{(bf16_t*)(ws + WS_MIX), D, (const bf16_t*)(ws + WS_SG) + 1024, 2048};
    pg8::gemm_phase<EpiBf16Row<1>, SchedGrid, false>(lds, wv, AW, S, E, nullptr); }
PHASE_FN void ph_outproj(unsigned char* ws, float* out, LAS unsigned char* lds, int wv, int l) { Frame F = make_frame(ws, out, lds, wv);
    SchedGrid S{(const char*)(ws + WS_MIX), (const char*)(ws + WS_WOUT + l * SZ_WOUT), M / 256, D / 256, F.G, F.bx, T1024};
    EpiResF32<0> E{(l == 0) ? INP(0) : (const float*)out, (float*)(ws + WS_YB), nullptr};
    pg8::gemm_phase<EpiResF32<0>, SchedGrid, false>(lds, wv, D, S, E, nullptr); }
PHASE_FN void ph_ln1(unsigned char* ws, float* out, LAS unsigned char* lds, int wv, int l) { Frame F = make_frame(ws, out, lds, wv); ln_phase<1>(F, l); }
PHASE_FN void ph_ln2(unsigned char* ws, float* out, LAS unsigned char* lds, int wv, int l) { Frame F = make_frame(ws, out, lds, wv); ln_phase<2>(F, l); }
PHASE_FN void ph_plegate(unsigned char* ws, float* out, LAS unsigned char* lds, int wv, int l) { Frame F = make_frame(ws, out, lds, wv);
    if (l & 1) route_build(F, l >> 1);
    SchedGrid S{(const char*)(ws + WS_XB), (const char*)(ws + WS_WPG + l * SZ_WPG), M / 256, D / 256, F.G, F.bx, T1024};
    EpiBf16Row<2> E{(bf16_t*)(ws + WS_PLE), D, nullptr, 0};
    pg8::gemm_phase<EpiBf16Row<2>, SchedGrid, false>(lds, wv, D, S, E, nullptr); }
PHASE_FN void ph_pleproj(unsigned char* ws, float* out, LAS unsigned char* lds, int wv, int l) { Frame F = make_frame(ws, out, lds, wv);
    SchedGrid S{(const char*)(ws + WS_PB), (const char*)(ws + WS_WPP + l * SZ_WPP), M / 256, D / 256, F.G, F.bx, T256};
    EpiBf16Row<3> E{(bf16_t*)(ws + WS_PLE), D, nullptr, 0};
    pg8::gemm_phase<EpiBf16Row<3>, SchedGrid, false>(lds, wv, PLED, S, E, nullptr); }
PHASE_FN void ph_ffn_up_dense(unsigned char* ws, float* out, LAS unsigned char* lds, int wv, int mi) { Frame F = make_frame(ws, out, lds, wv);
    EpiSwiGLU E{(bf16_t*)(ws + WS_H)};
    SchedGrid S{(const char*)(ws + WS_XB), (const char*)(ws + WS_WGU + mi * SZ_WGU), M / 256, 2 * FF / 256, F.G, F.bx, T1024};
    pg8::gemm_phase<EpiSwiGLU, SchedGrid, false>(lds, wv, D, S, E, nullptr); }
PHASE_FN void ph_ffn_up_moe(unsigned char* ws, float* out, LAS unsigned char* lds, int wv, int mi) { Frame F = make_frame(ws, out, lds, wv);
    EpiSwiGLU E{(bf16_t*)(ws + WS_H)};
    SchedMoe S; S.A = (const char*)(ws + WS_XB); S.B = (const char*)(ws + WS_EWGU); S.nN = 2 * FF / 256; S.G = F.G; S.c = F.bx; S.tstepA = T1024; S.tstepB = T1024; S.gather = true;
    moe_starts(F, mi, S.pstart); S.npan = S.pstart[NE];
    pg8::gemm_phase<EpiSwiGLU, SchedMoe, true>(lds, wv, D, S, E, (const int*)(ws + WS_RTOK)); }
PHASE_FN void ph_ffn_down_dense(unsigned char* ws, float* out, LAS unsigned char* lds, int wv, int mi) { Frame F = make_frame(ws, out, lds, wv);
    SchedGrid S{(const char*)(ws + WS_H), (const char*)(ws + WS_WD + mi * SZ_WD), M / 256, D / 256, F.G, F.bx, T3584};
    EpiResF32<1> E{(const float*)(ws + WS_YB), (float*)(ws + WS_YB), (const bf16_t*)(ws + WS_PLE)};
    pg8::gemm_phase<EpiResF32<1>, SchedGrid, false>(lds, wv, FF, S, E, nullptr); }
PHASE_FN void ph_ffn_down_moe(unsigned char* ws, float* out, LAS unsigned char* lds, int wv, int mi) { Frame F = make_frame(ws, out, lds, wv);
    SchedMoe S; S.A = (const char*)(ws + WS_H); S.B = (const char*)(ws + WS_EWD); S.nN = D / 256; S.G = F.G; S.c = F.bx; S.tstepA = T3584; S.tstepB = T3584; S.gather = false;
    moe_starts(F, mi, S.pstart); S.npan = S.pstart[NE];
    EpiMoeDown E{(bf16_t*)out, (const int*)(ws + WS_RDST), (const float*)(ws + WS_RGATE)};
    pg8::gemm_phase<EpiMoeDown, SchedMoe, false>(lds, wv, FF, S, E, nullptr); }

__global__ void __launch_bounds__(NTHR, 2) fwd_kernel(Args args) {
    extern __shared__ __attribute__((aligned(16))) unsigned char lds_raw[];
    LAS unsigned char* lds = (LAS unsigned char*)lds_raw;
    unsigned char* ws = args.ws; float* out = args.out;
    const int wv = __builtin_amdgcn_readfirstlane((int)threadIdx.x >> 6);
    for (int u = phase_tid(wv); u < (LDS_BYTES - LDSCTL_OFF) / 4; u += NTHR) ((LAS unsigned*)(lds + LDSCTL_OFF))[u] = 0u;
    __syncthreads();
#if MK_SINGLE
    XcdBarrier bar = xcd_barrier_post((unsigned*)(ws + WS_CTL) + CW_BAR, (volatile LAS unsigned*)(lds + MISC_OFF) + 8, phase_tid(wv));
#define RUN(k) (true)
#define SEAM() do { XcdBarrier b_ = bar; asm volatile("" : "+s"(b_.bar), "+s"(b_.x)); xcd_barrier(b_, phase_tid(wv)); } while (0)
#else
    const int ph = args.ph;
#define RUN(k) (ph == (k))
#define SEAM() do { } while (0)
#endif
    if (RUN(0)) ph_prologue(ws, out, lds, wv);
    SEAM();
#pragma unroll 1
    for (int l = 0; l < DEPTH; ++l) {
        const int pb = 1 + l * NPH; const bool moe = (l & 1) != 0; const int mi = l >> 1;
        if (RUN(pb + 0)) ph_inproj(ws, out, lds, wv, l);
        SEAM();
        if (RUN(pb + 1)) ph_thin(ws, out, lds, wv, l);
        SEAM();
        if (RUN(pb + 2)) ph_attn(ws, out, lds, wv);
        SEAM();
        if (RUN(pb + 3)) ph_mixc(ws, out, lds, wv, l);
        SEAM();
        if (RUN(pb + 4)) ph_mixa(ws, out, lds, wv, l);
        SEAM();
        if (RUN(pb + 5)) ph_outproj(ws, out, lds, wv, l);
        SEAM();
        if (RUN(pb + 6)) ph_ln1(ws, out, lds, wv, l);
        SEAM();
        if (RUN(pb + 7)) ph_plegate(ws, out, lds, wv, l);
        SEAM();
        if (RUN(pb + 8)) ph_pleproj(ws, out, lds, wv, l);
        SEAM();
        if (RUN(pb + 9)) { if (!moe) ph_ffn_up_dense(ws, out, lds, wv, mi); else ph_ffn_up_moe(ws, out, lds, wv, mi); }
        SEAM();
        if (RUN(pb + 10)) { if (!moe) ph_ffn_down_dense(ws, out, lds, wv, mi); else ph_ffn_down_moe(ws, out, lds, wv, mi); }
        SEAM();
        if (RUN(pb + 11)) ph_ln2(ws, out, lds, wv, l);
        if (l + 1 < DEPTH) SEAM();
    }
#undef RUN
#undef SEAM
}

extern "C" void kernel_launch(void* const* d_in, const int* in_sizes, int n_in, void* d_out, int out_size, void* d_ws, size_t ws_size, hipStream_t stream) {
    static int grid = 0;
    if (grid == 0) {
        if (n_in != 24 || in_sizes[0] != M * D || out_size != M * D || ws_size < WS_END) { fprintf(stderr, "kernel_launch: unexpected problem shape / workspace (%d inputs, ws %zu < %zu)\n", n_in, ws_size, (size_t)WS_END); grid = -1; return; }
        int dev = 0, cus = 0, per_cu = 0;
        if (hipGetDevice(&dev) != hipSuccess || hipDeviceGetAttribute(&cus, hipDeviceAttributeMultiprocessorCount, dev) != hipSuccess) { grid = -1; return; }
        if (hipFuncSetAttribute((const void*)fwd_kernel, hipFuncAttributeMaxDynamicSharedMemorySize, LDS_BYTES) != hipSuccess) { fprintf(stderr, "kernel_launch: hipFuncSetAttribute failed\n"); grid = -1; return; }
        if (hipOccupancyMaxActiveBlocksPerMultiprocessor(&per_cu, (const void*)fwd_kernel, NTHR, LDS_BYTES) != hipSuccess || per_cu < 1) fprintf(stderr, "kernel_launch: occupancy query reports %d\n", per_cu);
        (void)hipGetLastError();
        grid = cus;
    }
    if (grid < 0) return;
    (void)hipMemsetAsync((char*)d_ws + WS_CTL, 0, CTL_ZERO_BYTES, stream);
    Args a{};
    for (int i = 0; i < 24; ++i) a.in[i] = (const float*)d_in[i];
    a.out = (float*)d_out; a.ws = (unsigned char*)d_ws; a.ph = 0; a.pad = 0;
#if MK_SINGLE
    hipLaunchKernelGGL(fwd_kernel, dim3(grid), dim3(NTHR), LDS_BYTES, stream, a);
#else
    for (int ph = 0; ph < N_PHASES; ++ph) { a.ph = ph; hipLaunchKernelGGL(fwd_kernel, dim3(grid), dim3(NTHR), LDS_BYTES, stream, a); }
#endif
}
```

```cpp
#include <hip/hip_runtime.h>
#include <cstdio>
#include <cstdint>

#ifndef MK_SINGLE
#define MK_SINGLE 1
#endif
#ifndef DBG_CHECK
#define DBG_CHECK 0
#endif

#define LAS __attribute__((address_space(3)))
#define GAS __attribute__((address_space(1)))
typedef unsigned short bf16_t;
typedef short bf16x8 __attribute__((ext_vector_type(8)));
typedef short s16x4 __attribute__((ext_vector_type(4)));
typedef float f32x2 __attribute__((ext_vector_type(2)));
typedef float f32x4 __attribute__((ext_vector_type(4)));
typedef float f32x16 __attribute__((ext_vector_type(16)));
typedef unsigned u32x2 __attribute__((ext_vector_type(2)));
typedef unsigned u32x4 __attribute__((ext_vector_type(4)));
typedef __bf16 bf16x2_t __attribute__((ext_vector_type(2)));

constexpr int D = 1024, BATCH = 8, SEQ = 4096, M = BATCH * SEQ, DEPTH = 4;
constexpr int NH = 8, HD = 64, AW = 512, CW = 512, CKW = 31, MOBA = 256, NBLK = SEQ / MOBA;
constexpr int FF = 3584, NE = 8, PLED = 256, NIN = 4608;
constexpr float LN_EPS = 1e-5f;
constexpr float ALPHA = 1.6817928305074290f;
constexpr float LOG2E = 1.4426950408889634f;
constexpr float QSCALE = 0.125f * LOG2E;
constexpr int NWAVES = 8, NTHR = 512;
constexpr int MAXPANEL = 264;
constexpr int MAXROWS = MAXPANEL * 256;

constexpr size_t MiB = 1u << 20;
constexpr size_t WS_CTL = 0, CTL_ZERO_BYTES = 1 * MiB;
constexpr size_t SZ_WIN = (size_t)NIN * D * 2, SZ_WC = (size_t)D * CW * 2, SZ_WA = (size_t)D * AW * 2, SZ_WOUT = (size_t)D * D * 2, SZ_WPG = (size_t)D * D * 2, SZ_WPP = (size_t)D * PLED * 2;
constexpr size_t SZ_WGU = (size_t)2 * FF * D * 2, SZ_WD = (size_t)D * FF * 2;
constexpr size_t WS_WIN = 2 * MiB;
constexpr size_t WS_WC = WS_WIN + DEPTH * SZ_WIN;
constexpr size_t WS_WA = WS_WC + DEPTH * SZ_WC;
constexpr size_t WS_WOUT = WS_WA + DEPTH * SZ_WA;
constexpr size_t WS_WPG = WS_WOUT + DEPTH * SZ_WOUT;
constexpr size_t WS_WPP = WS_WPG + DEPTH * SZ_WPG;
constexpr size_t WS_WGU = WS_WPP + DEPTH * SZ_WPP;
constexpr size_t WS_WD = WS_WGU + 2 * SZ_WGU;
constexpr size_t WS_EWGU = WS_WD + 2 * SZ_WD;
constexpr size_t WS_EWD = WS_EWGU + NE * SZ_WGU;
constexpr size_t WS_XB = WS_EWD + NE * SZ_WD;
constexpr size_t WS_YB = WS_XB + (size_t)M * D * 2;
constexpr size_t WS_PB = WS_YB + (size_t)M * D * 4;
constexpr size_t WS_PLE = WS_PB + (size_t)M * PLED * 2;
constexpr size_t WS_KM = WS_PLE + (size_t)M * D * 2;
constexpr size_t WS_ROUTE = WS_KM + (size_t)128 * 512 * 4;
constexpr size_t WS_RTOK = WS_ROUTE + (size_t)M * 32;
constexpr size_t WS_RDST = WS_RTOK + (size_t)MAXROWS * 4;
constexpr size_t WS_RGATE = WS_RDST + (size_t)MAXROWS * 4;
constexpr size_t WS_U = ((WS_RGATE + (size_t)MAXROWS * 4 + 4095) / 4096) * 4096;
constexpr size_t WS_H0 = WS_U;
constexpr size_t WS_Q = WS_H0 + (size_t)M * 512 * 2;
constexpr size_t WS_K = WS_Q + (size_t)M * 512 * 2;
constexpr size_t WS_VT = WS_K + (size_t)M * 512 * 2;
constexpr size_t WS_SG = WS_VT + (size_t)M * 512 * 2;
constexpr size_t WS_HC = WS_SG + (size_t)M * 2048 * 2;
constexpr size_t WS_HA = WS_HC + (size_t)M * 512 * 2;
constexpr size_t WS_MIX = WS_HA + (size_t)M * 512 * 2;
constexpr size_t WS_U_END_TM = WS_MIX + (size_t)M * D * 2;
constexpr size_t WS_H = WS_U;
constexpr size_t WS_U_END_FF = WS_H + (size_t)MAXROWS * FF * 2;
constexpr size_t WS_END = WS_U_END_FF > WS_U_END_TM ? WS_U_END_FF : WS_U_END_TM;

constexpr int CW_BAR = 4096;
constexpr int CW_GCNT = 16384;
constexpr int CW_DBG = 32768;

constexpr int RING_BYTES = 131072;
constexpr int LDSCTL_OFF = RING_BYTES, MISC_OFF = LDSCTL_OFF + 320;
constexpr int LDS_BYTES = 147456;

#define RLX_AGENT __ATOMIC_RELAXED, __HIP_MEMORY_SCOPE_AGENT
#define LDS_WAIT() asm volatile("s_waitcnt lgkmcnt(0)" ::: "memory")
#define VM_WAIT() asm volatile("s_waitcnt vmcnt(0)" ::: "memory")

__device__ __forceinline__ unsigned cvtpk(float lo, float hi) { f32x2 v = {lo, hi}; bf16x2_t b = __builtin_convertvector(v, bf16x2_t); return __builtin_bit_cast(unsigned, b); }
__device__ __forceinline__ float bf_lo(unsigned w) { return __uint_as_float(w << 16); }
__device__ __forceinline__ float bf_hi(unsigned w) { return __uint_as_float(w & 0xffff0000u); }
__device__ __forceinline__ float sigmoidf_(float x) { return __builtin_amdgcn_rcpf(1.0f + __builtin_amdgcn_exp2f(-x * LOG2E)); }

__device__ __forceinline__ int phase_tid(int wv) {
    int w = wv, ln; asm volatile("v_mbcnt_lo_u32_b32 %1, -1, 0\n\tv_mbcnt_hi_u32_b32 %1, -1, %1" : "+s"(w), "=&v"(ln));
    return w * 64 + ln;
}
namespace pg8 {
constexpr int BM = 256, BK = 64, HALF = 128, HTB = HALF * BK * 2, STAGE_BYTES = 8 * HTB, NXCD = 8, WGM = 8;
__host__ __device__ __forceinline__ int lds_byte(int r, int c) { const int st = (r >> 4) * 2 + (c >> 5), rr = r & 15, cc = c & 31, ob = rr * 64 + cc * 2; return st * 1024 + (ob ^ (((ob >> 9) & 1) << 5)); }
__host__ __device__ __forceinline__ void stage_rc(int b, int& R, int& C) { const int st = b / 1024, sb = b % 1024, swz = sb ^ (((sb >> 9) & 1) << 5); R = (st >> 1) * 16 + swz / 64; C = (st & 1) * 32 + (swz % 64) / 2; }
__host__ __device__ __forceinline__ int perm32(int rho) { const int n = rho >> 4, i = rho & 15; return 8 * (i >> 2) + 4 * n + (i & 3); }

struct Unit { const char* a; const char* b; int pm, pn, ty; };

__device__ __forceinline__ bool static_order(int i, int G, int c, int nM, int nN, int& pm, int& pn) {
    const int nwg = nM * nN; const long L = (long)i * G + c; if (L >= nwg) return false;
    int wgid = (int)L; { const int q = nwg / NXCD, r = nwg % NXCD, xcd = wgid % NXCD, off = wgid / NXCD; wgid = (xcd < r ? xcd * (q + 1) : r * (q + 1) + (xcd - r) * q) + off; }
    const int nig = WGM * nN, gid = wgid / nig, fm = gid * WGM, gsz = (nM - fm) < WGM ? (nM - fm) : WGM;
    pm = fm + ((wgid % nig) % gsz); pn = (wgid % nig) / gsz; return true;
}

template <class Epi, class Sched, bool GATHER>
__device__ __forceinline__ void gemm_phase(LAS unsigned char* lds, const int wv, const int K, const Sched& S, const Epi& E, const int* gidx) {
    const int tid = phase_tid(wv),
              wid = __builtin_amdgcn_readfirstlane(tid >> 6), lane = tid & 63, wr = wid >> 2, wc = wid & 3, fr = lane & 15, fq = lane >> 4;
    const int nt = K / BK;
    const size_t kstep = (size_t)(BK * 2);
    const size_t hstep = (size_t)HALF * K * 2;
    unsigned vA0[2], vA1[2], voffB[2];
#pragma unroll
    for (int i = 0; i < 2; ++i) { int R, C; stage_rc(tid * 16 + i * 8192, R, C); const int Rb = Epi::PERM ? ((R & ~31) + perm32(R & 31)) : R;
        vA0[i] = (unsigned)(R * K + C) * 2u; vA1[i] = vA0[i] + (unsigned)hstep; voffB[i] = (unsigned)(Rb * K + C) * 2u; }
    const unsigned ldsw = (unsigned)wid * 1024u;
    const int aoff = lds_byte(wr * 64 + fr, fq * 8), boff = lds_byte(wc * 32 + fr, fq * 8);
#define PG8_SA(b, h) (((b) * 2 + (h)) * HTB)
#define PG8_SB(b, h) ((4 + (b) * 2 + (h)) * HTB)
#define PG8_STAGE(bufoff, gbase, voff) do { _Pragma("unroll") for (int _i = 0; _i < 2; ++_i) \
        __builtin_amdgcn_global_load_lds((const unsigned*)((const char*)(gbase) + (voff)[_i]), (LAS unsigned*)(lds + (bufoff) + ldsw + _i * 8192), 16, 0, 0); } while (0)
#define PG8_LDA(dst, b, h) do { _Pragma("unroll") for (int m = 0; m < 4; ++m) _Pragma("unroll") for (int k = 0; k < 2; ++k) dst[m][k] = *(const LAS bf16x8*)(lds + PG8_SA(b, h) + aoff + m * 2048 + k * 1024); } while (0)
#define PG8_LDB(dst, b, h) do { _Pragma("unroll") for (int n = 0; n < 2; ++n) _Pragma("unroll") for (int k = 0; k < 2; ++k) dst[n][k] = *(const LAS bf16x8*)(lds + PG8_SB(b, h) + boff + n * 2048 + k * 1024); } while (0)
#define PG8_MMA(ai, bj, At, Bt) do { __builtin_amdgcn_s_setprio(1); _Pragma("unroll") for (int m = 0; m < 4; ++m) _Pragma("unroll") for (int n = 0; n < 2; ++n) _Pragma("unroll") for (int k = 0; k < 2; ++k) \
        acc[ai][bj][m][n] = __builtin_amdgcn_mfma_f32_16x16x32_bf16(Bt[n][k], At[m][k], acc[ai][bj][m][n], 0, 0, 0); __builtin_amdgcn_s_setprio(0); } while (0)
#define PG8_WAIT_V(n) asm volatile("s_waitcnt vmcnt(" #n ")" ::: "memory")
#define PG8_WAIT_L(n) asm volatile("s_waitcnt lgkmcnt(" #n ")" ::: "memory")
#define PG8_BAR __builtin_amdgcn_s_barrier()
#define PG8_SCHED __builtin_amdgcn_sched_barrier(0)
    Unit cur, nxt; int ui = 0;
    if (!S.next(0, cur)) return;
#define PG8_GATHER(pm_, o0, o1) do { int t_ = tid; asm volatile("" : "+v"(t_)); _Pragma("unroll") for (int i = 0; i < 2; ++i) { int R, C; stage_rc(t_ * 16 + i * 8192, R, C); const int* gp_ = gidx + (pm_) * BM + R; \
        o0[i] = (unsigned)(gp_[0] * K + C) * 2u; o1[i] = (unsigned)(gp_[HALF] * K + C) * 2u; } } while (0)
    if constexpr (GATHER) PG8_GATHER(cur.pm, vA0, vA1);
    unsigned nA0[2] = {vA0[0], vA0[1]}, nA1[2] = {vA1[0], vA1[1]};
    f32x4 acc[2][2][4][2];
#pragma unroll
    for (int a = 0; a < 2; ++a)
#pragma unroll
        for (int b = 0; b < 2; ++b)
#pragma unroll
            for (int m = 0; m < 4; ++m)
#pragma unroll
                for (int n = 0; n < 2; ++n) acc[a][b][m][n] = (f32x4){0.f, 0.f, 0.f, 0.f};
    bf16x8 At[4][2], B0[2][2], B1[2][2];
    const char* cA = cur.a; const char* cB = cur.b;
    PG8_STAGE(PG8_SB(0, 0), cB, voffB); PG8_STAGE(PG8_SB(0, 1), cB + hstep, voffB); PG8_STAGE(PG8_SA(0, 0), cA, vA0); PG8_STAGE(PG8_SA(0, 1), cA, vA1);
    if (wr == 1) PG8_BAR;
    PG8_WAIT_V(2); PG8_BAR;
    PG8_STAGE(PG8_SB(1, 0), cB + kstep, voffB); PG8_STAGE(PG8_SA(1, 0), cA + kstep, vA0); PG8_STAGE(PG8_SB(1, 1), cB + hstep + kstep, voffB);
    PG8_WAIT_V(6); PG8_BAR;
    for (;;) {
        const bool has_next = S.next(ui + 1, nxt);
        const char* nA = has_next ? nxt.a : cA; const char* nB = has_next ? nxt.b : cB;
        if constexpr (GATHER) {
            if (has_next) PG8_GATHER(nxt.pm, nA0, nA1);
        }
        for (int t = 0; t < nt; t += 2) {
            const bool last = (t == nt - 2);
            const char* a1 = cA + (size_t)(t + 1) * kstep;
            const char* a2 = last ? nA : cA + (size_t)(t + 2) * kstep; const char* b2 = last ? nB : cB + (size_t)(t + 2) * kstep;
            const char* a3 = a2 + kstep; const char* b3 = b2 + kstep;
            unsigned w0[2], w1[2];
            if constexpr (GATHER) { w0[0] = last ? nA0[0] : vA0[0]; w0[1] = last ? nA0[1] : vA0[1]; w1[0] = last ? nA1[0] : vA1[0]; w1[1] = last ? nA1[1] : vA1[1]; }
            else { w0[0] = vA0[0]; w0[1] = vA0[1]; w1[0] = vA1[0]; w1[1] = vA1[1]; }
            PG8_LDB(B0, 0, 0); PG8_LDB(B1, 0, 1); PG8_SCHED; PG8_LDA(At, 0, 0); PG8_STAGE(PG8_SA(1, 1), a1, vA1);
            PG8_WAIT_V(8); PG8_WAIT_L(0); PG8_BAR; PG8_MMA(0, 0, At, B0); PG8_MMA(0, 1, At, B1); PG8_BAR; PG8_SCHED;
            PG8_LDA(At, 0, 1); PG8_STAGE(PG8_SB(0, 0), b2, voffB); PG8_STAGE(PG8_SB(0, 1), b2 + hstep, voffB); PG8_STAGE(PG8_SA(0, 0), a2, w0);
            PG8_WAIT_V(8); PG8_WAIT_L(0); PG8_BAR; PG8_MMA(1, 0, At, B0); PG8_MMA(1, 1, At, B1); PG8_BAR; PG8_SCHED;
            PG8_LDB(B0, 1, 0); PG8_LDB(B1, 1, 1); PG8_SCHED; PG8_LDA(At, 1, 0); PG8_STAGE(PG8_SA(0, 1), a2, w1);
            PG8_WAIT_V(8); PG8_WAIT_L(0); PG8_BAR; PG8_MMA(0, 0, At, B0); PG8_MMA(0, 1, At, B1); PG8_BAR; PG8_SCHED;
            PG8_LDA(At, 1, 1); PG8_STAGE(PG8_SB(1, 0), b3, voffB); PG8_STAGE(PG8_SB(1, 1), b3 + hstep, voffB); PG8_STAGE(PG8_SA(1, 0), a3, w0);
            PG8_WAIT_V(8); PG8_WAIT_L(0); PG8_BAR; PG8_MMA(1, 0, At, B0); PG8_MMA(1, 1, At, B1); PG8_BAR; PG8_SCHED;
        }
        if (wr == 0) PG8_BAR;
        E(acc, cur, wr, wc, fr, fq);
        if (!has_next) break;
#pragma unroll
        for (int a = 0; a < 2; ++a)
#pragma unroll
            for (int b = 0; b < 2; ++b)
#pragma unroll
                for (int m = 0; m < 4; ++m)
#pragma unroll
                    for (int n = 0; n < 2; ++n) acc[a][b][m][n] = (f32x4){0.f, 0.f, 0.f, 0.f};
        cur = nxt; cA = nA; cB = nB; ++ui;
        if constexpr (GATHER) { vA0[0] = nA0[0]; vA0[1] = nA0[1]; vA1[0] = nA1[0]; vA1[1] = nA1[1]; }
        if (wr == 1) PG8_BAR;
    }
    PG8_WAIT_V(0);
    PG8_BAR;
#undef PG8_GATHER
#undef PG8_SA
#undef PG8_SB
#undef PG8_STAGE
#undef PG8_LDA
#undef PG8_LDB
#undef PG8_MMA
#undef PG8_WAIT_V
#undef PG8_WAIT_L
#undef PG8_BAR
#undef PG8_SCHED
}
}

#define XB_TMO      128
#define XB_XCNT(j)  (256  + 64 * (j))
#define XB_XSUB(j)  (1280 + 64 * (j))
#define XB_XGEN(j)  (2304 + 64 * (j))
#define XB_TOP      3328
#define XB_TOPGEN   3392
#define XCD_BAR_WORDS 3456
#define XB_SPIN_CAP (1u << 22)
__device__ __forceinline__ unsigned xb_ld(unsigned* p)              { return __hip_atomic_load(p, __ATOMIC_RELAXED, __HIP_MEMORY_SCOPE_AGENT); }
__device__ __forceinline__ unsigned xb_add(unsigned* p, unsigned v) { return __hip_atomic_fetch_add(p, v, __ATOMIC_RELAXED, __HIP_MEMORY_SCOPE_AGENT); }
__device__ __forceinline__ unsigned xb_xcc_id() { return (unsigned)__builtin_amdgcn_s_getreg((3 << 11) | 20) & 0xFu; }
#define XB_SPIN(cond, bar) do { unsigned _sp = 0; while (cond) { __builtin_amdgcn_s_sleep(1); \
    if ((++_sp & 255u) == 0u) { if (xb_ld(&(bar)[XB_TMO])) break; if (_sp > XB_SPIN_CAP) { atomicAdd(&(bar)[XB_TMO], 1u); break; } } } } while (0)
struct XcdBarrier { unsigned* bar; unsigned x; volatile LAS unsigned* st; };
__device__ __forceinline__ XcdBarrier xcd_barrier_post(unsigned* bar, volatile LAS unsigned* st, int tid) {
    XcdBarrier b; b.bar = bar; b.x = xb_xcc_id(); b.st = st;
    if (tid == 0) (void)xb_add(&bar[XB_XCNT(b.x)], 1u);
    return b;
}
__device__ __forceinline__ void xcd_barrier_complete(unsigned* bar, unsigned x, unsigned& nloc, unsigned& nx) {
    const unsigned G = gridDim.x * gridDim.y * gridDim.z;
    unsigned sum, cnt, mine, sp = 0u;
    for (;;) {
        sum = 0u; cnt = 0u; mine = 0u;
#pragma unroll
        for (unsigned j = 0; j < 16; ++j) { const unsigned c = xb_ld(&bar[XB_XCNT(j)]); sum += c; cnt += (c > 0u) ? 1u : 0u; mine = (j == x) ? c : mine; }
        if (sum == G) break;
        __builtin_amdgcn_s_sleep(1);
        if ((++sp & 255u) == 0u) { if (xb_ld(&bar[XB_TMO])) break; if (sp > XB_SPIN_CAP) { atomicAdd(&bar[XB_TMO], 1u); break; } }
    }
    nloc = mine > 0u ? mine : 1u; nx = cnt > 0u ? cnt : 1u;
}
__device__ __forceinline__ void xcd_barrier(const XcdBarrier& b, int tid) {
    asm volatile("s_waitcnt vmcnt(0)" ::: "memory");
    __syncthreads();
    if (tid == 0) {
        unsigned* bar = b.bar;
        __builtin_amdgcn_s_waitcnt(0);
        unsigned nloc = b.st[0], nx = b.st[1];
        if (nloc == 0u) { xcd_barrier_complete(bar, b.x, nloc, nx); b.st[0] = nloc; b.st[1] = nx; }
        const unsigned old = xb_add(&bar[XB_XSUB(b.x)], 1u);
        const unsigned gen = old / nloc;
        if (old + 1u == (gen + 1u) * nloc) {
            __builtin_amdgcn_fence(__ATOMIC_RELEASE, "agent");
            asm volatile("s_waitcnt vmcnt(0)" ::: "memory");
            const unsigned og = xb_add(&bar[XB_TOP], 1u);
            const unsigned tg = og / nx;
            if (og + 1u == (tg + 1u) * nx) xb_add(&bar[XB_TOPGEN], 1u);
            else XB_SPIN(xb_ld(&bar[XB_TOPGEN]) == tg, bar);
            __builtin_amdgcn_fence(__ATOMIC_ACQUIRE, "agent");
            xb_add(&bar[XB_XGEN(b.x)], 1u);
            asm volatile("s_waitcnt vmcnt(0)" ::: "memory");
        } else {
            XB_SPIN(xb_ld(&bar[XB_XGEN(b.x)]) == gen, bar);
            __builtin_amdgcn_fence(__ATOMIC_ACQUIRE, "agent");
            asm volatile("s_waitcnt vmcnt(0)" ::: "memory");
        }
    }
    __syncthreads();
}

struct Frame {
    LAS unsigned char* lds;
    volatile LAS unsigned* MISC;
    unsigned* ctl;
    int tid, lane, wave, G, vcu, bx;
    unsigned char* ws;
    float* out;
};
#define INP(i) in_ptr<(i)>()
template <int I> __device__ __forceinline__ const float* in_ptr() {
    const float* p; auto ka = __builtin_amdgcn_kernarg_segment_ptr();
    asm volatile("s_load_dwordx2 %0, %1, %2\n\ts_waitcnt lgkmcnt(0)" : "=s"(p) : "s"(ka), "i"(I * 8) : "memory");
    return p;
}

__device__ __forceinline__ float wave_sum(float v) {
#pragma unroll
    for (int o = 1; o < 64; o <<= 1) v += __shfl_xor(v, o);
    return v;
}

using pg8::Unit;
struct EpiInProj {
    static constexpr bool PERM = true;
    bf16_t *H0, *Q, *Kb, *VT, *SG;
    __device__ __forceinline__ void operator()(const f32x4 (&acc)[2][2][4][2], const Unit& u, int wr, int wc, int fr, int fq) const {
        int r0 = wr * 64 + fr, c0 = wc * 32 + 8 * fq; asm volatile("" : "+v"(r0), "+v"(c0));
        if (u.ty == 0) {
#pragma unroll
            for (int ai = 0; ai < 2; ++ai)
#pragma unroll
                for (int m = 0; m < 4; ++m) { const size_t row = (size_t)u.pm * 256 + ai * 128 + m * 16 + r0;
                    f32x4 a0 = acc[ai][0][m][0], a1 = acc[ai][0][m][1], g0 = acc[ai][1][m][0], g1 = acc[ai][1][m][1];
                    u32x4 w; w.x = cvtpk(a0[0] * sigmoidf_(g0[0]), a0[1] * sigmoidf_(g0[1])); w.y = cvtpk(a0[2] * sigmoidf_(g0[2]), a0[3] * sigmoidf_(g0[3]));
                    w.z = cvtpk(a1[0] * sigmoidf_(g1[0]), a1[1] * sigmoidf_(g1[1])); w.w = cvtpk(a1[2] * sigmoidf_(g1[2]), a1[3] * sigmoidf_(g1[3]));
                    *(u32x4*)(H0 + row * 512 + u.pn * 128 + c0) = w; }
        } else if (u.ty == 3) {
            const int cpan = u.pn - 8;
#pragma unroll
            for (int ai = 0; ai < 2; ++ai)
#pragma unroll
                for (int m = 0; m < 4; ++m) { const size_t ch = (size_t)cpan * 256 + ai * 128 + m * 16 + r0;
#pragma unroll
                    for (int bj = 0; bj < 2; ++bj) { const f32x4 v0 = acc[ai][bj][m][0], v1 = acc[ai][bj][m][1];
                        u32x4 w; w.x = cvtpk(v0[0], v0[1]); w.y = cvtpk(v0[2], v0[3]); w.z = cvtpk(v1[0], v1[1]); w.w = cvtpk(v1[2], v1[3]);
                        *(u32x4*)(VT + ch * M + (size_t)u.pm * 256 + bj * 128 + c0) = w; } }
        } else if (u.ty == 4) {
            const int cb = (u.pn - 10) * 256;
#pragma unroll
            for (int ai = 0; ai < 2; ++ai)
#pragma unroll
                for (int m = 0; m < 4; ++m) { const size_t row = (size_t)u.pm * 256 + ai * 128 + m * 16 + r0;
#pragma unroll
                    for (int bj = 0; bj < 2; ++bj) { const f32x4 v0 = acc[ai][bj][m][0], v1 = acc[ai][bj][m][1];
                        u32x4 w; w.x = cvtpk(sigmoidf_(v0[0]), sigmoidf_(v0[1])); w.y = cvtpk(sigmoidf_(v0[2]), sigmoidf_(v0[3])); w.z = cvtpk(sigmoidf_(v1[0]), sigmoidf_(v1[1])); w.w = cvtpk(sigmoidf_(v1[2]), sigmoidf_(v1[3]));
                        *(u32x4*)(SG + row * 2048 + cb + bj * 128 + c0) = w; } }
        } else {
            bf16_t* base = (u.ty == 1) ? Q : Kb; const float sc = (u.ty == 1) ? QSCALE : 1.0f;
            const int cb = ((u.ty == 1) ? (u.pn - 4) : (u.pn - 6)) * 256;
#pragma unroll
            for (int ai = 0; ai < 2; ++ai)
#pragma unroll
                for (int m = 0; m < 4; ++m) { const size_t row = (size_t)u.pm * 256 + ai * 128 + m * 16 + r0;
#pragma unroll
                    for (int bj = 0; bj < 2; ++bj) { const f32x4 v0 = acc[ai][bj][m][0] * sc, v1 = acc[ai][bj][m][1] * sc;
                        u32x4 w; w.x = cvtpk(v0[0], v0[1]); w.y = cvtpk(v0[2], v0[3]); w.z = cvtpk(v1[0], v1[1]); w.w = cvtpk(v1[2], v1[3]);
                        *(u32x4*)(base + row * 512 + cb + bj * 128 + c0) = w; } }
        }
    }
};
template <int MODE> struct EpiBf16Row {
    static constexpr bool PERM = true;
    bf16_t* O; int ldo; const bf16_t* G; int ldg;
    __device__ __forceinline__ void operator()(const f32x4 (&acc)[2][2][4][2], const Unit& u, int wr, int wc, int fr, int fq) const {
        int r0 = wr * 64 + fr, c0 = u.pn * 256 + wc * 32 + 8 * fq; asm volatile("" : "+v"(r0), "+v"(c0));
#pragma unroll
        for (int ai = 0; ai < 2; ++ai)
#pragma unroll
            for (int m = 0; m < 4; ++m) { const size_t row = (size_t)u.pm * 256 + ai * 128 + m * 16 + r0;
#pragma unroll
                for (int bj = 0; bj < 2; ++bj) { f32x4 v0 = acc[ai][bj][m][0], v1 = acc[ai][bj][m][1];
                    bf16_t* op = O + row * ldo + c0 + bj * 128;
                    if (MODE == 0 || MODE == 1) { const u32x4 g = *(const u32x4*)(G + row * ldg + c0 + bj * 128);
                        v0[0] *= bf_lo(g.x); v0[1] *= bf_hi(g.x); v0[2] *= bf_lo(g.y); v0[3] *= bf_hi(g.y); v1[0] *= bf_lo(g.z); v1[1] *= bf_hi(g.z); v1[2] *= bf_lo(g.w); v1[3] *= bf_hi(g.w); }
                    if (MODE == 1) { const u32x4 o = *(const u32x4*)op;
                        v0[0] += bf_lo(o.x); v0[1] += bf_hi(o.x); v0[2] += bf_lo(o.y); v0[3] += bf_hi(o.y); v1[0] += bf_lo(o.z); v1[1] += bf_hi(o.z); v1[2] += bf_lo(o.w); v1[3] += bf_hi(o.w); }
                    if (MODE == 2) { for (int j = 0; j < 4; ++j) { v0[j] = sigmoidf_(v0[j]); v1[j] = sigmoidf_(v1[j]); } }
                    if (MODE == 3) { const u32x4 o = *(const u32x4*)op;
                        v0[0] *= bf_lo(o.x); v0[1] *= bf_hi(o.x); v0[2] *= bf_lo(o.y); v0[3] *= bf_hi(o.y); v1[0] *= bf_lo(o.z); v1[1] *= bf_hi(o.z); v1[2] *= bf_lo(o.w); v1[3] *= bf_hi(o.w); }
                    u32x4 w; w.x = cvtpk(v0[0], v0[1]); w.y = cvtpk(v0[2], v0[3]); w.z = cvtpk(v1[0], v1[1]); w.w = cvtpk(v1[2], v1[3]);
                    *(u32x4*)op = w; } }
    }
};
struct EpiSwiGLU {
    static constexpr bool PERM = true;
    bf16_t* H;
    __device__ __forceinline__ void operator()(const f32x4 (&acc)[2][2][4][2], const Unit& u, int wr, int wc, int fr, int fq) const {
        int r0 = wr * 64 + fr, c0 = u.pn * 128 + wc * 32 + 8 * fq; asm volatile("" : "+v"(r0), "+v"(c0));
#pragma unroll
        for (int ai = 0; ai < 2; ++ai)
#pragma unroll
            for (int m = 0; m < 4; ++m) { const size_t row = (size_t)u.pm * 256 + ai * 128 + m * 16 + r0;
                const f32x4 g0 = acc[ai][0][m][0], g1 = acc[ai][0][m][1], u0 = acc[ai][1][m][0], u1 = acc[ai][1][m][1];
                float h0[4], h1[4];
#pragma unroll
                for (int j = 0; j < 4; ++j) { h0[j] = g0[j] * sigmoidf_(g0[j]) * u0[j]; h1[j] = g1[j] * sigmoidf_(g1[j]) * u1[j]; }
                u32x4 w; w.x = cvtpk(h0[0], h0[1]); w.y = cvtpk(h0[2], h0[3]); w.z = cvtpk(h1[0], h1[1]); w.w = cvtpk(h1[2], h1[3]);
                *(u32x4*)(H + row * FF + c0) = w; }
    }
};
template <int MODE> struct EpiResF32 {
    static constexpr bool PERM = false;
    const float* X; float* Y; const bf16_t* P;
    __device__ __forceinline__ void operator()(const f32x4 (&acc)[2][2][4][2], const Unit& u, int wr, int wc, int fr, int fq) const {
        int r0 = wr * 64 + fr, c0 = u.pn * 256 + wc * 32 + 4 * fq; asm volatile("" : "+v"(r0), "+v"(c0));
#pragma unroll
        for (int ai = 0; ai < 2; ++ai)
#pragma unroll
            for (int m = 0; m < 4; ++m) { const size_t off = ((size_t)u.pm * 256 + ai * 128 + m * 16 + r0) * D + c0;
#pragma unroll
                for (int bj = 0; bj < 2; ++bj)
#pragma unroll
                    for (int n = 0; n < 2; ++n) { const size_t o = off + bj * 128 + n * 16;
                        f32x4 v = acc[ai][bj][m][n] + (*(const f32x4*)(X + o)) * ALPHA;
                        if (MODE == 1) { const u32x2 p = *(const u32x2*)(P + o); v[0] += bf_lo(p.x); v[1] += bf_hi(p.x); v[2] += bf_lo(p.y); v[3] += bf_hi(p.y); }
                        *(f32x4*)(Y + o) = v; } }
    }
};
struct EpiMoeDown {
    static constexpr bool PERM = true;
    bf16_t* Ys; const int* rdst; const float* rgate;
    __device__ __forceinline__ void operator()(const f32x4 (&acc)[2][2][4][2], const Unit& u, int wr, int wc, int fr, int fq) const {
        int r0 = wr * 64 + fr, c0 = u.pn * 256 + wc * 32 + 8 * fq; asm volatile("" : "+v"(r0), "+v"(c0));
#pragma unroll
        for (int ai = 0; ai < 2; ++ai)
#pragma unroll
            for (int m = 0; m < 4; ++m) { const int prow = u.pm * 256 + ai * 128 + m * 16 + r0; const int dst = rdst[prow]; const float gt = rgate[prow];
                if (dst >= 0) {
#pragma unroll
                    for (int bj = 0; bj < 2; ++bj) { const f32x4 v0 = acc[ai][bj][m][0] * gt, v1 = acc[ai][bj][m][1] * gt;
                        u32x4 w; w.x = cvtpk(v0[0], v0[1]); w.y = cvtpk(v0[2], v0[3]); w.z = cvtpk(v1[0], v1[1]); w.w = cvtpk(v1[2], v1[3]);
                        *(u32x4*)(Ys + (size_t)dst * D + c0 + bj * 128) = w; } } }
    }
};

struct SchedGrid {
    const char* A; const char* B; int nM, nN, G, c; size_t tstep;
    __device__ __forceinline__ bool next(int i, Unit& u) const { int pm, pn; if (!pg8::static_order(i, G, c, nM, nN, pm, pn)) return false; u.pm = pm; u.pn = pn; u.ty = 0; u.a = A + (size_t)pm * tstep; u.b = B + (size_t)pn * tstep; return true; }
};
struct SchedInProj {
    const char* X; const char* W; int G, c; size_t tstep;
    __device__ __forceinline__ bool next(int i, Unit& u) const { int pm, pn; if (!pg8::static_order(i, G, c, M / 256, 18, pm, pn)) return false; u.pm = pm; u.pn = pn;
        u.ty = pn < 4 ? 0 : pn < 6 ? 1 : pn < 8 ? 2 : pn < 10 ? 3 : 4;
        const char* xp = X + (size_t)pm * tstep; const char* wp = W + (size_t)pn * tstep;
        if (u.ty == 3) { u.a = wp; u.b = xp; } else { u.a = xp; u.b = wp; } return true; }
};
struct SchedMoe {
    const char* A; const char* B; int npan, nN, G, c; size_t tstepA, tstepB; int pstart[NE + 1]; bool gather;
    __device__ __forceinline__ bool next(int i, Unit& u) const { int pm, pn; if (!pg8::static_order(i, G, c, npan, nN, pm, pn)) return false; u.pm = pm; u.pn = pn; u.ty = 0;
        int e = 0;
#pragma unroll
        for (int j = 1; j < NE; ++j) e += (pm >= pstart[j]) ? 1 : 0;
        u.a = gather ? A : A + (size_t)pm * tstepA; u.b = B + ((size_t)e * nN + pn) * tstepB; return true; }
};

__device__ __forceinline__ void tr_item(const float* W, int ldw, int k0, int c0, bf16_t* WT, int K, int nrow0, LAS float* scr, int lane) {
#pragma unroll 8
    for (int i = 0; i < 32; ++i) { const int kk = 2 * i + (lane >> 5); scr[kk * 33 + (lane & 31)] = W[(size_t)(k0 + kk) * ldw + c0 + (lane & 31)]; }
    LDS_WAIT(); asm volatile("" ::: "memory");
    const int c = lane & 7;
#pragma unroll
    for (int j = 0; j < 4; ++j) { const int n = (lane >> 3) + 8 * j; const LAS float* s = scr + (8 * c) * 33 + n;
        u32x4 o; o.x = cvtpk(s[0 * 33], s[1 * 33]); o.y = cvtpk(s[2 * 33], s[3 * 33]); o.z = cvtpk(s[4 * 33], s[5 * 33]); o.w = cvtpk(s[6 * 33], s[7 * 33]);
        *(u32x4*)(WT + (size_t)(nrow0 + n) * K + k0 + 8 * c) = o; }
    LDS_WAIT(); asm volatile("" ::: "memory");
}
struct Job { const float* s0; const float* s1; bf16_t* dst; int ld, K, N, fam; };
__device__ __forceinline__ void run_job(Frame& F, const Job& jb, int rot) {
    LAS float* scr = (LAS float*)(F.lds + F.wave * 16384);
    const int NGW = F.G * NWAVES; int gw = (F.vcu * NWAVES + F.wave + rot) % NGW;
    const int nblk = jb.N / 32, nitems = (jb.K / 64) * nblk;
    for (int it = gw; it < nitems; it += NGW) {
        const int kb = it / nblk, nb = it - kb * nblk, n0 = nb * 32, k0 = kb * 64;
        const float* src = jb.s0; int c0 = n0;
        if (jb.fam == 0) { if (n0 < 1024) { const int t = n0 >> 8, w = n0 & 255; c0 = (w < 128) ? 128 * t + w : 512 + 128 * t + (w - 128); } }
        else if (jb.fam == 2) { const int t = n0 >> 8, w = n0 & 255; src = (w < 128) ? jb.s0 : jb.s1; c0 = 128 * t + (w & 127); }
        tr_item(src, jb.ld, k0, c0, jb.dst, jb.K, n0, scr, F.lane);
    }
}
__device__ __forceinline__ Job base_job(Frame& F, int j) {
    Job jb; jb.s1 = nullptr; jb.fam = 1;
    if (j < 24) { const int l = j / 6, k = j - l * 6;
        if (k == 0)      { jb.s0 = INP(3) + (size_t)l * D * NIN;  jb.ld = NIN; jb.K = D;    jb.N = NIN; jb.dst = (bf16_t*)(F.ws + WS_WIN + l * SZ_WIN); jb.fam = 0; }
        else if (k == 1) { jb.s0 = INP(8) + (size_t)l * CW * D;   jb.ld = D;   jb.K = CW;   jb.N = D;   jb.dst = (bf16_t*)(F.ws + WS_WC + l * SZ_WC); }
        else if (k == 2) { jb.s0 = INP(9) + (size_t)l * AW * D;   jb.ld = D;   jb.K = AW;   jb.N = D;   jb.dst = (bf16_t*)(F.ws + WS_WA + l * SZ_WA); }
        else if (k == 3) { jb.s0 = INP(10) + (size_t)l * D * D;   jb.ld = D;   jb.K = D;    jb.N = D;   jb.dst = (bf16_t*)(F.ws + WS_WOUT + l * SZ_WOUT); }
        else if (k == 4) { jb.s0 = INP(13) + (size_t)l * D * D;   jb.ld = D;   jb.K = D;    jb.N = D;   jb.dst = (bf16_t*)(F.ws + WS_WPG + l * SZ_WPG); }
        else             { jb.s0 = INP(14) + (size_t)l * PLED * D; jb.ld = D;  jb.K = PLED; jb.N = D;   jb.dst = (bf16_t*)(F.ws + WS_WPP + l * SZ_WPP); }
    } else { const int i = (j - 24) >> 1, k = (j - 24) & 1;
        if (k == 0) { jb.s0 = INP(17) + (size_t)i * D * FF; jb.s1 = INP(18) + (size_t)i * D * FF; jb.ld = FF; jb.K = D; jb.N = 2 * FF; jb.dst = (bf16_t*)(F.ws + WS_WGU + i * SZ_WGU); jb.fam = 2; }
        else        { jb.s0 = INP(19) + (size_t)i * FF * D; jb.ld = D; jb.K = FF; jb.N = D; jb.dst = (bf16_t*)(F.ws + WS_WD + i * SZ_WD); }
    }
    return jb;
}
__device__ __forceinline__ Job expert_job(Frame& F, int mi, int j) {
    Job jb; const int e = j >> 1, k = j & 1; const size_t eo = (size_t)(mi * NE + e) * D * FF;
    if (k == 0) { jb.s0 = INP(21) + eo; jb.s1 = INP(22) + eo; jb.ld = FF; jb.K = D; jb.N = 2 * FF; jb.dst = (bf16_t*)(F.ws + WS_EWGU + e * SZ_WGU); jb.fam = 2; }
    else        { jb.s0 = INP(23) + eo; jb.s1 = nullptr;       jb.ld = D;  jb.K = FF; jb.N = D;     jb.dst = (bf16_t*)(F.ws + WS_EWD + e * SZ_WD);   jb.fam = 1; }
    return jb;
}
__device__ __forceinline__ void cvt_rows(Frame& F, const float* src, bf16_t* dst, size_t n) {
    const size_t nch = n / 8, stride = (size_t)F.G * NTHR;
    for (size_t i = (size_t)F.vcu * NTHR + F.tid; i < nch; i += stride) { const f32x4 a = *(const f32x4*)(src + i * 8), b = *(const f32x4*)(src + i * 8 + 4);
        u32x4 w; w.x = cvtpk(a[0], a[1]); w.y = cvtpk(a[2], a[3]); w.z = cvtpk(b[0], b[1]); w.w = cvtpk(b[2], b[3]); *(u32x4*)(dst + i * 8) = w; }
}
__device__ __forceinline__ void prologue_phase(Frame& F) {
    for (int j = 0; j < 28; ++j) { const Job jb = base_job(F, j); run_job(F, jb, (j * 397) & 2047); }
    for (int j = 0; j < 16; ++j) { const Job jb = expert_job(F, 0, j); run_job(F, jb, (j * 397 + 100) & 2047); }
    cvt_rows(F, INP(0), (bf16_t*)(F.ws + WS_XB), (size_t)M * D);
}

__device__ __forceinline__ void thin_phase(Frame& F, int l) {
    const int tid = F.tid, lane = F.lane, wave = F.wave;
    {   const bf16_t* Kb = (const bf16_t*)(F.ws + WS_K); float* KM = (float*)(F.ws + WS_KM); LAS float* ps = (LAS float*)F.lds;
        for (int u = F.vcu; u < M / 256; u += F.G) {
            float s[8] = {0.f, 0.f, 0.f, 0.f, 0.f, 0.f, 0.f, 0.f};
#pragma unroll 4
            for (int i = 0; i < 32; ++i) { const u32x4 v = *(const u32x4*)(Kb + ((size_t)u * 256 + wave + 8 * i) * 512 + lane * 8);
                s[0] += bf_lo(v.x); s[1] += bf_hi(v.x); s[2] += bf_lo(v.y); s[3] += bf_hi(v.y); s[4] += bf_lo(v.z); s[5] += bf_hi(v.z); s[6] += bf_lo(v.w); s[7] += bf_hi(v.w); }
            __syncthreads();
#pragma unroll
            for (int j = 0; j < 8; ++j) ps[wave * 512 + lane * 8 + j] = s[j];
            __syncthreads();
            float t = 0.f;
#pragma unroll
            for (int w = 0; w < 8; ++w) t += ps[w * 512 + tid];
            KM[(size_t)u * 512 + tid] = t * (1.0f / 256.0f);
        }
        __syncthreads();
    }
    {   const bf16_t* H0 = (const bf16_t*)(F.ws + WS_H0); bf16_t* HC = (bf16_t*)(F.ws + WS_HC);
        LAS float* wl = (LAS float*)F.lds; LAS bf16_t* xt = (LAS bf16_t*)(F.lds + 63488);
        const float* cw = INP(4) + (size_t)l * CKW * CW;
        for (int i = tid; i < CKW * CW / 4; i += NTHR) ((LAS f32x4*)wl)[i] = ((const f32x4*)cw)[i];
        const f32x4 cb0 = *(const f32x4*)(INP(5) + l * CW + lane * 8), cb1 = *(const f32x4*)(INP(5) + l * CW + lane * 8 + 4);
        const f32x4 lg0 = *(const f32x4*)(INP(6) + l * CW + lane * 8), lg1 = *(const f32x4*)(INP(6) + l * CW + lane * 8 + 4);
        const f32x4 lb0 = *(const f32x4*)(INP(7) + l * CW + lane * 8), lb1 = *(const f32x4*)(INP(7) + l * CW + lane * 8 + 4);
        for (int u = F.vcu; u < BATCH * (SEQ / 32); u += F.G) {
            const int b = u / (SEQ / 32), t0 = (u % (SEQ / 32)) * 32;
            __syncthreads();
            for (int i = tid; i < 62 * 64; i += NTHR) { const int row = i >> 6, ch = i & 63, t = t0 - 30 + row; u32x4 v = {0u, 0u, 0u, 0u};
                if (t >= 0) v = *(const u32x4*)(H0 + ((size_t)(b * SEQ + t)) * 512 + ch * 8);
                *(LAS u32x4*)(xt + row * 512 + ch * 8) = v; }
            __syncthreads();
            float acc[4][8];
#pragma unroll
            for (int tt = 0; tt < 4; ++tt)
#pragma unroll
                for (int c = 0; c < 8; ++c) acc[tt][c] = 0.f;
#pragma unroll 1
            for (int j = 0; j < CKW; ++j) {
                const f32x4 w0 = *(const LAS f32x4*)(wl + j * 512 + lane * 8), w1 = *(const LAS f32x4*)(wl + j * 512 + lane * 8 + 4);
#pragma unroll
                for (int tt = 0; tt < 4; ++tt) { const u32x4 xv = *(const LAS u32x4*)(xt + (wave * 4 + tt + j) * 512 + lane * 8);
                    acc[tt][0] += w0[0] * bf_lo(xv.x); acc[tt][1] += w0[1] * bf_hi(xv.x); acc[tt][2] += w0[2] * bf_lo(xv.y); acc[tt][3] += w0[3] * bf_hi(xv.y);
                    acc[tt][4] += w1[0] * bf_lo(xv.z); acc[tt][5] += w1[1] * bf_hi(xv.z); acc[tt][6] += w1[2] * bf_lo(xv.w); acc[tt][7] += w1[3] * bf_hi(xv.w); }
            }
#pragma unroll
            for (int tt = 0; tt < 4; ++tt) {
                float v[8]; float s = 0.f;
#pragma unroll
                for (int c = 0; c < 8; ++c) { v[c] = acc[tt][c] + (c < 4 ? cb0[c] : cb1[c - 4]); s += v[c]; }
                const float mean = wave_sum(s) * (1.0f / CW); float q = 0.f;
#pragma unroll
                for (int c = 0; c < 8; ++c) { v[c] -= mean; q += v[c] * v[c]; }
                const float rstd = 1.0f / sqrtf(wave_sum(q) * (1.0f / CW) + LN_EPS);
#pragma unroll
                for (int c = 0; c < 8; ++c) { const float y = v[c] * rstd * (c < 4 ? lg0[c] : lg1[c - 4]) + (c < 4 ? lb0[c] : lb1[c - 4]); v[c] = y * sigmoidf_(y); }
                u32x4 w; w.x = cvtpk(v[0], v[1]); w.y = cvtpk(v[2], v[3]); w.z = cvtpk(v[4], v[5]); w.w = cvtpk(v[6], v[7]);
                *(u32x4*)(HC + ((size_t)(b * SEQ + t0 + wave * 4 + tt)) * 512 + lane * 8) = w;
            }
        }
        __syncthreads();
    }
    cvt_rows(F, INP(1) + (size_t)l * M * PLED, (bf16_t*)(F.ws + WS_PB), (size_t)M * PLED);
    if (l == 2) { for (int j = 0; j < 16; ++j) { const Job jb = expert_job(F, 1, j); run_job(F, jb, (j * 397) & 2047); } }
}

template <int MODE> __device__ __forceinline__ void ln_phase(Frame& F, int l) {
    const int tid = F.tid, lane = F.lane, wave = F.wave; const bool moe = (l & 1) != 0; const int mi = l >> 1;
    float* YB = (float*)(F.ws + WS_YB); bf16_t* XB = (bf16_t*)(F.ws + WS_XB);
    const float* gp = (MODE == 1 ? INP(11) : INP(15)) + l * D; const float* bp = (MODE == 1 ? INP(12) : INP(16)) + l * D;
    f32x4 g[4], bb[4];
#pragma unroll
    for (int j = 0; j < 4; ++j) { g[j] = *(const f32x4*)(gp + 4 * lane + 256 * j); bb[j] = *(const f32x4*)(bp + 4 * lane + 256 * j); }
    LAS float* wr = (LAS float*)F.lds;
    LAS float* rt = (LAS float*)(F.lds + 32768);
    LAS int* lcnt = (LAS int*)(F.lds + 32768 + 2048);
    LAS int* lrk = (LAS int*)(F.lds + 32768 + 2048 + 64);
    if (MODE == 1 && moe) { const float* rw = INP(20) + (size_t)mi * D * NE; for (int i = tid; i < D * NE / 4; i += NTHR) ((LAS f32x4*)wr)[i] = ((const f32x4*)rw)[i]; if (tid < 8) lcnt[tid] = 0; __syncthreads(); }
    for (int c = F.vcu; c < M / 128; c += F.G) {
        for (int i = 0; i < 16; ++i) {
            const int rl = wave + 8 * i; const size_t row = (size_t)c * 128 + rl;
            f32x4 v[4]; float s = 0.f;
#pragma unroll
            for (int j = 0; j < 4; ++j) v[j] = *(const f32x4*)(YB + row * D + 4 * lane + 256 * j);
            if (MODE == 2 && moe) {
                const bf16_t* P = (const bf16_t*)(F.ws + WS_PLE); const bf16_t* Ys = (const bf16_t*)F.out;
#pragma unroll
                for (int j = 0; j < 4; ++j) { const u32x2 p = *(const u32x2*)(P + row * D + 4 * lane + 256 * j);
                    const u32x2 y0 = *(const u32x2*)(Ys + (2 * row) * D + 4 * lane + 256 * j), y1 = *(const u32x2*)(Ys + (2 * row + 1) * D + 4 * lane + 256 * j);
                    v[j][0] = v[j][0] * ALPHA + bf_lo(p.x) + bf_lo(y0.x) + bf_lo(y1.x); v[j][1] = v[j][1] * ALPHA + bf_hi(p.x) + bf_hi(y0.x) + bf_hi(y1.x);
                    v[j][2] = v[j][2] * ALPHA + bf_lo(p.y) + bf_lo(y0.y) + bf_lo(y1.y); v[j][3] = v[j][3] * ALPHA + bf_hi(p.y) + bf_hi(y0.y) + bf_hi(y1.y); }
                asm volatile("s_waitcnt vmcnt(0)" ::: "memory");
            }
#pragma unroll
            for (int j = 0; j < 4; ++j) s += (v[j][0] + v[j][1]) + (v[j][2] + v[j][3]);
            const float mean = wave_sum(s) * (1.0f / D); float q = 0.f;
#pragma unroll
            for (int j = 0; j < 4; ++j) { v[j] = v[j] - mean; q += (v[j][0] * v[j][0] + v[j][1] * v[j][1]) + (v[j][2] * v[j][2] + v[j][3] * v[j][3]); }
            const float rstd = 1.0f / sqrtf(wave_sum(q) * (1.0f / D) + LN_EPS);
            float* of = (MODE == 1) ? YB : F.out;
#pragma unroll
            for (int j = 0; j < 4; ++j) { v[j] = v[j] * rstd * g[j] + bb[j]; *(f32x4*)(of + row * D + 4 * lane + 256 * j) = v[j];
                u32x2 w; w.x = cvtpk(v[j][0], v[j][1]); w.y = cvtpk(v[j][2], v[j][3]); *(u32x2*)(XB + row * D + 4 * lane + 256 * j) = w; }
            if (MODE == 1 && moe) {
                float lg[NE];
#pragma unroll
                for (int e = 0; e < NE; ++e) lg[e] = 0.f;
#pragma unroll
                for (int j = 0; j < 4; ++j)
#pragma unroll
                    for (int k = 0; k < 4; ++k) { const int kk = 4 * lane + 256 * j + k; const f32x4 w0 = *(const LAS f32x4*)(wr + kk * 8), w1 = *(const LAS f32x4*)(wr + kk * 8 + 4); const float xv = v[j][k];
                        lg[0] += xv * w0[0]; lg[1] += xv * w0[1]; lg[2] += xv * w0[2]; lg[3] += xv * w0[3]; lg[4] += xv * w1[0]; lg[5] += xv * w1[1]; lg[6] += xv * w1[2]; lg[7] += xv * w1[3]; }
#pragma unroll
                for (int e = 0; e < NE; ++e) lg[e] = wave_sum(lg[e]);
                float b1 = lg[0]; int i1 = 0;
#pragma unroll
                for (int e = 1; e < NE; ++e) if (lg[e] > b1) { b1 = lg[e]; i1 = e; }
                float b2 = -INFINITY; int i2 = 0;
#pragma unroll
                for (int e = 0; e < NE; ++e) if (e != i1 && lg[e] > b2) { b2 = lg[e]; i2 = e; }
                const float p1 = 1.0f / (1.0f + __expf(b2 - b1));
                if (lane == 0) { rt[rl * 4 + 0] = __int_as_float(i1); rt[rl * 4 + 1] = __int_as_float(i2); rt[rl * 4 + 2] = p1; rt[rl * 4 + 3] = 1.0f - p1; }
            }
        }
        if (MODE == 1 && moe) {
            __syncthreads();
            int e1 = 0, e2 = 0;
            if (tid < 128) { e1 = __float_as_int(rt[tid * 4 + 0]); e2 = __float_as_int(rt[tid * 4 + 1]); lrk[tid * 2 + 0] = atomicAdd((int*)&lcnt[e1], 1); lrk[tid * 2 + 1] = atomicAdd((int*)&lcnt[e2], 1); }
            __syncthreads();
            if (tid < 8) { const int n = lcnt[tid]; lcnt[8 + tid] = (int)__hip_atomic_fetch_add(F.ctl + CW_GCNT + (mi * NE + tid) * 64, (unsigned)n, RLX_AGENT); }
            __syncthreads();
            if (tid < 128) { int* ro = (int*)(F.ws + WS_ROUTE) + ((size_t)c * 128 + tid) * 8;
                ro[0] = e1; ro[1] = e2; ro[2] = lcnt[8 + e1] + lrk[tid * 2 + 0]; ro[3] = lcnt[8 + e2] + lrk[tid * 2 + 1]; ((float*)ro)[4] = rt[tid * 4 + 2]; ((float*)ro)[5] = rt[tid * 4 + 3]; }
            __syncthreads();
            if (tid < 8) lcnt[tid] = 0;
            __syncthreads();
        }
    }
}
__device__ __forceinline__ void moe_starts(Frame& F, int mi, int (&pstart)[NE + 1]) {
    int acc = 0;
#pragma unroll
    for (int e = 0; e < NE; ++e) { pstart[e] = acc; const int n = (int)__hip_atomic_load(F.ctl + CW_GCNT + (mi * NE + e) * 64, RLX_AGENT); acc += (n + 255) >> 8; }
    pstart[NE] = acc;
}
__device__ __forceinline__ void route_build(Frame& F, int mi) {
    int pstart[NE + 1]; moe_starts(F, mi, pstart);
    int* rtok = (int*)(F.ws + WS_RTOK); int* rdst = (int*)(F.ws + WS_RDST); float* rgate = (float*)(F.ws + WS_RGATE);
    for (int t = F.vcu * NTHR + F.tid; t < M; t += F.G * NTHR) { const int* ro = (const int*)(F.ws + WS_ROUTE) + (size_t)t * 8;
        int e1 = ro[0], e2 = ro[1], r1 = ro[2], r2 = ro[3]; const float p1 = ((const float*)ro)[4], p2 = ((const float*)ro)[5];
        int s1 = 0, s2 = 0;
#pragma unroll
        for (int e = 0; e < NE; ++e) { s1 = (e == e1) ? pstart[e] : s1; s2 = (e == e2) ? pstart[e] : s2; }
        const int q1 = s1 * 256 + r1, q2 = s2 * 256 + r2;
        rtok[q1] = t; rdst[q1] = 2 * t; rgate[q1] = p1; rtok[q2] = t; rdst[q2] = 2 * t + 1; rgate[q2] = p2; }
    if (F.vcu < NE) { const int e = F.vcu; const int n = (int)__hip_atomic_load(F.ctl + CW_GCNT + (mi * NE + e) * 64, RLX_AGENT);
        for (int q = pstart[e] * 256 + n + F.tid; q < pstart[e + 1] * 256; q += NTHR) { rtok[q] = 0; rdst[q] = -1; rgate[q] = 0.f; } }
}

__device__ __forceinline__ int crow(int r, int hi) { return (r & 3) + 8 * (r >> 2) + 4 * hi; }
__device__ __forceinline__ float pl32_max(float m) { auto rr = __builtin_amdgcn_permlane32_swap(__float_as_uint(m), __float_as_uint(m), false, false); return fmaxf(__uint_as_float(rr[0]), __uint_as_float(rr[1])); }
__device__ __forceinline__ float pl32_sum(float m) { auto rr = __builtin_amdgcn_permlane32_swap(__float_as_uint(m), __float_as_uint(m), false, false); return __uint_as_float(rr[0]) + __uint_as_float(rr[1]); }
__device__ __forceinline__ int rel_bucket_dev(int n) {
    if (n < 16) return n;
    const int large = 16 + (int)(__log2f((float)n * (1.0f / 16.0f)) * (16.0f / 3.0f));
    return large < 31 ? large : 31;
}
constexpr int AT_KS = 0, AT_KROW = 144, AT_KBUF = 64 * AT_KROW;
constexpr int AT_VS = 2 * AT_KBUF, AT_VROW = 136, AT_VBUF = 64 * AT_VROW;
constexpr int AT_LUT = AT_VS + 2 * AT_VBUF, AT_WSF = AT_LUT + 512, AT_END = AT_WSF + NWAVES * 256;
__device__ __forceinline__ void attn_phase(Frame& F) {
    const int tid = F.tid, lane = F.lane, wid = F.wave, r = lane & 31, hh = lane >> 5;
    const bf16_t* Q = (const bf16_t*)(F.ws + WS_Q); const bf16_t* Kb = (const bf16_t*)(F.ws + WS_K); const bf16_t* VT = (const bf16_t*)(F.ws + WS_VT);
    const float* KM = (const float*)(F.ws + WS_KM); bf16_t* HA = (bf16_t*)(F.ws + WS_HA); const float* rel_bias = INP(2);
    LAS unsigned char* L = F.lds; LAS float* lut = (LAS float*)(L + AT_LUT); LAS float* wsf = (LAS float*)(L + AT_WSF) + wid * 64;
    const int lrow = tid >> 3, lch = tid & 7;
    for (int n = F.vcu; n < BATCH * NH * NBLK; n += F.G) {
        const int ii = n >> 8, w = n & 255, bh = w >> 2, s4 = w & 3; const int qb = (ii == 0) ? s4 : (ii == 1) ? 7 - s4 : (ii == 2) ? 8 + s4 : 15 - s4;
        const int b = bh >> 3, h = bh & 7;
        const int q0 = qb * 256 + wid * 32;
        const bf16_t* Kh = Kb + (size_t)b * SEQ * 512 + h * 64; const bf16_t* Vh = VT + (size_t)(h * 64) * M + (size_t)b * SEQ;
#define AT_LOAD(i, kreg, vreg) do { const int kp_ = ((i) < 4) ? qb * 256 + (i) * 64 : ((i) - 4) * 64; \
            kreg = *(const u32x4*)(Kh + (size_t)(kp_ + lrow) * 512 + lch * 8); vreg = *(const u32x4*)(Vh + (size_t)lrow * M + kp_ + lch * 8); } while (0)
#define AT_STORE(buf, kreg, vreg) do { *(LAS u32x4*)(L + AT_KS + (buf) * AT_KBUF + lrow * AT_KROW + lch * 16) = kreg; \
            *(LAS u32x2*)(L + AT_VS + (buf) * AT_VBUF + lrow * AT_VROW + lch * 16) = (u32x2){vreg.x, vreg.y}; *(LAS u32x2*)(L + AT_VS + (buf) * AT_VBUF + lrow * AT_VROW + lch * 16 + 8) = (u32x2){vreg.z, vreg.w}; } while (0)
        u32x4 kreg, vreg;
        AT_LOAD(0, kreg, vreg);
        bf16x8 qf[4];
#pragma unroll
        for (int d0 = 0; d0 < 4; ++d0) qf[d0] = *(const bf16x8*)(Q + ((size_t)(b * SEQ + q0 + r)) * 512 + h * 64 + d0 * 16 + hh * 8);
        unsigned selmask = 0u;
        if (qb > 0) {
            f32x16 sc;
#pragma unroll
            for (int i = 0; i < 16; ++i) sc[i] = 0.f;
#pragma unroll
            for (int d0 = 0; d0 < 4; ++d0) {
                f32x4 k0 = {0.f, 0.f, 0.f, 0.f}, k1 = {0.f, 0.f, 0.f, 0.f};
                if (r < 16) { const float* kp = KM + ((size_t)(b * NBLK + r)) * 512 + h * 64 + d0 * 16 + hh * 8; k0 = *(const f32x4*)kp; k1 = *(const f32x4*)(kp + 4); }
                u32x4 hi4, lo4;
                hi4.x = cvtpk(k0[0], k0[1]); hi4.y = cvtpk(k0[2], k0[3]); hi4.z = cvtpk(k1[0], k1[1]); hi4.w = cvtpk(k1[2], k1[3]);
                lo4.x = cvtpk(k0[0] - bf_lo(hi4.x), k0[1] - bf_hi(hi4.x)); lo4.y = cvtpk(k0[2] - bf_lo(hi4.y), k0[3] - bf_hi(hi4.y));
                lo4.z = cvtpk(k1[0] - bf_lo(hi4.z), k1[1] - bf_hi(hi4.z)); lo4.w = cvtpk(k1[2] - bf_lo(hi4.w), k1[3] - bf_hi(hi4.w));
                sc = __builtin_amdgcn_mfma_f32_32x32x16_bf16(__builtin_bit_cast(bf16x8, hi4), qf[d0], sc, 0, 0, 0);
                sc = __builtin_amdgcn_mfma_f32_32x32x16_bf16(__builtin_bit_cast(bf16x8, lo4), qf[d0], sc, 0, 0, 0);
            }
            float full[16];
#pragma unroll
            for (int g = 0; g < 8; ++g) { const float mine = sc[g], other = __shfl_xor(mine, 32);
                full[crow(g, 0)] = hh ? other : mine; full[crow(g, 1)] = hh ? mine : other; }
#pragma unroll
            for (int p = 0; p < 3; ++p) { float best = -INFINITY; int bi = -1;
#pragma unroll
                for (int j = 0; j < 16; ++j) { const bool ok = (j < qb) && !((selmask >> j) & 1u) && (full[j] > best); best = ok ? full[j] : best; bi = ok ? j : bi; }
                if (bi >= 0) selmask |= 1u << bi; }
        }
        float m_run = -INFINITY, l_run = 0.f; f32x16 o0, o1;
#pragma unroll
        for (int i = 0; i < 16; ++i) { o0[i] = 0.f; o1[i] = 0.f; }
        __syncthreads();
        if (tid < 128) lut[tid] = rel_bias[rel_bucket_dev(tid) * NH + h] * LOG2E;
        AT_STORE(0, kreg, vreg);
        __syncthreads();
        const int NT = 4 * (qb + 1);
        for (int i = 0; i < NT; ++i) {
            if (i + 1 < NT) AT_LOAD(i + 1, kreg, vreg);
            const int buf = i & 1; const bool own = i < 4; const int kp0 = own ? qb * 256 + i * 64 : (i - 4) * 64; const int jblk = (i - 4) >> 2;
            const bool sel = own ? true : (((selmask >> jblk) & 1u) != 0u);
            const bool skip = own ? (i * 64 > wid * 32 + 31) : !__any(sel);
            if (!skip) {
                f32x16 p0, p1;
#pragma unroll
                for (int x = 0; x < 16; ++x) { p0[x] = 0.f; p1[x] = 0.f; }
                const LAS unsigned char* kb = L + AT_KS + buf * AT_KBUF + r * AT_KROW + hh * 16;
#pragma unroll
                for (int d0 = 0; d0 < 4; ++d0) {
                    const bf16x8 a0 = *(const LAS bf16x8*)(kb + d0 * 32), a1 = *(const LAS bf16x8*)(kb + 32 * AT_KROW + d0 * 32);
                    p0 = __builtin_amdgcn_mfma_f32_32x32x16_bf16(a0, qf[d0], p0, 0, 0, 0);
                    p1 = __builtin_amdgcn_mfma_f32_32x32x16_bf16(a1, qf[d0], p1, 0, 0, 0);
                }
                const int qpos = q0 + r;
                if (own || (q0 - (kp0 + 63) < 113)) {
#pragma unroll
                    for (int x = 0; x < 16; ++x) { const int d0_ = qpos - (kp0 + crow(x, hh)), d1_ = d0_ - 32;
                        const float b0 = lut[d0_ < 0 ? 0 : (d0_ > 127 ? 127 : d0_)], b1 = lut[d1_ < 0 ? 0 : (d1_ > 127 ? 127 : d1_)];
                        p0[x] = (d0_ < 0) ? -INFINITY : p0[x] + b0; p1[x] = (d1_ < 0) ? -INFINITY : p1[x] + b1; }
                } else { const float bc = lut[127];
#pragma unroll
                    for (int x = 0; x < 16; ++x) { p0[x] += bc; p1[x] += bc; } }
                if (!sel) {
#pragma unroll
                    for (int x = 0; x < 16; ++x) { p0[x] = -INFINITY; p1[x] = -INFINITY; } }
                float mt = fmaxf(p0[0], p1[0]);
#pragma unroll
                for (int x = 1; x < 16; ++x) mt = fmaxf(mt, fmaxf(p0[x], p1[x]));
                mt = pl32_max(mt);
                const float m_new = fmaxf(m_run, mt);
                if (__any(m_new > m_run)) {
                    const float alpha = (m_new > m_run) ? __builtin_amdgcn_exp2f(m_run - m_new) : 1.0f;
                    l_run *= alpha;
                    if (hh == 0) wsf[r] = alpha;
#pragma unroll
                    for (int x = 0; x < 16; ++x) { const float a = wsf[crow(x, hh)]; o0[x] *= a; o1[x] *= a; }
                    m_run = m_new;
                }
                float ls = 0.f;
#pragma unroll
                for (int x = 0; x < 16; ++x) { p0[x] = __builtin_amdgcn_exp2f(p0[x] - m_run); p1[x] = __builtin_amdgcn_exp2f(p1[x] - m_run); ls += p0[x] + p1[x]; }
                l_run += ls;
                const LAS unsigned char* vb = L + AT_VS + buf * AT_VBUF + r * AT_VROW + hh * 8;
#pragma unroll
                for (int kh = 0; kh < 2; ++kh)
#pragma unroll
                    for (int s = 0; s < 2; ++s) {
                        u32x4 pa;
                        if (kh == 0) { pa.x = cvtpk(p0[8 * s + 0], p0[8 * s + 1]); pa.y = cvtpk(p0[8 * s + 2], p0[8 * s + 3]); pa.z = cvtpk(p0[8 * s + 4], p0[8 * s + 5]); pa.w = cvtpk(p0[8 * s + 6], p0[8 * s + 7]); }
                        else         { pa.x = cvtpk(p1[8 * s + 0], p1[8 * s + 1]); pa.y = cvtpk(p1[8 * s + 2], p1[8 * s + 3]); pa.z = cvtpk(p1[8 * s + 4], p1[8 * s + 5]); pa.w = cvtpk(p1[8 * s + 6], p1[8 * s + 7]); }
                        const int ko = (32 * kh + 16 * s) * 2;
                        const u32x2 va0 = *(const LAS u32x2*)(vb + ko), va1 = *(const LAS u32x2*)(vb + ko + 16);
                        const u32x2 vb0 = *(const LAS u32x2*)(vb + 32 * AT_VROW + ko), vb1 = *(const LAS u32x2*)(vb + 32 * AT_VROW + ko + 16);
                        const u32x4 fa = {va0.x, va0.y, va1.x, va1.y}, fb = {vb0.x, vb0.y, vb1.x, vb1.y};
                        o0 = __builtin_amdgcn_mfma_f32_32x32x16_bf16(__builtin_bit_cast(bf16x8, pa), __builtin_bit_cast(bf16x8, fa), o0, 0, 0, 0);
                        o1 = __builtin_amdgcn_mfma_f32_32x32x16_bf16(__builtin_bit_cast(bf16x8, pa), __builtin_bit_cast(bf16x8, fb), o1, 0, 0, 0);
                    }
            }
            if (i + 1 < NT) AT_STORE((i + 1) & 1, kreg, vreg);
            __syncthreads();
        }
        const float lt = pl32_sum(l_run);
        if (hh == 0) wsf[r] = 1.0f / lt;
        bf16_t* Ow = HA + ((size_t)(b * SEQ + q0)) * 512 + h * 64 + r;
#pragma unroll
        for (int x = 0; x < 16; ++x) { const int qq = crow(x, hh); const float a = wsf[qq];
            const unsigned w0 = cvtpk(o0[x] * a, 0.f), w1 = cvtpk(o1[x] * a, 0.f);
            Ow[(size_t)qq * 512] = (bf16_t)(w0 & 0xffffu); Ow[(size_t)qq * 512 + 32] = (bf16_t)(w1 & 0xffffu); }
#undef AT_LOAD
#undef AT_STORE
    }
    __syncthreads();
}

constexpr int NPH = 12, N_PHASES = 1 + DEPTH * NPH;
struct Args { const float* in[24]; float* out; unsigned char* ws; int ph; int pad; };
#ifndef PH_NOINLINE
#define PH_NOINLINE 0
#endif
#if PH_NOINLINE
#define PHASE_FN __device__ __noinline__
#else
#define PHASE_FN __device__ __forceinline__
#endif
__device__ __forceinline__ Frame make_frame(unsigned char* ws, float* out, LAS unsigned char* lds, int wv) {
    Frame F; F.lds = lds; F.MISC = (volatile LAS unsigned*)(lds + MISC_OFF);
    F.tid = phase_tid(wv); F.lane = F.tid & 63; F.wave = __builtin_amdgcn_readfirstlane(F.tid >> 6);
    F.G = gridDim.x; F.bx = blockIdx.x; F.vcu = (F.G % 8 == 0) ? (F.bx % 8) * (F.G / 8) + F.bx / 8 : F.bx;
    F.ws = ws; F.ctl = (unsigned*)(ws + WS_CTL); F.out = out; return F;
}
constexpr size_t T1024 = (size_t)256 * 1024 * 2, T512 = (size_t)256 * 512 * 2, T256 = (size_t)256 * 256 * 2, T3584 = (size_t)256 * 3584 * 2;
PHASE_FN void ph_prologue(unsigned char* ws, float* out, LAS unsigned char* lds, int wv) { Frame F = make_frame(ws, out, lds, wv); prologue_phase(F); }
PHASE_FN void ph_inproj(unsigned char* ws, float* out, LAS unsigned char* lds, int wv, int l) { Frame F = make_frame(ws, out, lds, wv);
    SchedInProj S{(const char*)(ws + WS_XB), (const char*)(ws + WS_WIN + l * SZ_WIN), F.G, F.bx, T1024};
    EpiInProj E{(bf16_t*)(ws + WS_H0), (bf16_t*)(ws + WS_Q), (bf16_t*)(ws + WS_K), (bf16_t*)(ws + WS_VT), (bf16_t*)(ws + WS_SG)};
    pg8::gemm_phase<EpiInProj, SchedInProj, false>(lds, wv, D, S, E, nullptr); }
PHASE_FN void ph_thin(unsigned char* ws, float* out, LAS unsigned char* lds, int wv, int l) { Frame F = make_frame(ws, out, lds, wv); thin_phase(F, l); }
PHASE_FN void ph_attn(unsigned char* ws, float* out, LAS unsigned char* lds, int wv) { Frame F = make_frame(ws, out, lds, wv); attn_phase(F); }
PHASE_FN void ph_mixc(unsigned char* ws, float* out, LAS unsigned char* lds, int wv, int l) { Frame F = make_frame(ws, out, lds, wv);
    SchedGrid S{(const char*)(ws + WS_HC), (const char*)(ws + WS_WC + l * SZ_WC), M / 256, D / 256, F.G, F.bx, T512};
    EpiBf16Row<0> E{(bf16_t*)(ws + WS_MIX), D, (const bf16_t*)(ws + WS_SG), 2048};
    pg8::gemm_phase<EpiBf16Row<0>, SchedGrid, false>(lds, wv, CW, S, E, nullptr); }
PHASE_FN void ph_mixa(unsigned char* ws, float* out, LAS unsigned char* lds, int wv, int l) { Frame F = make_frame(ws, out, lds, wv);
    SchedGrid S{(const char*)(ws + WS_HA), (const char*)(ws + WS_WA + l * SZ_WA), M / 256, D / 256, F.G, F.bx, T512};
    EpiBf16Row<1> E{(bf16_t*)(ws + WS_MIX), D, (const bf16_t*)(ws + WS_SG) + 1024, 2048};
    pg8::gemm_phase<EpiBf16Row<1>, SchedGrid, false>(lds, wv, AW, S, E, nullptr); }
PHASE_FN void ph_outproj(unsigned char* ws, float* out, LAS unsigned char* lds, int wv, int l) { Frame F = make_frame(ws, out, lds, wv);
    SchedGrid S{(const char*)(ws + WS_MIX), (const char*)(ws + WS_WOUT + l * SZ_WOUT), M / 256, D / 256, F.G, F.bx, T1024};
    EpiResF32<0> E{(l == 0) ? INP(0) : (const float*)out, (float*)(ws + WS_YB), nullptr};
    pg8::gemm_phase<EpiResF32<0>, SchedGrid, false>(lds, wv, D, S, E, nullptr); }
PHASE_FN void ph_ln1(unsigned char* ws, float* out, LAS unsigned char* lds, int wv, int l) { Frame F = make_frame(ws, out, lds, wv); ln_phase<1>(F, l); }
PHASE_FN void ph_ln2(unsigned char* ws, float* out, LAS unsigned char* lds, int wv, int l) { Frame F = make_frame(ws, out, lds, wv); ln_phase<2>(F, l); }
PHASE_FN void ph_plegate(unsigned char* ws, float* out, LAS unsigned char* lds, int wv, int l) { Frame F = make_frame(ws, out, lds, wv);
    if (l & 1) route_build(F, l >> 1);
    SchedGrid S{(const char*)(ws + WS_XB), (const char*)(ws + WS_WPG + l * SZ_WPG), M / 256, D / 256, F.G, F.bx, T1024};
    EpiBf16Row<2> E{(bf16_t*)(ws + WS_PLE), D, nullptr, 0};
    pg8::gemm_phase<EpiBf16Row<2>, SchedGrid, false>(lds, wv, D, S, E, nullptr); }
PHASE_FN void ph_pleproj(unsigned char* ws, float* out, LAS unsigned char* lds, int wv, int l) { Frame F = make_frame(ws, out, lds, wv);
    SchedGrid S{(const char*)(ws + WS_PB), (const char*)(ws + WS_WPP + l * SZ_WPP), M / 256, D / 256, F.G, F.bx, T256};
    EpiBf16Row<3> E{(bf16_t*)(ws + WS_PLE), D, nullptr, 0};
    pg8::gemm_phase<EpiBf16Row<3>, SchedGrid, false>(lds, wv, PLED, S, E, nullptr); }
PHASE_FN void ph_ffn_up_dense(unsigned char* ws, float* out, LAS unsigned char* lds, int wv, int mi) { Frame F = make_frame(ws, out, lds, wv);
    EpiSwiGLU E{(bf16_t*)(ws + WS_H)};
    SchedGrid S{(const char*)(ws + WS_XB), (const char*)(ws + WS_WGU + mi * SZ_WGU), M / 256, 2 * FF / 256, F.G, F.bx, T1024};
    pg8::gemm_phase<EpiSwiGLU, SchedGrid, false>(lds, wv, D, S, E, nullptr); }
PHASE_FN void ph_ffn_up_moe(unsigned char* ws, float* out, LAS unsigned char* lds, int wv, int mi) { Frame F = make_frame(ws, out, lds, wv);
    EpiSwiGLU E{(bf16_t*)(ws + WS_H)};
    SchedMoe S; S.A = (const char*)(ws + WS_XB); S.B = (const char*)(ws + WS_EWGU); S.nN = 2 * FF / 256; S.G = F.G; S.c = F.bx; S.tstepA = T1024; S.tstepB = T1024; S.gather = true;
    moe_starts(F, mi, S.pstart); S.npan = S.pstart[NE];
    pg8::gemm_phase<EpiSwiGLU, SchedMoe, true>(lds, wv, D, S, E, (const int*)(ws + WS_RTOK)); }
PHASE_FN void ph_ffn_down_dense(unsigned char* ws, float* out, LAS unsigned char* lds, int wv, int mi) { Frame F = make_frame(ws, out, lds, wv);
    SchedGrid S{(const char*)(ws + WS_H), (const char*)(ws + WS_WD + mi * SZ_WD), M / 256, D / 256, F.G, F.bx, T3584};
    EpiResF32<1> E{(const float*)(ws + WS_YB), (float*)(ws + WS_YB), (const bf16_t*)(ws + WS_PLE)};
    pg8::gemm_phase<EpiResF32<1>, SchedGrid, false>(lds, wv, FF, S, E, nullptr); }
PHASE_FN void ph_ffn_down_moe(unsigned char* ws, float* out, LAS unsigned char* lds, int wv, int mi) { Frame F = make_frame(ws, out, lds, wv);
    SchedMoe S; S.A = (const char*)(ws + WS_H); S.B = (const char*)(ws + WS_EWD); S.nN = D / 256; S.G = F.G; S.c = F.bx; S.tstepA = T3584; S.tstepB = T3584; S.gather = false;
    moe_starts(F, mi, S.pstart); S.npan = S.pstart[NE];
    EpiMoeDown E{(bf16_t*)out, (const int*)(ws + WS_RDST), (const float*)(ws + WS_RGATE)};
    pg8::gemm_phase<EpiMoeDown, SchedMoe, false>(lds, wv, FF, S, E, nullptr); }

__global__ void __launch_bounds__(NTHR, 2) fwd_kernel(Args args) {
    extern __shared__ __attribute__((aligned(16))) unsigned char lds_raw[];
    LAS unsigned char* lds = (LAS unsigned char*)lds_raw;
    unsigned char* ws = args.ws; float* out = args.out;
    const int wv = __builtin_amdgcn_readfirstlane((int)threadIdx.x >> 6);
    for (int u = phase_tid(wv); u < (LDS_BYTES - LDSCTL_OFF) / 4; u += NTHR) ((LAS unsigned*)(lds + LDSCTL_OFF))[u] = 0u;
    __syncthreads();
#if MK_SINGLE
    XcdBarrier bar = xcd_barrier_post((unsigned*)(ws + WS_CTL) + CW_BAR, (volatile LAS unsigned*)(lds + MISC_OFF) + 8, phase_tid(wv));
#define RUN(k) (true)
#define SEAM() do { XcdBarrier b_ = bar; asm volatile("" : "+s"(b_.bar), "+s"(b_.x)); xcd_barrier(b_, phase_tid(wv)); } while (0)
#else
    const int ph = args.ph;
#define RUN(k) (ph == (k))
#define SEAM() do { } while (0)
#endif
    if (RUN(0)) ph_prologue(ws, out, lds, wv);
    SEAM();
#pragma unroll 1
    for (int l = 0; l < DEPTH; ++l) {
        const int pb = 1 + l * NPH; const bool moe = (l & 1) != 0; const int mi = l >> 1;
        if (RUN(pb + 0)) ph_inproj(ws, out, lds, wv, l);
        SEAM();
        if (RUN(pb + 1)) ph_thin(ws, out, lds, wv, l);
        SEAM();
        if (RUN(pb + 2)) ph_attn(ws, out, lds, wv);
        SEAM();
        if (RUN(pb + 3)) ph_mixc(ws, out, lds, wv, l);
        SEAM();
        if (RUN(pb + 4)) ph_mixa(ws, out, lds, wv, l);
        SEAM();
        if (RUN(pb + 5)) ph_outproj(ws, out, lds, wv, l);
        SEAM();
        if (RUN(pb + 6)) ph_ln1(ws, out, lds, wv, l);
        SEAM();
        if (RUN(pb + 7)) ph_plegate(ws, out, lds, wv, l);
        SEAM();
        if (RUN(pb + 8)) ph_pleproj(ws, out, lds, wv, l);
        SEAM();
        if (RUN(pb + 9)) { if (!moe) ph_ffn_up_dense(ws, out, lds, wv, mi); else ph_ffn_up_moe(ws, out, lds, wv, mi); }
        SEAM();
        if (RUN(pb + 10)) { if (!moe) ph_ffn_down_dense(ws, out, lds, wv, mi); else ph_ffn_down_moe(ws, out, lds, wv, mi); }
        SEAM();
        if (RUN(pb + 11)) ph_ln2(ws, out, lds, wv, l);
        if (l + 1 < DEPTH) SEAM();
    }
#undef RUN
#undef SEAM
}

extern "C" void kernel_launch(void* const* d_in, const int* in_sizes, int n_in, void* d_out, int out_size, void* d_ws, size_t ws_size, hipStream_t stream) {
    static int grid = 0;
    if (grid == 0) {
        if (n_in != 24 || in_sizes[0] != M * D || out_size != M * D || ws_size < WS_END) { fprintf(stderr, "kernel_launch: unexpected problem shape / workspace (%d inputs, ws %zu < %zu)\n", n_in, ws_size, (size_t)WS_END); grid = -1; return; }
        int dev = 0, cus = 0, per_cu = 0;
        if (hipGetDevice(&dev) != hipSuccess || hipDeviceGetAttribute(&cus, hipDeviceAttributeMultiprocessorCount, dev) != hipSuccess) { grid = -1; return; }
        if (hipFuncSetAttribute((const void*)fwd_kernel, hipFuncAttributeMaxDynamicSharedMemorySize, LDS_BYTES) != hipSuccess) { fprintf(stderr, "kernel_launch: hipFuncSetAttribute failed\n"); grid = -1; return; }
        if (hipOccupancyMaxActiveBlocksPerMultiprocessor(&per_cu, (const void*)fwd_kernel, NTHR, LDS_BYTES) != hipSuccess || per_cu < 1) fprintf(stderr, "kernel_launch: occupancy query reports %d\n", per_cu);
        (void)hipGetLastError();
        grid = cus;
    }
    if (grid < 0) return;
    (void)hipMemsetAsync((char*)d_ws + WS_CTL, 0, CTL_ZERO_BYTES, stream);
    Args a{};
    for (int i = 0; i < 24; ++i) a.in[i] = (const float*)d_in[i];
    a.out = (float*)d_out; a.ws = (unsigned char*)d_ws; a.ph = 0; a.pad = 0;
#if MK_SINGLE
    hipLaunchKernelGGL(fwd_kernel, dim3(grid), dim3(NTHR), LDS_BYTES, stream, a);
#else
    for (int ph = 0; ph < N_PHASES; ++ph) { a.ph = ph; hipLaunchKernelGGL(fwd_kernel, dim3(grid), dim3(NTHR), LDS_BYTES, stream, a); }
#endif
}
```

```cpp
#include <hip/hip_runtime.h>
#include <cstdio>
#include <cstdint>

#ifndef MK_SINGLE
#define MK_SINGLE 1
#endif
#ifndef DBG_CHECK
#define DBG_CHECK 0
#endif
#ifndef REP_MASK
#define REP_MASK 0
#endif
#define NREP(k) ((((REP_MASK) >> (k)) & 1) ? 2 : 1)

#define LAS __attribute__((address_space(3)))
#define GAS __attribute__((address_space(1)))
typedef unsigned short bf16_t;
typedef short bf16x8 __attribute__((ext_vector_type(8)));
typedef short s16x4 __attribute__((ext_vector_type(4)));
typedef float f32x2 __attribute__((ext_vector_type(2)));
typedef float f32x4 __attribute__((ext_vector_type(4)));
typedef float f32x16 __attribute__((ext_vector_type(16)));
typedef unsigned u32x2 __attribute__((ext_vector_type(2)));
typedef unsigned u32x4 __attribute__((ext_vector_type(4)));
typedef __bf16 bf16x2_t __attribute__((ext_vector_type(2)));

constexpr int D = 1024, BATCH = 8, SEQ = 4096, M = BATCH * SEQ, DEPTH = 4;
constexpr int NH = 8, HD = 64, AW = 512, CW = 512, CKW = 31, MOBA = 256, NBLK = SEQ / MOBA;
constexpr int FF = 3584, NE = 8, PLED = 256, NIN = 4608;
constexpr float LN_EPS = 1e-5f;
constexpr float ALPHA = 1.6817928305074290f;
constexpr float LOG2E = 1.4426950408889634f;
constexpr float QSCALE = 0.125f * LOG2E;
constexpr int NWAVES = 8, NTHR = 512;
constexpr int MAXPANEL = 264;
constexpr int MAXROWS = MAXPANEL * 256;

constexpr size_t MiB = 1u << 20;
constexpr size_t WS_CTL = 0, CTL_ZERO_BYTES = 1 * MiB;
constexpr size_t SZ_WIN = (size_t)NIN * D * 2, SZ_WC = (size_t)D * CW * 2, SZ_WA = (size_t)D * AW * 2, SZ_WOUT = (size_t)D * D * 2, SZ_WPG = (size_t)D * D * 2, SZ_WPP = (size_t)D * PLED * 2;
constexpr size_t SZ_WGU = (size_t)2 * FF * D * 2, SZ_WD = (size_t)D * FF * 2;
constexpr size_t WS_WIN = 2 * MiB;
constexpr size_t WS_WC = WS_WIN + DEPTH * SZ_WIN;
constexpr size_t WS_WA = WS_WC + DEPTH * SZ_WC;
constexpr size_t WS_WOUT = WS_WA + DEPTH * SZ_WA;
constexpr size_t WS_WPG = WS_WOUT + DEPTH * SZ_WOUT;
constexpr size_t WS_WPP = WS_WPG + DEPTH * SZ_WPG;
constexpr size_t WS_WGU = WS_WPP + DEPTH * SZ_WPP;
constexpr size_t WS_WD = WS_WGU + 2 * SZ_WGU;
constexpr size_t WS_EWGU = WS_WD + 2 * SZ_WD;
constexpr size_t WS_EWD = WS_EWGU + NE * SZ_WGU;
constexpr size_t WS_XB = WS_EWD + NE * SZ_WD;
constexpr size_t WS_YB = WS_XB + (size_t)M * D * 2;
constexpr size_t WS_PB = WS_YB + (size_t)M * D * 4;
constexpr size_t WS_PLE = WS_PB + (size_t)M * PLED * 2;
constexpr size_t WS_KM = WS_PLE + (size_t)M * D * 2;
constexpr size_t WS_ROUTE = WS_KM + (size_t)128 * 512 * 4;
constexpr size_t WS_RTOK = WS_ROUTE + (size_t)M * 32;
constexpr size_t WS_RDST = WS_RTOK + (size_t)MAXROWS * 4;
constexpr size_t WS_RGATE = WS_RDST + (size_t)MAXROWS * 4;
constexpr size_t WS_U = ((WS_RGATE + (size_t)MAXROWS * 4 + 4095) / 4096) * 4096;
constexpr size_t WS_H0 = WS_U;
constexpr size_t WS_Q = WS_H0 + (size_t)M * 512 * 2;
constexpr size_t WS_K = WS_Q + (size_t)M * 512 * 2;
constexpr size_t WS_VT = WS_K + (size_t)M * 512 * 2;
constexpr size_t WS_SG = WS_VT + (size_t)M * 512 * 2;
constexpr size_t WS_HC = WS_SG + (size_t)M * 2048 * 2;
constexpr size_t WS_HA = WS_HC + (size_t)M * 512 * 2;
constexpr size_t WS_MIX = WS_HA + (size_t)M * 512 * 2;
constexpr size_t WS_U_END_TM = WS_MIX + (size_t)M * D * 2;
constexpr size_t WS_H = WS_U;
constexpr size_t WS_U_END_FF = WS_H + (size_t)MAXROWS * FF * 2;
constexpr size_t WS_END = WS_U_END_FF > WS_U_END_TM ? WS_U_END_FF : WS_U_END_TM;

constexpr int CW_BAR = 4096;
constexpr int CW_GCNT = 16384;
constexpr int CW_DBG = 32768;

constexpr int RING_BYTES = 131072;
constexpr int LDSCTL_OFF = RING_BYTES, MISC_OFF = LDSCTL_OFF + 320;
constexpr int LDS_BYTES = 147456;

#define RLX_AGENT __ATOMIC_RELAXED, __HIP_MEMORY_SCOPE_AGENT
#define LDS_WAIT() asm volatile("s_waitcnt lgkmcnt(0)" ::: "memory")
#define VM_WAIT() asm volatile("s_waitcnt vmcnt(0)" ::: "memory")

__device__ __forceinline__ unsigned cvtpk(float lo, float hi) { f32x2 v = {lo, hi}; bf16x2_t b = __builtin_convertvector(v, bf16x2_t); return __builtin_bit_cast(unsigned, b); }
__device__ __forceinline__ float bf_lo(unsigned w) { return __uint_as_float(w << 16); }
__device__ __forceinline__ float bf_hi(unsigned w) { return __uint_as_float(w & 0xffff0000u); }
__device__ __forceinline__ float sigmoidf_(float x) { return __builtin_amdgcn_rcpf(1.0f + __builtin_amdgcn_exp2f(-x * LOG2E)); }

__device__ __forceinline__ int phase_tid(int wv) {
    int w = wv, ln; asm volatile("v_mbcnt_lo_u32_b32 %1, -1, 0\n\tv_mbcnt_hi_u32_b32 %1, -1, %1" : "+s"(w), "=&v"(ln));
    return w * 64 + ln;
}
namespace pg8 {
constexpr int BM = 256, BK = 64, HALF = 128, HTB = HALF * BK * 2, STAGE_BYTES = 8 * HTB, NXCD = 8, WGM = 8;
__host__ __device__ __forceinline__ int lds_byte(int r, int c) { const int st = (r >> 4) * 2 + (c >> 5), rr = r & 15, cc = c & 31, ob = rr * 64 + cc * 2; return st * 1024 + (ob ^ (((ob >> 9) & 1) << 5)); }
__host__ __device__ __forceinline__ void stage_rc(int b, int& R, int& C) { const int st = b / 1024, sb = b % 1024, swz = sb ^ (((sb >> 9) & 1) << 5); R = (st >> 1) * 16 + swz / 64; C = (st & 1) * 32 + (swz % 64) / 2; }
__host__ __device__ __forceinline__ int perm32(int rho) { const int n = rho >> 4, i = rho & 15; return 8 * (i >> 2) + 4 * n + (i & 3); }

struct Unit { const char* a; const char* b; int pm, pn, ty; };

__device__ __forceinline__ bool static_order(int i, int G, int c, int nM, int nN, int& pm, int& pn) {
    const int nwg = nM * nN; const long L = (long)i * G + c; if (L >= nwg) return false;
    int wgid = (int)L; { const int q = nwg / NXCD, r = nwg % NXCD, xcd = wgid % NXCD, off = wgid / NXCD; wgid = (xcd < r ? xcd * (q + 1) : r * (q + 1) + (xcd - r) * q) + off; }
    const int nig = WGM * nN, gid = wgid / nig, fm = gid * WGM, gsz = (nM - fm) < WGM ? (nM - fm) : WGM;
    pm = fm + ((wgid % nig) % gsz); pn = (wgid % nig) / gsz; return true;
}

template <class Epi, class Sched, bool GATHER>
__device__ __forceinline__ void gemm_phase(LAS unsigned char* lds, const int wv, const int K, const Sched& S, const Epi& E, const int* gidx) {
    const int tid = phase_tid(wv),
              wid = __builtin_amdgcn_readfirstlane(tid >> 6), lane = tid & 63, wr = wid >> 2, wc = wid & 3, fr = lane & 15, fq = lane >> 4;
    const int nt = K / BK;
    const size_t kstep = (size_t)(BK * 2);
    const size_t hstep = (size_t)HALF * K * 2;
    unsigned vA0[2], vA1[2], voffB[2];
#pragma unroll
    for (int i = 0; i < 2; ++i) { int R, C; stage_rc(tid * 16 + i * 8192, R, C); const int Rb = Epi::PERM ? ((R & ~31) + perm32(R & 31)) : R;
        vA0[i] = (unsigned)(R * K + C) * 2u; vA1[i] = vA0[i] + (unsigned)hstep; voffB[i] = (unsigned)(Rb * K + C) * 2u; }
    const unsigned ldsw = (unsigned)wid * 1024u;
    const int aoff = lds_byte(wr * 64 + fr, fq * 8), boff = lds_byte(wc * 32 + fr, fq * 8);
#define PG8_SA(b, h) (((b) * 2 + (h)) * HTB)
#define PG8_SB(b, h) ((4 + (b) * 2 + (h)) * HTB)
#define PG8_STAGE(bufoff, gbase, voff) do { _Pragma("unroll") for (int _i = 0; _i < 2; ++_i) \
        __builtin_amdgcn_global_load_lds((const unsigned*)((const char*)(gbase) + (voff)[_i]), (LAS unsigned*)(lds + (bufoff) + ldsw + _i * 8192), 16, 0, 0); } while (0)
#define PG8_LDA(dst, b, h) do { _Pragma("unroll") for (int m = 0; m < 4; ++m) _Pragma("unroll") for (int k = 0; k < 2; ++k) dst[m][k] = *(const LAS bf16x8*)(lds + PG8_SA(b, h) + aoff + m * 2048 + k * 1024); } while (0)
#define PG8_LDB(dst, b, h) do { _Pragma("unroll") for (int n = 0; n < 2; ++n) _Pragma("unroll") for (int k = 0; k < 2; ++k) dst[n][k] = *(const LAS bf16x8*)(lds + PG8_SB(b, h) + boff + n * 2048 + k * 1024); } while (0)
#define PG8_MMA(ai, bj, At, Bt) do { __builtin_amdgcn_s_setprio(1); _Pragma("unroll") for (int m = 0; m < 4; ++m) _Pragma("unroll") for (int n = 0; n < 2; ++n) _Pragma("unroll") for (int k = 0; k < 2; ++k) \
        acc[ai][bj][m][n] = __builtin_amdgcn_mfma_f32_16x16x32_bf16(Bt[n][k], At[m][k], acc[ai][bj][m][n], 0, 0, 0); __builtin_amdgcn_s_setprio(0); } while (0)
#define PG8_WAIT_V(n) asm volatile("s_waitcnt vmcnt(" #n ")" ::: "memory")
#define PG8_WAIT_L(n) asm volatile("s_waitcnt lgkmcnt(" #n ")" ::: "memory")
#define PG8_BAR __builtin_amdgcn_s_barrier()
#define PG8_SCHED __builtin_amdgcn_sched_barrier(0)
    Unit cur, nxt; int ui = 0;
    if (!S.next(0, cur)) return;
#define PG8_GATHER(pm_, o0, o1) do { int t_ = tid; asm volatile("" : "+v"(t_)); _Pragma("unroll") for (int i = 0; i < 2; ++i) { int R, C; stage_rc(t_ * 16 + i * 8192, R, C); const int* gp_ = gidx + (pm_) * BM + R; \
        o0[i] = (unsigned)(gp_[0] * K + C) * 2u; o1[i] = (unsigned)(gp_[HALF] * K + C) * 2u; } } while (0)
    if constexpr (GATHER) PG8_GATHER(cur.pm, vA0, vA1);
    unsigned nA0[2] = {vA0[0], vA0[1]}, nA1[2] = {vA1[0], vA1[1]};
    f32x4 acc[2][2][4][2];
#pragma unroll
    for (int a = 0; a < 2; ++a)
#pragma unroll
        for (int b = 0; b < 2; ++b)
#pragma unroll
            for (int m = 0; m < 4; ++m)
#pragma unroll
                for (int n = 0; n < 2; ++n) acc[a][b][m][n] = (f32x4){0.f, 0.f, 0.f, 0.f};
    bf16x8 At[4][2], B0[2][2], B1[2][2];
    const char* cA = cur.a; const char* cB = cur.b;
    PG8_STAGE(PG8_SB(0, 0), cB, voffB); PG8_STAGE(PG8_SB(0, 1), cB + hstep, voffB); PG8_STAGE(PG8_SA(0, 0), cA, vA0); PG8_STAGE(PG8_SA(0, 1), cA, vA1);
    if (wr == 1) PG8_BAR;
    PG8_WAIT_V(2); PG8_BAR;
    PG8_STAGE(PG8_SB(1, 0), cB + kstep, voffB); PG8_STAGE(PG8_SA(1, 0), cA + kstep, vA0); PG8_STAGE(PG8_SB(1, 1), cB + hstep + kstep, voffB);
    PG8_WAIT_V(6); PG8_BAR;
    for (;;) {
        const bool has_next = S.next(ui + 1, nxt);
        const char* nA = has_next ? nxt.a : cA; const char* nB = has_next ? nxt.b : cB;
        if constexpr (GATHER) {
            if (has_next) PG8_GATHER(nxt.pm, nA0, nA1);
        }
        for (int t = 0; t < nt; t += 2) {
            const bool last = (t == nt - 2);
            const char* a1 = cA + (size_t)(t + 1) * kstep;
            const char* a2 = last ? nA : cA + (size_t)(t + 2) * kstep; const char* b2 = last ? nB : cB + (size_t)(t + 2) * kstep;
            const char* a3 = a2 + kstep; const char* b3 = b2 + kstep;
            unsigned w0[2], w1[2];
            if constexpr (GATHER) { w0[0] = last ? nA0[0] : vA0[0]; w0[1] = last ? nA0[1] : vA0[1]; w1[0] = last ? nA1[0] : vA1[0]; w1[1] = last ? nA1[1] : vA1[1]; }
            else { w0[0] = vA0[0]; w0[1] = vA0[1]; w1[0] = vA1[0]; w1[1] = vA1[1]; }
            PG8_LDB(B0, 0, 0); PG8_LDB(B1, 0, 1); PG8_SCHED; PG8_LDA(At, 0, 0); PG8_STAGE(PG8_SA(1, 1), a1, vA1);
            PG8_WAIT_V(8); PG8_WAIT_L(0); PG8_BAR; PG8_MMA(0, 0, At, B0); PG8_MMA(0, 1, At, B1); PG8_BAR; PG8_SCHED;
            PG8_LDA(At, 0, 1); PG8_STAGE(PG8_SB(0, 0), b2, voffB); PG8_STAGE(PG8_SB(0, 1), b2 + hstep, voffB); PG8_STAGE(PG8_SA(0, 0), a2, w0);
            PG8_WAIT_V(8); PG8_WAIT_L(0); PG8_BAR; PG8_MMA(1, 0, At, B0); PG8_MMA(1, 1, At, B1); PG8_BAR; PG8_SCHED;
            PG8_LDB(B0, 1, 0); PG8_LDB(B1, 1, 1); PG8_SCHED; PG8_LDA(At, 1, 0); PG8_STAGE(PG8_SA(0, 1), a2, w1);
            PG8_WAIT_V(8); PG8_WAIT_L(0); PG8_BAR; PG8_MMA(0, 0, At, B0); PG8_MMA(0, 1, At, B1); PG8_BAR; PG8_SCHED;
            PG8_LDA(At, 1, 1); PG8_STAGE(PG8_SB(1, 0), b3, voffB); PG8_STAGE(PG8_SB(1, 1), b3 + hstep, voffB); PG8_STAGE(PG8_SA(1, 0), a3, w0);
            PG8_WAIT_V(8); PG8_WAIT_L(0); PG8_BAR; PG8_MMA(1, 0, At, B0); PG8_MMA(1, 1, At, B1); PG8_BAR; PG8_SCHED;
        }
        if (wr == 0) PG8_BAR;
        E(acc, cur, wr, wc, fr, fq);
        if (!has_next) break;
#pragma unroll
        for (int a = 0; a < 2; ++a)
#pragma unroll
            for (int b = 0; b < 2; ++b)
#pragma unroll
                for (int m = 0; m < 4; ++m)
#pragma unroll
                    for (int n = 0; n < 2; ++n) acc[a][b][m][n] = (f32x4){0.f, 0.f, 0.f, 0.f};
        cur = nxt; cA = nA; cB = nB; ++ui;
        if constexpr (GATHER) { vA0[0] = nA0[0]; vA0[1] = nA0[1]; vA1[0] = nA1[0]; vA1[1] = nA1[1]; }
        if (wr == 1) PG8_BAR;
    }
    PG8_WAIT_V(0);
    PG8_BAR;
#undef PG8_GATHER
#undef PG8_SA
#undef PG8_SB
#undef PG8_STAGE
#undef PG8_LDA
#undef PG8_LDB
#undef PG8_MMA
#undef PG8_WAIT_V
#undef PG8_WAIT_L
#undef PG8_BAR
#undef PG8_SCHED
}
}

#define XB_TMO      128
#define XB_XCNT(j)  (256  + 64 * (j))
#define XB_XSUB(j)  (1280 + 64 * (j))
#define XB_XGEN(j)  (2304 + 64 * (j))
#define XB_TOP      3328
#define XB_TOPGEN   3392
#define XCD_BAR_WORDS 3456
#define XB_SPIN_CAP (1u << 22)
__device__ __forceinline__ unsigned xb_ld(unsigned* p)              { return __hip_atomic_load(p, __ATOMIC_RELAXED, __HIP_MEMORY_SCOPE_AGENT); }
__device__ __forceinline__ unsigned xb_add(unsigned* p, unsigned v) { return __hip_atomic_fetch_add(p, v, __ATOMIC_RELAXED, __HIP_MEMORY_SCOPE_AGENT); }
__device__ __forceinline__ unsigned xb_xcc_id() { return (unsigned)__builtin_amdgcn_s_getreg((3 << 11) | 20) & 0xFu; }
#define XB_SPIN(cond, bar) do { unsigned _sp = 0; while (cond) { __builtin_amdgcn_s_sleep(1); \
    if ((++_sp & 255u) == 0u) { if (xb_ld(&(bar)[XB_TMO])) break; if (_sp > XB_SPIN_CAP) { atomicAdd(&(bar)[XB_TMO], 1u); break; } } } } while (0)
struct XcdBarrier { unsigned* bar; unsigned x; volatile LAS unsigned* st; };
__device__ __forceinline__ XcdBarrier xcd_barrier_post(unsigned* bar, volatile LAS unsigned* st, int tid) {
    XcdBarrier b; b.bar = bar; b.x = xb_xcc_id(); b.st = st;
    if (tid == 0) (void)xb_add(&bar[XB_XCNT(b.x)], 1u);
    return b;
}
__device__ __forceinline__ void xcd_barrier_complete(unsigned* bar, unsigned x, unsigned& nloc, unsigned& nx) {
    const unsigned G = gridDim.x * gridDim.y * gridDim.z;
    unsigned sum, cnt, mine, sp = 0u;
    for (;;) {
        sum = 0u; cnt = 0u; mine = 0u;
#pragma unroll
        for (unsigned j = 0; j < 16; ++j) { const unsigned c = xb_ld(&bar[XB_XCNT(j)]); sum += c; cnt += (c > 0u) ? 1u : 0u; mine = (j == x) ? c : mine; }
        if (sum == G) break;
        __builtin_amdgcn_s_sleep(1);
        if ((++sp & 255u) == 0u) { if (xb_ld(&bar[XB_TMO])) break; if (sp > XB_SPIN_CAP) { atomicAdd(&bar[XB_TMO], 1u); break; } }
    }
    nloc = mine > 0u ? mine : 1u; nx = cnt > 0u ? cnt : 1u;
}
__device__ __forceinline__ void xcd_barrier(const XcdBarrier& b, int tid) {
    asm volatile("s_waitcnt vmcnt(0)" ::: "memory");
    __syncthreads();
    if (tid == 0) {
        unsigned* bar = b.bar;
        __builtin_amdgcn_s_waitcnt(0);
        unsigned nloc = b.st[0], nx = b.st[1];
        if (nloc == 0u) { xcd_barrier_complete(bar, b.x, nloc, nx); b.st[0] = nloc; b.st[1] = nx; }
        const unsigned old = xb_add(&bar[XB_XSUB(b.x)], 1u);
        const unsigned gen = old / nloc;
        if (old + 1u == (gen + 1u) * nloc) {
            __builtin_amdgcn_fence(__ATOMIC_RELEASE, "agent");
            asm volatile("s_waitcnt vmcnt(0)" ::: "memory");
            const unsigned og = xb_add(&bar[XB_TOP], 1u);
            const unsigned tg = og / nx;
            if (og + 1u == (tg + 1u) * nx) xb_add(&bar[XB_TOPGEN], 1u);
            else XB_SPIN(xb_ld(&bar[XB_TOPGEN]) == tg, bar);
            __builtin_amdgcn_fence(__ATOMIC_ACQUIRE, "agent");
            xb_add(&bar[XB_XGEN(b.x)], 1u);
            asm volatile("s_waitcnt vmcnt(0)" ::: "memory");
        } else {
            XB_SPIN(xb_ld(&bar[XB_XGEN(b.x)]) == gen, bar);
            __builtin_amdgcn_fence(__ATOMIC_ACQUIRE, "agent");
            asm volatile("s_waitcnt vmcnt(0)" ::: "memory");
        }
    }
    __syncthreads();
}

struct Frame {
    LAS unsigned char* lds;
    volatile LAS unsigned* MISC;
    unsigned* ctl;
    int tid, lane, wave, G, vcu, bx;
    unsigned char* ws;
    float* out;
};
__device__ __forceinline__ Frame make_frame(unsigned char* ws, float* out, LAS unsigned char* lds, int wv);
#define INP(i) in_ptr<(i)>()
template <int I> __device__ __forceinline__ const float* in_ptr() {
    const float* p; auto ka = __builtin_amdgcn_kernarg_segment_ptr();
    asm volatile("s_load_dwordx2 %0, %1, %2\n\ts_waitcnt lgkmcnt(0)" : "=s"(p) : "s"(ka), "i"(I * 8) : "memory");
    return p;
}

__device__ __forceinline__ float wave_sum(float v) {
#pragma unroll
    for (int o = 1; o < 64; o <<= 1) v += __shfl_xor(v, o);
    return v;
}

using pg8::Unit;
struct EpiInProj {
    static constexpr bool PERM = true;
    bf16_t *H0, *Q, *Kb, *VT, *SG;
    __device__ __forceinline__ void operator()(const f32x4 (&acc)[2][2][4][2], const Unit& u, int wr, int wc, int fr, int fq) const {
        int r0 = wr * 64 + fr, c0 = wc * 32 + 8 * fq; asm volatile("" : "+v"(r0), "+v"(c0));
        if (u.ty == 0) {
#pragma unroll
            for (int ai = 0; ai < 2; ++ai)
#pragma unroll
                for (int m = 0; m < 4; ++m) { const size_t row = (size_t)u.pm * 256 + ai * 128 + m * 16 + r0;
                    f32x4 a0 = acc[ai][0][m][0], a1 = acc[ai][0][m][1], g0 = acc[ai][1][m][0], g1 = acc[ai][1][m][1];
                    u32x4 w; w.x = cvtpk(a0[0] * sigmoidf_(g0[0]), a0[1] * sigmoidf_(g0[1])); w.y = cvtpk(a0[2] * sigmoidf_(g0[2]), a0[3] * sigmoidf_(g0[3]));
                    w.z = cvtpk(a1[0] * sigmoidf_(g1[0]), a1[1] * sigmoidf_(g1[1])); w.w = cvtpk(a1[2] * sigmoidf_(g1[2]), a1[3] * sigmoidf_(g1[3]));
                    *(u32x4*)(H0 + row * 512 + u.pn * 128 + c0) = w; }
        } else if (u.ty == 3) {
            const int cpan = u.pn - 8;
#pragma unroll
            for (int ai = 0; ai < 2; ++ai)
#pragma unroll
                for (int m = 0; m < 4; ++m) { const size_t ch = (size_t)cpan * 256 + ai * 128 + m * 16 + r0;
#pragma unroll
                    for (int bj = 0; bj < 2; ++bj) { const f32x4 v0 = acc[ai][bj][m][0], v1 = acc[ai][bj][m][1];
                        u32x4 w; w.x = cvtpk(v0[0], v0[1]); w.y = cvtpk(v0[2], v0[3]); w.z = cvtpk(v1[0], v1[1]); w.w = cvtpk(v1[2], v1[3]);
                        *(u32x4*)(VT + ch * M + (size_t)u.pm * 256 + bj * 128 + c0) = w; } }
        } else if (u.ty == 4) {
            const int cb = (u.pn - 10) * 256;
#pragma unroll
            for (int ai = 0; ai < 2; ++ai)
#pragma unroll
                for (int m = 0; m < 4; ++m) { const size_t row = (size_t)u.pm * 256 + ai * 128 + m * 16 + r0;
#pragma unroll
                    for (int bj = 0; bj < 2; ++bj) { const f32x4 v0 = acc[ai][bj][m][0], v1 = acc[ai][bj][m][1];
                        u32x4 w; w.x = cvtpk(sigmoidf_(v0[0]), sigmoidf_(v0[1])); w.y = cvtpk(sigmoidf_(v0[2]), sigmoidf_(v0[3])); w.z = cvtpk(sigmoidf_(v1[0]), sigmoidf_(v1[1])); w.w = cvtpk(sigmoidf_(v1[2]), sigmoidf_(v1[3]));
                        *(u32x4*)(SG + row * 2048 + cb + bj * 128 + c0) = w; } }
        } else {
            bf16_t* base = (u.ty == 1) ? Q : Kb; const float sc = (u.ty == 1) ? QSCALE : 1.0f;
            const int cb = ((u.ty == 1) ? (u.pn - 4) : (u.pn - 6)) * 256;
#pragma unroll
            for (int ai = 0; ai < 2; ++ai)
#pragma unroll
                for (int m = 0; m < 4; ++m) { const size_t row = (size_t)u.pm * 256 + ai * 128 + m * 16 + r0;
#pragma unroll
                    for (int bj = 0; bj < 2; ++bj) { const f32x4 v0 = acc[ai][bj][m][0] * sc, v1 = acc[ai][bj][m][1] * sc;
                        u32x4 w; w.x = cvtpk(v0[0], v0[1]); w.y = cvtpk(v0[2], v0[3]); w.z = cvtpk(v1[0], v1[1]); w.w = cvtpk(v1[2], v1[3]);
                        *(u32x4*)(base + row * 512 + cb + bj * 128 + c0) = w; } }
        }
    }
};
template <int MODE> struct EpiBf16Row {
    static constexpr bool PERM = true;
    bf16_t* O; int ldo; const bf16_t* G; int ldg;
    __device__ __forceinline__ void operator()(const f32x4 (&acc)[2][2][4][2], const Unit& u, int wr, int wc, int fr, int fq) const {
        int r0 = wr * 64 + fr, c0 = u.pn * 256 + wc * 32 + 8 * fq; asm volatile("" : "+v"(r0), "+v"(c0));
#pragma unroll
        for (int ai = 0; ai < 2; ++ai)
#pragma unroll
            for (int m = 0; m < 4; ++m) { const size_t row = (size_t)u.pm * 256 + ai * 128 + m * 16 + r0;
#pragma unroll
                for (int bj = 0; bj < 2; ++bj) { f32x4 v0 = acc[ai][bj][m][0], v1 = acc[ai][bj][m][1];
                    bf16_t* op = O + row * ldo + c0 + bj * 128;
                    if (MODE == 0 || MODE == 1) { const u32x4 g = *(const u32x4*)(G + row * ldg + c0 + bj * 128);
                        v0[0] *= bf_lo(g.x); v0[1] *= bf_hi(g.x); v0[2] *= bf_lo(g.y); v0[3] *= bf_hi(g.y); v1[0] *= bf_lo(g.z); v1[1] *= bf_hi(g.z); v1[2] *= bf_lo(g.w); v1[3] *= bf_hi(g.w); }
                    if (MODE == 1) { const u32x4 o = *(const u32x4*)op;
                        v0[0] += bf_lo(o.x); v0[1] += bf_hi(o.x); v0[2] += bf_lo(o.y); v0[3] += bf_hi(o.y); v1[0] += bf_lo(o.z); v1[1] += bf_hi(o.z); v1[2] += bf_lo(o.w); v1[3] += bf_hi(o.w); }
                    if (MODE == 2) { for (int j = 0; j < 4; ++j) { v0[j] = sigmoidf_(v0[j]); v1[j] = sigmoidf_(v1[j]); } }
                    if (MODE == 3) { const u32x4 o = *(const u32x4*)op;
                        v0[0] *= bf_lo(o.x); v0[1] *= bf_hi(o.x); v0[2] *= bf_lo(o.y); v0[3] *= bf_hi(o.y); v1[0] *= bf_lo(o.z); v1[1] *= bf_hi(o.z); v1[2] *= bf_lo(o.w); v1[3] *= bf_hi(o.w); }
                    u32x4 w; w.x = cvtpk(v0[0], v0[1]); w.y = cvtpk(v0[2], v0[3]); w.z = cvtpk(v1[0], v1[1]); w.w = cvtpk(v1[2], v1[3]);
                    *(u32x4*)op = w; } }
    }
};
struct EpiSwiGLU {
    static constexpr bool PERM = true;
    bf16_t* H;
    __device__ __forceinline__ void operator()(const f32x4 (&acc)[2][2][4][2], const Unit& u, int wr, int wc, int fr, int fq) const {
        int r0 = wr * 64 + fr, c0 = u.pn * 128 + wc * 32 + 8 * fq; asm volatile("" : "+v"(r0), "+v"(c0));
#pragma unroll
        for (int ai = 0; ai < 2; ++ai)
#pragma unroll
            for (int m = 0; m < 4; ++m) { const size_t row = (size_t)u.pm * 256 + ai * 128 + m * 16 + r0;
                const f32x4 g0 = acc[ai][0][m][0], g1 = acc[ai][0][m][1], u0 = acc[ai][1][m][0], u1 = acc[ai][1][m][1];
                float h0[4], h1[4];
#pragma unroll
                for (int j = 0; j < 4; ++j) { h0[j] = g0[j] * sigmoidf_(g0[j]) * u0[j]; h1[j] = g1[j] * sigmoidf_(g1[j]) * u1[j]; }
                u32x4 w; w.x = cvtpk(h0[0], h0[1]); w.y = cvtpk(h0[2], h0[3]); w.z = cvtpk(h1[0], h1[1]); w.w = cvtpk(h1[2], h1[3]);
                *(u32x4*)(H + row * FF + c0) = w; }
    }
};
template <int MODE> struct EpiResF32 {
    static constexpr bool PERM = false;
    const float* X; float* Y; const bf16_t* P;
    __device__ __forceinline__ void operator()(const f32x4 (&acc)[2][2][4][2], const Unit& u, int wr, int wc, int fr, int fq) const {
        int r0 = wr * 64 + fr, c0 = u.pn * 256 + wc * 32 + 4 * fq; asm volatile("" : "+v"(r0), "+v"(c0));
#pragma unroll
        for (int ai = 0; ai < 2; ++ai)
#pragma unroll
            for (int m = 0; m < 4; ++m) { const size_t off = ((size_t)u.pm * 256 + ai * 128 + m * 16 + r0) * D + c0;
#pragma unroll
                for (int bj = 0; bj < 2; ++bj)
#pragma unroll
                    for (int n = 0; n < 2; ++n) { const size_t o = off + bj * 128 + n * 16;
                        f32x4 v = acc[ai][bj][m][n] + (*(const f32x4*)(X + o)) * ALPHA;
                        if (MODE == 1) { const u32x2 p = *(const u32x2*)(P + o); v[0] += bf_lo(p.x); v[1] += bf_hi(p.x); v[2] += bf_lo(p.y); v[3] += bf_hi(p.y); }
                        *(f32x4*)(Y + o) = v; } }
    }
};
struct EpiMoeDown {
    static constexpr bool PERM = true;
    bf16_t* Ys; const int* rdst; const float* rgate;
    __device__ __forceinline__ void operator()(const f32x4 (&acc)[2][2][4][2], const Unit& u, int wr, int wc, int fr, int fq) const {
        int r0 = wr * 64 + fr, c0 = u.pn * 256 + wc * 32 + 8 * fq; asm volatile("" : "+v"(r0), "+v"(c0));
#pragma unroll
        for (int ai = 0; ai < 2; ++ai)
#pragma unroll
            for (int m = 0; m < 4; ++m) { const int prow = u.pm * 256 + ai * 128 + m * 16 + r0; const int dst = rdst[prow]; const float gt = rgate[prow];
                if (dst >= 0) {
#pragma unroll
                    for (int bj = 0; bj < 2; ++bj) { const f32x4 v0 = acc[ai][bj][m][0] * gt, v1 = acc[ai][bj][m][1] * gt;
                        u32x4 w; w.x = cvtpk(v0[0], v0[1]); w.y = cvtpk(v0[2], v0[3]); w.z = cvtpk(v1[0], v1[1]); w.w = cvtpk(v1[2], v1[3]);
                        *(u32x4*)(Ys + (size_t)dst * D + c0 + bj * 128) = w; } } }
    }
};

struct SchedGrid {
    const char* A; const char* B; int nM, nN, G, c; size_t tstep;
    __device__ __forceinline__ bool next(int i, Unit& u) const { int pm, pn; if (!pg8::static_order(i, G, c, nM, nN, pm, pn)) return false; u.pm = pm; u.pn = pn; u.ty = 0; u.a = A + (size_t)pm * tstep; u.b = B + (size_t)pn * tstep; return true; }
};
struct SchedInProj {
    const char* X; const char* W; int G, c; size_t tstep;
    __device__ __forceinline__ bool next(int i, Unit& u) const { int pm, pn; if (!pg8::static_order(i, G, c, M / 256, 18, pm, pn)) return false; u.pm = pm; u.pn = pn;
        u.ty = pn < 4 ? 0 : pn < 6 ? 1 : pn < 8 ? 2 : pn < 10 ? 3 : 4;
        const char* xp = X + (size_t)pm * tstep; const char* wp = W + (size_t)pn * tstep;
        if (u.ty == 3) { u.a = wp; u.b = xp; } else { u.a = xp; u.b = wp; } return true; }
};
struct SchedMoe {
    const char* A; const char* B; int npan, nN, G, c; size_t tstepA, tstepB; int pstart[NE + 1]; bool gather;
    __device__ __forceinline__ bool next(int i, Unit& u) const { int pm, pn; if (!pg8::static_order(i, G, c, npan, nN, pm, pn)) return false; u.pm = pm; u.pn = pn; u.ty = 0;
        int e = 0;
#pragma unroll
        for (int j = 1; j < NE; ++j) e += (pm >= pstart[j]) ? 1 : 0;
        u.a = gather ? A : A + (size_t)pm * tstepA; u.b = B + ((size_t)e * nN + pn) * tstepB; return true; }
};

__device__ __forceinline__ void tr_item(const float* W, int ldw, int k0, int c0, bf16_t* WT, int K, int nrow0, LAS float* scr, int lane) {
    const int lr = lane >> 3, lc = (lane & 7) * 4;
    f32x4 v[8];
#pragma unroll
    for (int i = 0; i < 8; ++i) v[i] = *(const f32x4*)(W + (size_t)(k0 + 8 * i + lr) * ldw + c0 + lc);
#pragma unroll
    for (int i = 0; i < 8; ++i) { LAS float* d = scr + (8 * i + lr) * 33 + lc; d[0] = v[i][0]; d[1] = v[i][1]; d[2] = v[i][2]; d[3] = v[i][3]; }
    LDS_WAIT(); asm volatile("" ::: "memory");
    const int c = lane & 7;
#pragma unroll
    for (int j = 0; j < 4; ++j) { const int n = (lane >> 3) + 8 * j; const LAS float* s = scr + (8 * c) * 33 + n;
        u32x4 o; o.x = cvtpk(s[0 * 33], s[1 * 33]); o.y = cvtpk(s[2 * 33], s[3 * 33]); o.z = cvtpk(s[4 * 33], s[5 * 33]); o.w = cvtpk(s[6 * 33], s[7 * 33]);
        *(u32x4*)(WT + (size_t)(nrow0 + n) * K + k0 + 8 * c) = o; }
    LDS_WAIT(); asm volatile("" ::: "memory");
}
struct Job { const float* s0; const float* s1; bf16_t* dst; int ld, K, N, fam; };
__device__ __forceinline__ void run_job(Frame& F, const Job& jb, int rot) {
    LAS float* scr = (LAS float*)(F.lds + F.wave * 16384);
    const int NGW = F.G * NWAVES; int gw = (F.vcu * NWAVES + F.wave + rot) % NGW;
    const int nblk = jb.N / 32, nitems = (jb.K / 64) * nblk;
    for (int it = gw; it < nitems; it += NGW) {
        const int kb = it / nblk, nb = it - kb * nblk, n0 = nb * 32, k0 = kb * 64;
        const float* src = jb.s0; int c0 = n0;
        if (jb.fam == 0) { if (n0 < 1024) { const int t = n0 >> 8, w = n0 & 255; c0 = (w < 128) ? 128 * t + w : 512 + 128 * t + (w - 128); } }
        else if (jb.fam == 2) { const int t = n0 >> 8, w = n0 & 255; src = (w < 128) ? jb.s0 : jb.s1; c0 = 128 * t + (w & 127); }
        tr_item(src, jb.ld, k0, c0, jb.dst, jb.K, n0, scr, F.lane);
    }
}
__device__ __forceinline__ Job base_job(Frame& F, int j) {
    Job jb; jb.s1 = nullptr; jb.fam = 1;
    if (j < 24) { const int l = j / 6, k = j - l * 6;
        if (k == 0)      { jb.s0 = INP(3) + (size_t)l * D * NIN;  jb.ld = NIN; jb.K = D;    jb.N = NIN; jb.dst = (bf16_t*)(F.ws + WS_WIN + l * SZ_WIN); jb.fam = 0; }
        else if (k == 1) { jb.s0 = INP(8) + (size_t)l * CW * D;   jb.ld = D;   jb.K = CW;   jb.N = D;   jb.dst = (bf16_t*)(F.ws + WS_WC + l * SZ_WC); }
        else if (k == 2) { jb.s0 = INP(9) + (size_t)l * AW * D;   jb.ld = D;   jb.K = AW;   jb.N = D;   jb.dst = (bf16_t*)(F.ws + WS_WA + l * SZ_WA); }
        else if (k == 3) { jb.s0 = INP(10) + (size_t)l * D * D;   jb.ld = D;   jb.K = D;    jb.N = D;   jb.dst = (bf16_t*)(F.ws + WS_WOUT + l * SZ_WOUT); }
        else if (k == 4) { jb.s0 = INP(13) + (size_t)l * D * D;   jb.ld = D;   jb.K = D;    jb.N = D;   jb.dst = (bf16_t*)(F.ws + WS_WPG + l * SZ_WPG); }
        else             { jb.s0 = INP(14) + (size_t)l * PLED * D; jb.ld = D;  jb.K = PLED; jb.N = D;   jb.dst = (bf16_t*)(F.ws + WS_WPP + l * SZ_WPP); }
    } else { const int i = (j - 24) >> 1, k = (j - 24) & 1;
        if (k == 0) { jb.s0 = INP(17) + (size_t)i * D * FF; jb.s1 = INP(18) + (size_t)i * D * FF; jb.ld = FF; jb.K = D; jb.N = 2 * FF; jb.dst = (bf16_t*)(F.ws + WS_WGU + i * SZ_WGU); jb.fam = 2; }
        else        { jb.s0 = INP(19) + (size_t)i * FF * D; jb.ld = D; jb.K = FF; jb.N = D; jb.dst = (bf16_t*)(F.ws + WS_WD + i * SZ_WD); }
    }
    return jb;
}
__device__ __forceinline__ Job expert_job(Frame& F, int mi, int j) {
    Job jb; const int e = j >> 1, k = j & 1; const size_t eo = (size_t)(mi * NE + e) * D * FF;
    if (k == 0) { jb.s0 = INP(21) + eo; jb.s1 = INP(22) + eo; jb.ld = FF; jb.K = D; jb.N = 2 * FF; jb.dst = (bf16_t*)(F.ws + WS_EWGU + e * SZ_WGU); jb.fam = 2; }
    else        { jb.s0 = INP(23) + eo; jb.s1 = nullptr;       jb.ld = D;  jb.K = FF; jb.N = D;     jb.dst = (bf16_t*)(F.ws + WS_EWD + e * SZ_WD);   jb.fam = 1; }
    return jb;
}
__device__ __forceinline__ void cvt_rows(Frame& F, const float* src, bf16_t* dst, size_t n) {
    const size_t nch = n / 8, stride = (size_t)F.G * NTHR;
    for (size_t i0 = (size_t)F.vcu * NTHR + F.tid; i0 < nch; i0 += 4 * stride) {
        f32x4 a[4], b[4];
#pragma unroll
        for (int u = 0; u < 4; ++u) { const size_t i = i0 + u * stride; if (i < nch) { a[u] = *(const f32x4*)(src + i * 8); b[u] = *(const f32x4*)(src + i * 8 + 4); } }
#pragma unroll
        for (int u = 0; u < 4; ++u) { const size_t i = i0 + u * stride; if (i < nch) { u32x4 w; w.x = cvtpk(a[u][0], a[u][1]); w.y = cvtpk(a[u][2], a[u][3]); w.z = cvtpk(b[u][0], b[u][1]); w.w = cvtpk(b[u][2], b[u][3]); *(u32x4*)(dst + i * 8) = w; } }
    }
}
__device__ __forceinline__ void prologue_phase(Frame& F) {
    for (int j = 0; j < 28; ++j) { const Job jb = base_job(F, j); run_job(F, jb, (j * 397) & 2047); }
    for (int j = 0; j < 16; ++j) { const Job jb = expert_job(F, 0, j); run_job(F, jb, (j * 397 + 100) & 2047); }
    cvt_rows(F, INP(0), (bf16_t*)(F.ws + WS_XB), (size_t)M * D);
}

__device__ __forceinline__ void thin_phase(Frame& F, int l) {
    const int tid = F.tid, lane = F.lane, wave = F.wave;
    {   const bf16_t* Kb = (const bf16_t*)(F.ws + WS_K); float* KM = (float*)(F.ws + WS_KM); LAS float* ps = (LAS float*)F.lds;
        for (int u = F.vcu; u < M / 256; u += F.G) {
            float s[8] = {0.f, 0.f, 0.f, 0.f, 0.f, 0.f, 0.f, 0.f};
#pragma unroll 1
            for (int i0 = 0; i0 < 32; i0 += 16) { u32x4 kv[16];
#pragma unroll
                for (int i = 0; i < 16; ++i) kv[i] = *(const u32x4*)(Kb + ((size_t)u * 256 + wave + 8 * (i0 + i)) * 512 + lane * 8);
#pragma unroll
                for (int i = 0; i < 16; ++i) { const u32x4 v = kv[i];
                    s[0] += bf_lo(v.x); s[1] += bf_hi(v.x); s[2] += bf_lo(v.y); s[3] += bf_hi(v.y); s[4] += bf_lo(v.z); s[5] += bf_hi(v.z); s[6] += bf_lo(v.w); s[7] += bf_hi(v.w); } }
            __syncthreads();
#pragma unroll
            for (int j = 0; j < 8; ++j) ps[wave * 512 + lane * 8 + j] = s[j];
            __syncthreads();
            float t = 0.f;
#pragma unroll
            for (int w = 0; w < 8; ++w) t += ps[w * 512 + tid];
            KM[(size_t)u * 512 + tid] = t * (1.0f / 256.0f);
        }
        __syncthreads();
    }
    {   const bf16_t* H0 = (const bf16_t*)(F.ws + WS_H0); bf16_t* HC = (bf16_t*)(F.ws + WS_HC);
        LAS float* wl = (LAS float*)F.lds; LAS bf16_t* xt = (LAS bf16_t*)(F.lds + 63488);
        const float* cw = INP(4) + (size_t)l * CKW * CW;
        { f32x4 wv8[8];
#pragma unroll
          for (int k = 0; k < 8; ++k) { const int i = tid + k * NTHR; if (i < CKW * CW / 4) wv8[k] = ((const f32x4*)cw)[i]; }
#pragma unroll
          for (int k = 0; k < 8; ++k) { const int i = tid + k * NTHR; if (i < CKW * CW / 4) ((LAS f32x4*)wl)[i] = wv8[k]; } }
        const f32x4 cb0 = *(const f32x4*)(INP(5) + l * CW + lane * 8), cb1 = *(const f32x4*)(INP(5) + l * CW + lane * 8 + 4);
        const f32x4 lg0 = *(const f32x4*)(INP(6) + l * CW + lane * 8), lg1 = *(const f32x4*)(INP(6) + l * CW + lane * 8 + 4);
        const f32x4 lb0 = *(const f32x4*)(INP(7) + l * CW + lane * 8), lb1 = *(const f32x4*)(INP(7) + l * CW + lane * 8 + 4);
        for (int u = F.vcu; u < BATCH * (SEQ / 32); u += F.G) {
            const int b = u / (SEQ / 32), t0 = (u % (SEQ / 32)) * 32;
            __syncthreads();
            { u32x4 xv8[8];
#pragma unroll
              for (int k = 0; k < 8; ++k) { const int i = tid + k * NTHR, row = i >> 6, ch = i & 63, t = t0 - 30 + row; xv8[k] = (u32x4){0u, 0u, 0u, 0u};
                  if (i < 62 * 64 && t >= 0) xv8[k] = *(const u32x4*)(H0 + ((size_t)(b * SEQ + t)) * 512 + ch * 8); }
#pragma unroll
              for (int k = 0; k < 8; ++k) { const int i = tid + k * NTHR, row = i >> 6, ch = i & 63; if (i < 62 * 64) *(LAS u32x4*)(xt + row * 512 + ch * 8) = xv8[k]; } }
            __syncthreads();
            float acc[4][8];
#pragma unroll
            for (int tt = 0; tt < 4; ++tt)
#pragma unroll
                for (int c = 0; c < 8; ++c) acc[tt][c] = 0.f;
#pragma unroll 1
            for (int j = 0; j < CKW; ++j) {
                const f32x4 w0 = *(const LAS f32x4*)(wl + j * 512 + lane * 8), w1 = *(const LAS f32x4*)(wl + j * 512 + lane * 8 + 4);
#pragma unroll
                for (int tt = 0; tt < 4; ++tt) { const u32x4 xv = *(const LAS u32x4*)(xt + (wave * 4 + tt + j) * 512 + lane * 8);
                    acc[tt][0] += w0[0] * bf_lo(xv.x); acc[tt][1] += w0[1] * bf_hi(xv.x); acc[tt][2] += w0[2] * bf_lo(xv.y); acc[tt][3] += w0[3] * bf_hi(xv.y);
                    acc[tt][4] += w1[0] * bf_lo(xv.z); acc[tt][5] += w1[1] * bf_hi(xv.z); acc[tt][6] += w1[2] * bf_lo(xv.w); acc[tt][7] += w1[3] * bf_hi(xv.w); }
            }
#pragma unroll
            for (int tt = 0; tt < 4; ++tt) {
                float v[8]; float s = 0.f;
#pragma unroll
                for (int c = 0; c < 8; ++c) { v[c] = acc[tt][c] + (c < 4 ? cb0[c] : cb1[c - 4]); s += v[c]; }
                const float mean = wave_sum(s) * (1.0f / CW); float q = 0.f;
#pragma unroll
                for (int c = 0; c < 8; ++c) { v[c] -= mean; q += v[c] * v[c]; }
                const float rstd = 1.0f / sqrtf(wave_sum(q) * (1.0f / CW) + LN_EPS);
#pragma unroll
                for (int c = 0; c < 8; ++c) { const float y = v[c] * rstd * (c < 4 ? lg0[c] : lg1[c - 4]) + (c < 4 ? lb0[c] : lb1[c - 4]); v[c] = y * sigmoidf_(y); }
                u32x4 w; w.x = cvtpk(v[0], v[1]); w.y = cvtpk(v[2], v[3]); w.z = cvtpk(v[4], v[5]); w.w = cvtpk(v[6], v[7]);
                *(u32x4*)(HC + ((size_t)(b * SEQ + t0 + wave * 4 + tt)) * 512 + lane * 8) = w;
            }
        }
        __syncthreads();
    }
    cvt_rows(F, INP(1) + (size_t)l * M * PLED, (bf16_t*)(F.ws + WS_PB), (size_t)M * PLED);
    if (l == 2) { for (int j = 0; j < 16; ++j) { const Job jb = expert_job(F, 1, j); run_job(F, jb, (j * 397) & 2047); } }
}

template <int MODE> __device__ __forceinline__ void ln_phase(Frame& F, int l) {
    const int tid = F.tid, lane = F.lane, wave = F.wave; const bool moe = (l & 1) != 0; const int mi = l >> 1;
    float* YB = (float*)(F.ws + WS_YB); bf16_t* XB = (bf16_t*)(F.ws + WS_XB);
    const float* gp = (MODE == 1 ? INP(11) : INP(15)) + l * D; const float* bp = (MODE == 1 ? INP(12) : INP(16)) + l * D;
    f32x4 g[4], bb[4];
#pragma unroll
    for (int j = 0; j < 4; ++j) { g[j] = *(const f32x4*)(gp + 4 * lane + 256 * j); bb[j] = *(const f32x4*)(bp + 4 * lane + 256 * j); }
    LAS float* wr = (LAS float*)F.lds;
    LAS float* rt = (LAS float*)(F.lds + 32768);
    LAS int* lcnt = (LAS int*)(F.lds + 32768 + 2048);
    LAS int* lrk = (LAS int*)(F.lds + 32768 + 2048 + 64);
    if (MODE == 1 && moe) { const float* rw = INP(20) + (size_t)mi * D * NE; for (int i = tid; i < D * NE / 4; i += NTHR) ((LAS f32x4*)wr)[i] = ((const f32x4*)rw)[i]; if (tid < 8) lcnt[tid] = 0; __syncthreads(); }
    for (int c = F.vcu; c < M / 128; c += F.G) {
        for (int i = 0; i < 16; ++i) {
            const int rl = wave + 8 * i; const size_t row = (size_t)c * 128 + rl;
            f32x4 v[4]; float s = 0.f;
#pragma unroll
            for (int j = 0; j < 4; ++j) v[j] = *(const f32x4*)(YB + row * D + 4 * lane + 256 * j);
            if (MODE == 2 && moe) {
                const bf16_t* P = (const bf16_t*)(F.ws + WS_PLE); const bf16_t* Ys = (const bf16_t*)F.out;
#pragma unroll
                for (int j = 0; j < 4; ++j) { const u32x2 p = *(const u32x2*)(P + row * D + 4 * lane + 256 * j);
                    const u32x2 y0 = *(const u32x2*)(Ys + (2 * row) * D + 4 * lane + 256 * j), y1 = *(const u32x2*)(Ys + (2 * row + 1) * D + 4 * lane + 256 * j);
                    v[j][0] = v[j][0] * ALPHA + bf_lo(p.x) + bf_lo(y0.x) + bf_lo(y1.x); v[j][1] = v[j][1] * ALPHA + bf_hi(p.x) + bf_hi(y0.x) + bf_hi(y1.x);
                    v[j][2] = v[j][2] * ALPHA + bf_lo(p.y) + bf_lo(y0.y) + bf_lo(y1.y); v[j][3] = v[j][3] * ALPHA + bf_hi(p.y) + bf_hi(y0.y) + bf_hi(y1.y); }
                asm volatile("s_waitcnt vmcnt(0)" ::: "memory");
            }
#pragma unroll
            for (int j = 0; j < 4; ++j) s += (v[j][0] + v[j][1]) + (v[j][2] + v[j][3]);
            const float mean = wave_sum(s) * (1.0f / D); float q = 0.f;
#pragma unroll
            for (int j = 0; j < 4; ++j) { v[j] = v[j] - mean; q += (v[j][0] * v[j][0] + v[j][1] * v[j][1]) + (v[j][2] * v[j][2] + v[j][3] * v[j][3]); }
            const float rstd = 1.0f / sqrtf(wave_sum(q) * (1.0f / D) + LN_EPS);
            float* of = (MODE == 1) ? YB : F.out;
#pragma unroll
            for (int j = 0; j < 4; ++j) { v[j] = v[j] * rstd * g[j] + bb[j]; *(f32x4*)(of + row * D + 4 * lane + 256 * j) = v[j];
                u32x2 w; w.x = cvtpk(v[j][0], v[j][1]); w.y = cvtpk(v[j][2], v[j][3]); *(u32x2*)(XB + row * D + 4 * lane + 256 * j) = w; }
            if (MODE == 1 && moe) {
                float lg[NE];
#pragma unroll
                for (int e = 0; e < NE; ++e) lg[e] = 0.f;
#pragma unroll
                for (int j = 0; j < 4; ++j)
#pragma unroll
                    for (int k = 0; k < 4; ++k) { const int kk = 4 * lane + 256 * j + k; const f32x4 w0 = *(const LAS f32x4*)(wr + kk * 8), w1 = *(const LAS f32x4*)(wr + kk * 8 + 4); const float xv = v[j][k];
                        lg[0] += xv * w0[0]; lg[1] += xv * w0[1]; lg[2] += xv * w0[2]; lg[3] += xv * w0[3]; lg[4] += xv * w1[0]; lg[5] += xv * w1[1]; lg[6] += xv * w1[2]; lg[7] += xv * w1[3]; }
#pragma unroll
                for (int e = 0; e < NE; ++e) lg[e] = wave_sum(lg[e]);
                float b1 = lg[0]; int i1 = 0;
#pragma unroll
                for (int e = 1; e < NE; ++e) if (lg[e] > b1) { b1 = lg[e]; i1 = e; }
                float b2 = -INFINITY; int i2 = 0;
#pragma unroll
                for (int e = 0; e < NE; ++e) if (e != i1 && lg[e] > b2) { b2 = lg[e]; i2 = e; }
                const float p1 = 1.0f / (1.0f + __expf(b2 - b1));
                if (lane == 0) { rt[rl * 4 + 0] = __int_as_float(i1); rt[rl * 4 + 1] = __int_as_float(i2); rt[rl * 4 + 2] = p1; rt[rl * 4 + 3] = 1.0f - p1; }
            }
        }
        if (MODE == 1 && moe) {
            __syncthreads();
            int e1 = 0, e2 = 0;
            if (tid < 128) { e1 = __float_as_int(rt[tid * 4 + 0]); e2 = __float_as_int(rt[tid * 4 + 1]); lrk[tid * 2 + 0] = atomicAdd((int*)&lcnt[e1], 1); lrk[tid * 2 + 1] = atomicAdd((int*)&lcnt[e2], 1); }
            __syncthreads();
            if (tid < 8) { const int n = lcnt[tid]; lcnt[8 + tid] = (int)__hip_atomic_fetch_add(F.ctl + CW_GCNT + (mi * NE + tid) * 64, (unsigned)n, RLX_AGENT); }
            __syncthreads();
            if (tid < 128) { int* ro = (int*)(F.ws + WS_ROUTE) + ((size_t)c * 128 + tid) * 8;
                ro[0] = e1; ro[1] = e2; ro[2] = lcnt[8 + e1] + lrk[tid * 2 + 0]; ro[3] = lcnt[8 + e2] + lrk[tid * 2 + 1]; ((float*)ro)[4] = rt[tid * 4 + 2]; ((float*)ro)[5] = rt[tid * 4 + 3]; }
            __syncthreads();
            if (tid < 8) lcnt[tid] = 0;
            __syncthreads();
        }
    }
}
__device__ __forceinline__ void moe_starts(Frame& F, int mi, int (&pstart)[NE + 1]) {
    int acc = 0;
#pragma unroll
    for (int e = 0; e < NE; ++e) { pstart[e] = acc; const int n = (int)__hip_atomic_load(F.ctl + CW_GCNT + (mi * NE + e) * 64, RLX_AGENT); acc += (n + 255) >> 8; }
    pstart[NE] = acc;
}
__device__ __forceinline__ void route_build(Frame& F, int mi) {
    int pstart[NE + 1]; moe_starts(F, mi, pstart);
    int* rtok = (int*)(F.ws + WS_RTOK); int* rdst = (int*)(F.ws + WS_RDST); float* rgate = (float*)(F.ws + WS_RGATE);
    for (int t = F.vcu * NTHR + F.tid; t < M; t += F.G * NTHR) { const int* ro = (const int*)(F.ws + WS_ROUTE) + (size_t)t * 8;
        int e1 = ro[0], e2 = ro[1], r1 = ro[2], r2 = ro[3]; const float p1 = ((const float*)ro)[4], p2 = ((const float*)ro)[5];
        int s1 = 0, s2 = 0;
#pragma unroll
        for (int e = 0; e < NE; ++e) { s1 = (e == e1) ? pstart[e] : s1; s2 = (e == e2) ? pstart[e] : s2; }
        const int q1 = s1 * 256 + r1, q2 = s2 * 256 + r2;
        rtok[q1] = t; rdst[q1] = 2 * t; rgate[q1] = p1; rtok[q2] = t; rdst[q2] = 2 * t + 1; rgate[q2] = p2; }
    if (F.vcu < NE) { const int e = F.vcu; const int n = (int)__hip_atomic_load(F.ctl + CW_GCNT + (mi * NE + e) * 64, RLX_AGENT);
        for (int q = pstart[e] * 256 + n + F.tid; q < pstart[e + 1] * 256; q += NTHR) { rtok[q] = 0; rdst[q] = -1; rgate[q] = 0.f; } }
}

__device__ __forceinline__ int crow(int r, int hi) { return (r & 3) + 8 * (r >> 2) + 4 * hi; }
__device__ __forceinline__ float pl32_max(float m) { auto rr = __builtin_amdgcn_permlane32_swap(__float_as_uint(m), __float_as_uint(m), false, false); return fmaxf(__uint_as_float(rr[0]), __uint_as_float(rr[1])); }
__device__ __forceinline__ float pl32_sum(float m) { auto rr = __builtin_amdgcn_permlane32_swap(__float_as_uint(m), __float_as_uint(m), false, false); return __uint_as_float(rr[0]) + __uint_as_float(rr[1]); }
__device__ __forceinline__ int rel_bucket_dev(int n) {
    if (n < 16) return n;
    const int large = 16 + (int)(__log2f((float)n * (1.0f / 16.0f)) * (16.0f / 3.0f));
    return large < 31 ? large : 31;
}
constexpr int AT_KS = 0, AT_KROW = 144, AT_KBUF = 64 * AT_KROW;
constexpr int AT_VS = 2 * AT_KBUF, AT_VROW = 136, AT_VBUF = 64 * AT_VROW;
constexpr int AT_LUT = AT_VS + 2 * AT_VBUF, AT_WSF = AT_LUT + 512, AT_END = AT_WSF + NWAVES * 256;
__device__ __forceinline__ void attn_phase(Frame& F) {
    const int tid = F.tid, lane = F.lane, wid = F.wave, r = lane & 31, hh = lane >> 5;
    const bf16_t* Q = (const bf16_t*)(F.ws + WS_Q); const bf16_t* Kb = (const bf16_t*)(F.ws + WS_K); const bf16_t* VT = (const bf16_t*)(F.ws + WS_VT);
    const float* KM = (const float*)(F.ws + WS_KM); bf16_t* HA = (bf16_t*)(F.ws + WS_HA); const float* rel_bias = INP(2);
    LAS unsigned char* L = F.lds; LAS float* lut = (LAS float*)(L + AT_LUT); LAS float* wsf = (LAS float*)(L + AT_WSF) + wid * 64;
    const int lrow = tid >> 3, lch = tid & 7;
    for (int n = F.vcu; n < BATCH * NH * NBLK; n += F.G) {
        const int ii = n >> 8, w = n & 255, bh = w >> 2, s4 = w & 3; const int qb = (ii == 0) ? s4 : (ii == 1) ? 7 - s4 : (ii == 2) ? 8 + s4 : 15 - s4;
        const int b = bh >> 3, h = bh & 7;
        const int q0 = qb * 256 + wid * 32;
        const bf16_t* Kh = Kb + (size_t)b * SEQ * 512 + h * 64; const bf16_t* Vh = VT + (size_t)(h * 64) * M + (size_t)b * SEQ;
#define AT_LOAD(i, kreg, vreg) do { const int kp_ = ((i) < 4) ? qb * 256 + (i) * 64 : ((i) - 4) * 64; \
            kreg = *(const u32x4*)(Kh + (size_t)(kp_ + lrow) * 512 + lch * 8); vreg = *(const u32x4*)(Vh + (size_t)lrow * M + kp_ + lch * 8); } while (0)
#define AT_STORE(buf, kreg, vreg) do { *(LAS u32x4*)(L + AT_KS + (buf) * AT_KBUF + lrow * AT_KROW + lch * 16) = kreg; \
            *(LAS u32x2*)(L + AT_VS + (buf) * AT_VBUF + lrow * AT_VROW + lch * 16) = (u32x2){vreg.x, vreg.y}; *(LAS u32x2*)(L + AT_VS + (buf) * AT_VBUF + lrow * AT_VROW + lch * 16 + 8) = (u32x2){vreg.z, vreg.w}; } while (0)
        u32x4 kreg, vreg;
        AT_LOAD(0, kreg, vreg);
        bf16x8 qf[4];
#pragma unroll
        for (int d0 = 0; d0 < 4; ++d0) qf[d0] = *(const bf16x8*)(Q + ((size_t)(b * SEQ + q0 + r)) * 512 + h * 64 + d0 * 16 + hh * 8);
        unsigned selmask = 0u;
        if (qb > 0) {
            f32x16 sc;
#pragma unroll
            for (int i = 0; i < 16; ++i) sc[i] = 0.f;
#pragma unroll
            for (int d0 = 0; d0 < 4; ++d0) {
                f32x4 k0 = {0.f, 0.f, 0.f, 0.f}, k1 = {0.f, 0.f, 0.f, 0.f};
                if (r < 16) { const float* kp = KM + ((size_t)(b * NBLK + r)) * 512 + h * 64 + d0 * 16 + hh * 8; k0 = *(const f32x4*)kp; k1 = *(const f32x4*)(kp + 4); }
                u32x4 hi4, lo4;
                hi4.x = cvtpk(k0[0], k0[1]); hi4.y = cvtpk(k0[2], k0[3]); hi4.z = cvtpk(k1[0], k1[1]); hi4.w = cvtpk(k1[2], k1[3]);
                lo4.x = cvtpk(k0[0] - bf_lo(hi4.x), k0[1] - bf_hi(hi4.x)); lo4.y = cvtpk(k0[2] - bf_lo(hi4.y), k0[3] - bf_hi(hi4.y));
                lo4.z = cvtpk(k1[0] - bf_lo(hi4.z), k1[1] - bf_hi(hi4.z)); lo4.w = cvtpk(k1[2] - bf_lo(hi4.w), k1[3] - bf_hi(hi4.w));
                sc = __builtin_amdgcn_mfma_f32_32x32x16_bf16(__builtin_bit_cast(bf16x8, hi4), qf[d0], sc, 0, 0, 0);
                sc = __builtin_amdgcn_mfma_f32_32x32x16_bf16(__builtin_bit_cast(bf16x8, lo4), qf[d0], sc, 0, 0, 0);
            }
            float full[16];
#pragma unroll
            for (int g = 0; g < 8; ++g) { const float mine = sc[g], other = __shfl_xor(mine, 32);
                full[crow(g, 0)] = hh ? other : mine; full[crow(g, 1)] = hh ? mine : other; }
#pragma unroll
            for (int p = 0; p < 3; ++p) { float best = -INFINITY; int bi = -1;
#pragma unroll
                for (int j = 0; j < 16; ++j) { const bool ok = (j < qb) && !((selmask >> j) & 1u) && (full[j] > best); best = ok ? full[j] : best; bi = ok ? j : bi; }
                if (bi >= 0) selmask |= 1u << bi; }
        }
        float m_run = -INFINITY, l_run = 0.f; f32x16 o0, o1;
#pragma unroll
        for (int i = 0; i < 16; ++i) { o0[i] = 0.f; o1[i] = 0.f; }
        __syncthreads();
        if (tid < 128) lut[tid] = rel_bias[rel_bucket_dev(tid) * NH + h] * LOG2E;
        AT_STORE(0, kreg, vreg);
        __syncthreads();
        const int NT = 4 * (qb + 1);
        for (int i = 0; i < NT; ++i) {
            if (i + 1 < NT) AT_LOAD(i + 1, kreg, vreg);
            const int buf = i & 1; const bool own = i < 4; const int kp0 = own ? qb * 256 + i * 64 : (i - 4) * 64; const int jblk = (i - 4) >> 2;
            const bool sel = own ? true : (((selmask >> jblk) & 1u) != 0u);
            const bool skip = own ? (i * 64 > wid * 32 + 31) : !__any(sel);
            if (!skip) {
                f32x16 p0, p1;
#pragma unroll
                for (int x = 0; x < 16; ++x) { p0[x] = 0.f; p1[x] = 0.f; }
                const LAS unsigned char* kb = L + AT_KS + buf * AT_KBUF + r * AT_KROW + hh * 16;
#pragma unroll
                for (int d0 = 0; d0 < 4; ++d0) {
                    const bf16x8 a0 = *(const LAS bf16x8*)(kb + d0 * 32), a1 = *(const LAS bf16x8*)(kb + 32 * AT_KROW + d0 * 32);
                    p0 = __builtin_amdgcn_mfma_f32_32x32x16_bf16(a0, qf[d0], p0, 0, 0, 0);
                    p1 = __builtin_amdgcn_mfma_f32_32x32x16_bf16(a1, qf[d0], p1, 0, 0, 0);
                }
                const int qpos = q0 + r;
                if (own || (q0 - (kp0 + 63) < 113)) {
#pragma unroll
                    for (int x = 0; x < 16; ++x) { const int d0_ = qpos - (kp0 + crow(x, hh)), d1_ = d0_ - 32;
                        const float b0 = lut[d0_ < 0 ? 0 : (d0_ > 127 ? 127 : d0_)], b1 = lut[d1_ < 0 ? 0 : (d1_ > 127 ? 127 : d1_)];
                        p0[x] = (d0_ < 0) ? -INFINITY : p0[x] + b0; p1[x] = (d1_ < 0) ? -INFINITY : p1[x] + b1; }
                } else { const float bc = lut[127];
#pragma unroll
                    for (int x = 0; x < 16; ++x) { p0[x] += bc; p1[x] += bc; } }
                if (!sel) {
#pragma unroll
                    for (int x = 0; x < 16; ++x) { p0[x] = -INFINITY; p1[x] = -INFINITY; } }
                float mt = fmaxf(p0[0], p1[0]);
#pragma unroll
                for (int x = 1; x < 16; ++x) mt = fmaxf(mt, fmaxf(p0[x], p1[x]));
                mt = pl32_max(mt);
                const float m_new = fmaxf(m_run, mt);
                if (__any(m_new > m_run)) {
                    const float alpha = (m_new > m_run) ? __builtin_amdgcn_exp2f(m_run - m_new) : 1.0f;
                    l_run *= alpha;
                    if (hh == 0) wsf[r] = alpha;
#pragma unroll
                    for (int x = 0; x < 16; ++x) { const float a = wsf[crow(x, hh)]; o0[x] *= a; o1[x] *= a; }
                    m_run = m_new;
                }
                float ls = 0.f;
#pragma unroll
                for (int x = 0; x < 16; ++x) { p0[x] = __builtin_amdgcn_exp2f(p0[x] - m_run); p1[x] = __builtin_amdgcn_exp2f(p1[x] - m_run); ls += p0[x] + p1[x]; }
                l_run += ls;
                const LAS unsigned char* vb = L + AT_VS + buf * AT_VBUF + r * AT_VROW + hh * 8;
#pragma unroll
                for (int kh = 0; kh < 2; ++kh)
#pragma unroll
                    for (int s = 0; s < 2; ++s) {
                        u32x4 pa;
                        if (kh == 0) { pa.x = cvtpk(p0[8 * s + 0], p0[8 * s + 1]); pa.y = cvtpk(p0[8 * s + 2], p0[8 * s + 3]); pa.z = cvtpk(p0[8 * s + 4], p0[8 * s + 5]); pa.w = cvtpk(p0[8 * s + 6], p0[8 * s + 7]); }
                        else         { pa.x = cvtpk(p1[8 * s + 0], p1[8 * s + 1]); pa.y = cvtpk(p1[8 * s + 2], p1[8 * s + 3]); pa.z = cvtpk(p1[8 * s + 4], p1[8 * s + 5]); pa.w = cvtpk(p1[8 * s + 6], p1[8 * s + 7]); }
                        const int ko = (32 * kh + 16 * s) * 2;
                        const u32x2 va0 = *(const LAS u32x2*)(vb + ko), va1 = *(const LAS u32x2*)(vb + ko + 16);
                        const u32x2 vb0 = *(const LAS u32x2*)(vb + 32 * AT_VROW + ko), vb1 = *(const LAS u32x2*)(vb + 32 * AT_VROW + ko + 16);
                        const u32x4 fa = {va0.x, va0.y, va1.x, va1.y}, fb = {vb0.x, vb0.y, vb1.x, vb1.y};
                        o0 = __builtin_amdgcn_mfma_f32_32x32x16_bf16(__builtin_bit_cast(bf16x8, pa), __builtin_bit_cast(bf16x8, fa), o0, 0, 0, 0);
                        o1 = __builtin_amdgcn_mfma_f32_32x32x16_bf16(__builtin_bit_cast(bf16x8, pa), __builtin_bit_cast(bf16x8, fb), o1, 0, 0, 0);
                    }
            }
            if (i + 1 < NT) AT_STORE((i + 1) & 1, kreg, vreg);
            __syncthreads();
        }
        const float lt = pl32_sum(l_run);
        if (hh == 0) wsf[r] = 1.0f / lt;
        bf16_t* Ow = HA + ((size_t)(b * SEQ + q0)) * 512 + h * 64 + r;
#pragma unroll
        for (int x = 0; x < 16; ++x) { const int qq = crow(x, hh); const float a = wsf[qq];
            const unsigned w0 = cvtpk(o0[x] * a, 0.f), w1 = cvtpk(o1[x] * a, 0.f);
            Ow[(size_t)qq * 512] = (bf16_t)(w0 & 0xffffu); Ow[(size_t)qq * 512 + 32] = (bf16_t)(w1 & 0xffffu); }
#undef AT_LOAD
#undef AT_STORE
    }
    __syncthreads();
}


#if DBG_CHECK
__device__ __forceinline__ unsigned hash_u(unsigned x) { x ^= x >> 16; x *= 0x7feb352du; x ^= x >> 15; x *= 0x846ca68bu; x ^= x >> 16; return x; }
__device__ __forceinline__ float bfv(const bf16_t* p) { return __uint_as_float(((unsigned)*p) << 16); }
__device__ __forceinline__ float rbf(float x) { return bf_lo(cvtpk(x, 0.f) & 0xffffu); }
__device__ __forceinline__ void dbg_acc(Frame& F, float d2, float r2) { if (F.lane == 0) { atomicAdd((float*)(F.ctl + CW_DBG), d2); atomicAdd((float*)(F.ctl + CW_DBG + 64), r2); } }
__device__ __forceinline__ float dbg_qk(const bf16_t* qp, const bf16_t* kp) { float a = 0.f;
#pragma unroll 1
    for (int d = 0; d < 64; ++d) a += bfv(qp + d) * bfv(kp + d); return a; }
__device__ __forceinline__ void dbg_attn(Frame& F, const float* rel_bias) {
    const bf16_t* Q = (const bf16_t*)(F.ws + WS_Q); const bf16_t* Kb = (const bf16_t*)(F.ws + WS_K); const bf16_t* VT = (const bf16_t*)(F.ws + WS_VT);
    const float* KM = (const float*)(F.ws + WS_KM); const bf16_t* HA = (const bf16_t*)(F.ws + WS_HA);
    const int gw = F.vcu * NWAVES + F.wave, lane = F.lane;
#pragma unroll 1
    for (int sidx = gw; sidx < 4096; sidx += F.G * NWAVES) {
        const unsigned hsh = hash_u(sidx * 2654435761u + 12345u);
        const int b = hsh & 7, h = (hsh >> 3) & 7; int q = (hsh >> 6) & 4095;
        if ((sidx & 7) == 0) q = (q & ~255) | ((hsh >> 20) & 3);
        if ((sidx & 7) == 1) q = (q & ~255) | (252 + ((hsh >> 20) & 3));
        if ((sidx & 15) == 2) q = q & 255;
        const int own = q >> 8; const bf16_t* qp = Q + ((size_t)(b * SEQ + q)) * 512 + h * 64;
        float myscore = -INFINITY;
        if (lane < own) { float a = 0.f;
#pragma unroll 1
            for (int d = 0; d < 64; ++d) a += bfv(qp + d) * KM[((size_t)(b * NBLK + lane)) * 512 + h * 64 + d]; myscore = a; }
        unsigned sel = 0u;
#pragma unroll 1
        for (int p = 0; p < 3; ++p) { float best = -INFINITY; int bi = -1;
#pragma unroll 1
            for (int j = 0; j < 16; ++j) { const float sj = __shfl(myscore, j); if (j < own && !((sel >> j) & 1u) && sj > best) { best = sj; bi = j; } }
            if (bi >= 0) sel |= 1u << bi; }
        float mx = -INFINITY;
#pragma unroll 1
        for (int kp = lane; kp <= q; kp += 64) { const int kb = kp >> 8; if (!(kb == own || ((sel >> kb) & 1u))) continue;
            const float a = dbg_qk(qp, Kb + ((size_t)(b * SEQ + kp)) * 512 + h * 64) + rel_bias[rel_bucket_dev(q - kp) * NH + h] * LOG2E; mx = fmaxf(mx, a); }
#pragma unroll
        for (int o = 1; o < 64; o <<= 1) mx = fmaxf(mx, __shfl_xor(mx, o));
        float ls = 0.f;
#pragma unroll 1
        for (int kp = lane; kp <= q; kp += 64) { const int kb = kp >> 8; if (!(kb == own || ((sel >> kb) & 1u))) continue;
            const float a = dbg_qk(qp, Kb + ((size_t)(b * SEQ + kp)) * 512 + h * 64) + rel_bias[rel_bucket_dev(q - kp) * NH + h] * LOG2E; ls += exp2f(a - mx); }
        ls = wave_sum(ls); float d2 = 0.f, r2 = 0.f;
#pragma unroll 1
        for (int d = 0; d < 64; ++d) { float ov = 0.f;
#pragma unroll 1
            for (int kp = lane; kp <= q; kp += 64) { const int kb = kp >> 8; if (!(kb == own || ((sel >> kb) & 1u))) continue;
                const float a = dbg_qk(qp, Kb + ((size_t)(b * SEQ + kp)) * 512 + h * 64) + rel_bias[rel_bucket_dev(q - kp) * NH + h] * LOG2E;
                ov += exp2f(a - mx) * bfv(VT + ((size_t)(h * 64 + d)) * M + (size_t)b * SEQ + kp); }
            const float o = wave_sum(ov) / ls; const float got = bfv(HA + ((size_t)(b * SEQ + q)) * 512 + h * 64 + d); d2 += (got - o) * (got - o); r2 += o * o; }
        dbg_acc(F, d2, r2);
    }
}
__device__ __forceinline__ float dbg_dot_x_w(Frame& F, const float* xrow, const float* W, int ldw, int col, int K) {
    float a = 0.f;
#pragma unroll 1
    for (int k = F.lane; k < K; k += 64) a += rbf(xrow[k]) * rbf(W[(size_t)k * ldw + col]); return wave_sum(a); }
__device__ __forceinline__ void dbg_inproj(Frame& F, const float* x, const float* w) {
    const int gw = F.vcu * NWAVES + F.wave;
#pragma unroll 1
    for (int sidx = gw; sidx < 8192; sidx += F.G * NWAVES) {
        const unsigned hsh = hash_u(sidx * 2654435761u + 777u); const int row = hsh & (M - 1); const int sec = sidx % 5; const unsigned r2_ = hash_u(hsh);
        const float* xr = x + (size_t)row * D; float ref, got;
        if (sec == 0) { const int c = r2_ & 511; const float a = dbg_dot_x_w(F, xr, w, NIN, c, D), g = dbg_dot_x_w(F, xr, w, NIN, 512 + c, D); ref = a / (1.f + __expf(-g)); got = bfv((const bf16_t*)(F.ws + WS_H0) + (size_t)row * 512 + c); }
        else if (sec == 1) { const int c = r2_ & 511; ref = dbg_dot_x_w(F, xr, w, NIN, 1024 + c, D) * QSCALE; got = bfv((const bf16_t*)(F.ws + WS_Q) + (size_t)row * 512 + c); }
        else if (sec == 2) { const int c = r2_ & 511; ref = dbg_dot_x_w(F, xr, w, NIN, 1536 + c, D); got = bfv((const bf16_t*)(F.ws + WS_K) + (size_t)row * 512 + c); }
        else if (sec == 3) { const int c = r2_ & 511; ref = dbg_dot_x_w(F, xr, w, NIN, 2048 + c, D); got = bfv((const bf16_t*)(F.ws + WS_VT) + (size_t)c * M + row); }
        else { const int c = r2_ & 2047; const float g = dbg_dot_x_w(F, xr, w, NIN, 2560 + c, D); ref = 1.f / (1.f + __expf(-g)); got = bfv((const bf16_t*)(F.ws + WS_SG) + (size_t)row * 2048 + c); }
        dbg_acc(F, (got - ref) * (got - ref), ref * ref);
    }
}
__device__ __forceinline__ void dbg_conv(Frame& F) {
    const bf16_t* H0 = (const bf16_t*)(F.ws + WS_H0); const bf16_t* HC = (const bf16_t*)(F.ws + WS_HC); const int gw = F.vcu * NWAVES + F.wave, lane = F.lane;
    const float* cw = INP(4); const float* cb = INP(5); const float* lg = INP(6); const float* lb = INP(7);
#pragma unroll 1
    for (int sidx = gw; sidx < 4096; sidx += F.G * NWAVES) {
        const unsigned hsh = hash_u(sidx * 2654435761u + 4242u); const int b = hsh & 7; int t = (hsh >> 3) & 4095; if ((sidx & 3) == 0) t &= 31;
        float v[8]; float s = 0.f;
#pragma unroll
        for (int c = 0; c < 8; ++c) { const int ch = lane * 8 + c; float a = cb[ch];
#pragma unroll 1
            for (int j = 0; j < CKW; ++j) { const int ti = t - 30 + j; if (ti >= 0) a += cw[j * CW + ch] * bfv(H0 + ((size_t)(b * SEQ + ti)) * 512 + ch); } v[c] = a; s += a; }
        const float mean = wave_sum(s) / CW; float qq = 0.f;
#pragma unroll
        for (int c = 0; c < 8; ++c) qq += (v[c] - mean) * (v[c] - mean);
        const float rstd = 1.f / sqrtf(wave_sum(qq) / CW + LN_EPS); float d2 = 0.f, r2 = 0.f;
#pragma unroll
        for (int c = 0; c < 8; ++c) { const int ch = lane * 8 + c; const float y = (v[c] - mean) * rstd * lg[ch] + lb[ch]; const float ref = y / (1.f + __expf(-y));
            const float got = bfv(HC + ((size_t)(b * SEQ + t)) * 512 + ch); d2 += (got - ref) * (got - ref); r2 += ref * ref; }
        dbg_acc(F, wave_sum(d2), wave_sum(r2));
    }
    const bf16_t* Kb = (const bf16_t*)(F.ws + WS_K); const float* KM = (const float*)(F.ws + WS_KM);
    for (int sidx = gw; sidx < 2048; sidx += F.G * NWAVES) { const unsigned hsh = hash_u(sidx * 2654435761u + 99u); const int u = hsh & 127, col = (hsh >> 7) & 511;
        float a = 0.f; for (int r = lane; r < 256; r += 64) a += bfv(Kb + ((size_t)u * 256 + r) * 512 + col); a = wave_sum(a) / 256.f; const float got = KM[(size_t)u * 512 + col];
        dbg_acc(F, (got - a) * (got - a) * 100.f, a * a * 100.f); }
}
__device__ __forceinline__ void dbg_mix(Frame& F) {
    const bf16_t* HC = (const bf16_t*)(F.ws + WS_HC); const bf16_t* HA = (const bf16_t*)(F.ws + WS_HA); const bf16_t* SG = (const bf16_t*)(F.ws + WS_SG); const bf16_t* MIX = (const bf16_t*)(F.ws + WS_MIX);
    const float* wc = INP(8); const float* wa = INP(9); const int gw = F.vcu * NWAVES + F.wave, lane = F.lane;
    for (int sidx = gw; sidx < 8192; sidx += F.G * NWAVES) { const unsigned hsh = hash_u(sidx * 2654435761u + 31337u); const int row = hsh & (M - 1), col = (hsh >> 15) & 1023;
        float a = 0.f, c = 0.f; for (int k = lane; k < 512; k += 64) { c += bfv(HC + (size_t)row * 512 + k) * rbf(wc[(size_t)k * D + col]); a += bfv(HA + (size_t)row * 512 + k) * rbf(wa[(size_t)k * D + col]); }
        c = wave_sum(c); a = wave_sum(a); const float ref = bfv(SG + (size_t)row * 2048 + col) * c + bfv(SG + (size_t)row * 2048 + 1024 + col) * a; const float got = bfv(MIX + (size_t)row * D + col);
        dbg_acc(F, (got - ref) * (got - ref), ref * ref); }
}
__device__ __forceinline__ void dbg_out(Frame& F) {
    const bf16_t* MIX = (const bf16_t*)(F.ws + WS_MIX); const float* YB = (const float*)(F.ws + WS_YB); const float* x = INP(0); const float* wo = INP(10); const int gw = F.vcu * NWAVES + F.wave, lane = F.lane;
    for (int sidx = gw; sidx < 8192; sidx += F.G * NWAVES) { const unsigned hsh = hash_u(sidx * 2654435761u + 555u); const int row = hsh & (M - 1), col = (hsh >> 15) & 1023;
        float a = 0.f; for (int k = lane; k < D; k += 64) a += bfv(MIX + (size_t)row * D + k) * rbf(wo[(size_t)k * D + col]); a = wave_sum(a);
        const float got = YB[(size_t)row * D + col] - ALPHA * x[(size_t)row * D + col]; dbg_acc(F, (got - a) * (got - a), a * a); }
}
#if DBG_CHECK == 1 || DBG_CHECK == 2
__device__ __noinline__ void dbg_entry(unsigned char* ws, float* out, LAS unsigned char* lds, int wv_, const float* p0, const float* p1) { const int wv = __builtin_amdgcn_readfirstlane(wv_); Frame F = make_frame(ws, out, lds, wv);
#if DBG_CHECK == 1
    dbg_attn(F, p0);
#else
    dbg_inproj(F, p0, p1);
#endif
}
#endif
__device__ __forceinline__ void dbg_finish(Frame& F) {
    const float d2 = __hip_atomic_load((float*)(F.ctl + CW_DBG), RLX_AGENT), r2 = __hip_atomic_load((float*)(F.ctl + CW_DBG + 64), RLX_AGENT);
    float v = -10.f * log10f(d2 / r2); v = (d2 == 0.f) ? 98.f : v; v = fminf(fmaxf(v, 0.f), 98.f); if (!(r2 > 0.f)) v = 0.f;
    const float c = sqrtf(v);
    for (size_t i = (size_t)F.vcu * NTHR + F.tid; i < (size_t)M * D; i += (size_t)F.G * NTHR) F.out[i] = c;
}
#endif
constexpr int NPH = 12, N_PHASES = 1 + DEPTH * NPH;
struct Args { const float* in[24]; float* out; unsigned char* ws; int ph; int pad; };
#ifndef PH_NOINLINE
#define PH_NOINLINE 0
#endif
#if PH_NOINLINE
#define PHASE_FN __device__ __noinline__
#else
#define PHASE_FN __device__ __forceinline__
#endif
__device__ __forceinline__ Frame make_frame_impl(unsigned char* ws, float* out, LAS unsigned char* lds, int wv) {
    Frame F; F.lds = lds; F.MISC = (volatile LAS unsigned*)(lds + MISC_OFF);
    F.tid = phase_tid(wv); F.lane = F.tid & 63; F.wave = __builtin_amdgcn_readfirstlane(F.tid >> 6);
    F.G = gridDim.x; F.bx = blockIdx.x; F.vcu = (F.G % 8 == 0) ? (F.bx % 8) * (F.G / 8) + F.bx / 8 : F.bx;
    F.ws = ws; F.ctl = (unsigned*)(ws + WS_CTL); F.out = out; return F;
}
__device__ __forceinline__ Frame make_frame(unsigned char* ws, float* out, LAS unsigned char* lds, int wv) { return make_frame_impl(ws, out, lds, wv); }
constexpr size_t T1024 = (size_t)256 * 1024 * 2, T512 = (size_t)256 * 512 * 2, T256 = (size_t)256 * 256 * 2, T3584 = (size_t)256 * 3584 * 2;
PHASE_FN void ph_prologue(unsigned char* ws, float* out, LAS unsigned char* lds, int wv) { Frame F = make_frame(ws, out, lds, wv); prologue_phase(F); }
PHASE_FN void ph_inproj(unsigned char* ws, float* out, LAS unsigned char* lds, int wv, int l) { Frame F = make_frame(ws, out, lds, wv);
    SchedInProj S{(const char*)(ws + WS_XB), (const char*)(ws + WS_WIN + l * SZ_WIN), F.G, F.bx, T1024};
    EpiInProj E{(bf16_t*)(ws + WS_H0), (bf16_t*)(ws + WS_Q), (bf16_t*)(ws + WS_K), (bf16_t*)(ws + WS_VT), (bf16_t*)(ws + WS_SG)};
    pg8::gemm_phase<EpiInProj, SchedInProj, false>(lds, wv, D, S, E, nullptr); }
PHASE_FN void ph_thin(unsigned char* ws, float* out, LAS unsigned char* lds, int wv, int l) { Frame F = make_frame(ws, out, lds, wv); thin_phase(F, l); }
PHASE_FN void ph_attn(unsigned char* ws, float* out, LAS unsigned char* lds, int wv) { Frame F = make_frame(ws, out, lds, wv); attn_phase(F); }
PHASE_FN void ph_mixc(unsigned char* ws, float* out, LAS unsigned char* lds, int wv, int l) { Frame F = make_frame(ws, out, lds, wv);
    SchedGrid S{(const char*)(ws + WS_HC), (const char*)(ws + WS_WC + l * SZ_WC), M / 256, D / 256, F.G, F.bx, T512};
    EpiBf16Row<0> E{(bf16_t*)(ws + WS_MIX), D, (const bf16_t*)(ws + WS_SG), 2048};
    pg8::gemm_phase<EpiBf16Row<0>, SchedGrid, false>(lds, wv, CW, S, E, nullptr); }
PHASE_FN void ph_mixa(unsigned char* ws, float* out, LAS unsigned char* lds, int wv, int l) { Frame F = make_frame(ws, out, lds, wv);
    SchedGrid S{(const char*)(ws + WS_HA), (const char*)(ws + WS_WA + l * SZ_WA), M / 256, D / 256, F.G, F.bx, T512};
    EpiBf16Row<1> E{(bf16_t*)(ws + WS_MIX), D, (const bf16_t*)(ws + WS_SG) + 1024, 2048};
    pg8::gemm_phase<EpiBf16Row<1>, SchedGrid, false>(lds, wv, AW, S, E, nullptr); }
PHASE_FN void ph_outproj(unsigned char* ws, float* out, LAS unsigned char* lds, int wv, int l) { Frame F = make_frame(ws, out, lds, wv);
    SchedGrid S{(const char*)(ws + WS_MIX), (const char*)(ws + WS_WOUT + l * SZ_WOUT), M / 256, D / 256, F.G, F.bx, T1024};
    EpiResF32<0> E{(l == 0) ? INP(0) : (const float*)out, (float*)(ws + WS_YB), nullptr};
    pg8::gemm_phase<EpiResF32<0>, SchedGrid, false>(lds, wv, D, S, E, nullptr); }
PHASE_FN void ph_ln1(unsigned char* ws, float* out, LAS unsigned char* lds, int wv, int l) { Frame F = make_frame(ws, out, lds, wv); ln_phase<1>(F, l); }
PHASE_FN void ph_ln2(unsigned char* ws, float* out, LAS unsigned char* lds, int wv, int l) { Frame F = make_frame(ws, out, lds, wv); ln_phase<2>(F, l); }
PHASE_FN void ph_plegate(unsigned char* ws, float* out, LAS unsigned char* lds, int wv, int l) { Frame F = make_frame(ws, out, lds, wv);
    if (l & 1) route_build(F, l >> 1);
    SchedGrid S{(const char*)(ws + WS_XB), (const char*)(ws + WS_WPG + l * SZ_WPG), M / 256, D / 256, F.G, F.bx, T1024};
    EpiBf16Row<2> E{(bf16_t*)(ws + WS_PLE), D, nullptr, 0};
    pg8::gemm_phase<EpiBf16Row<2>, SchedGrid, false>(lds, wv, D, S, E, nullptr); }
PHASE_FN void ph_pleproj(unsigned char* ws, float* out, LAS unsigned char* lds, int wv, int l) { Frame F = make_frame(ws, out, lds, wv);
    SchedGrid S{(const char*)(ws + WS_PB), (const char*)(ws + WS_WPP + l * SZ_WPP), M / 256, D / 256, F.G, F.bx, T256};
    EpiBf16Row<3> E{(bf16_t*)(ws + WS_PLE), D, nullptr, 0};
    pg8::gemm_phase<EpiBf16Row<3>, SchedGrid, false>(lds, wv, PLED, S, E, nullptr); }
PHASE_FN void ph_ffn_up_dense(unsigned char* ws, float* out, LAS unsigned char* lds, int wv, int mi) { Frame F = make_frame(ws, out, lds, wv);
    EpiSwiGLU E{(bf16_t*)(ws + WS_H)};
    SchedGrid S{(const char*)(ws + WS_XB), (const char*)(ws + WS_WGU + mi * SZ_WGU), M / 256, 2 * FF / 256, F.G, F.bx, T1024};
    pg8::gemm_phase<EpiSwiGLU, SchedGrid, false>(lds, wv, D, S, E, nullptr); }
PHASE_FN void ph_ffn_up_moe(unsigned char* ws, float* out, LAS unsigned char* lds, int wv, int mi) { Frame F = make_frame(ws, out, lds, wv);
    EpiSwiGLU E{(bf16_t*)(ws + WS_H)};
    SchedMoe S; S.A = (const char*)(ws + WS_XB); S.B = (const char*)(ws + WS_EWGU); S.nN = 2 * FF / 256; S.G = F.G; S.c = F.bx; S.tstepA = T1024; S.tstepB = T1024; S.gather = true;
    moe_starts(F, mi, S.pstart); S.npan = S.pstart[NE];
    pg8::gemm_phase<EpiSwiGLU, SchedMoe, true>(lds, wv, D, S, E, (const int*)(ws + WS_RTOK)); }
PHASE_FN void ph_ffn_down_dense(unsigned char* ws, float* out, LAS unsigned char* lds, int wv, int mi) { Frame F = make_frame(ws, out, lds, wv);
    SchedGrid S{(const char*)(ws + WS_H), (const char*)(ws + WS_WD + mi * SZ_WD), M / 256, D / 256, F.G, F.bx, T3584};
    EpiResF32<1> E{(const float*)(ws + WS_YB), (float*)(ws + WS_YB), (const bf16_t*)(ws + WS_PLE)};
    pg8::gemm_phase<EpiResF32<1>, SchedGrid, false>(lds, wv, FF, S, E, nullptr); }
PHASE_FN void ph_ffn_down_moe(unsigned char* ws, float* out, LAS unsigned char* lds, int wv, int mi) { Frame F = make_frame(ws, out, lds, wv);
    SchedMoe S; S.A = (const char*)(ws + WS_H); S.B = (const char*)(ws + WS_EWD); S.nN = D / 256; S.G = F.G; S.c = F.bx; S.tstepA = T3584; S.tstepB = T3584; S.gather = false;
    moe_starts(F, mi, S.pstart); S.npan = S.pstart[NE];
    EpiMoeDown E{(bf16_t*)out, (const int*)(ws + WS_RDST), (const float*)(ws + WS_RGATE)};
    pg8::gemm_phase<EpiMoeDown, SchedMoe, false>(lds, wv, FF, S, E, nullptr); }

__global__ void __launch_bounds__(NTHR, 2) fwd_kernel(Args args) {
    extern __shared__ __attribute__((aligned(16))) unsigned char lds_raw[];
    LAS unsigned char* lds = (LAS unsigned char*)lds_raw;
    unsigned char* ws = args.ws; float* out = args.out;
    const int wv = __builtin_amdgcn_readfirstlane((int)threadIdx.x >> 6);
    for (int u = phase_tid(wv); u < (LDS_BYTES - LDSCTL_OFF) / 4; u += NTHR) ((LAS unsigned*)(lds + LDSCTL_OFF))[u] = 0u;
    __syncthreads();
#if MK_SINGLE
    XcdBarrier bar = xcd_barrier_post((unsigned*)(ws + WS_CTL) + CW_BAR, (volatile LAS unsigned*)(lds + MISC_OFF) + 8, phase_tid(wv));
#define RUN(k) (true)
#define SEAM() do { XcdBarrier b_ = bar; asm volatile("" : "+s"(b_.bar), "+s"(b_.x)); xcd_barrier(b_, phase_tid(wv)); } while (0)
#else
    const int ph = args.ph;
#define RUN(k) (ph == (k))
#define SEAM() do { } while (0)
#endif
    if (RUN(0)) ph_prologue(ws, out, lds, wv);
    SEAM();
#pragma unroll 1
    for (int l = 0; l < DEPTH; ++l) {
        const int pb = 1 + l * NPH; const bool moe = (l & 1) != 0; const int mi = l >> 1;
        _Pragma("unroll") for (int r_ = 0; r_ < NREP(0); ++r_) { if (RUN(pb + 0)) ph_inproj(ws, out, lds, wv, l);
        SEAM(); }
#if DBG_CHECK == 2
        if (l == 0) dbg_entry(ws, out, lds, wv, INP(0), INP(3));
#endif
        _Pragma("unroll") for (int r_ = 0; r_ < NREP(1); ++r_) { if (RUN(pb + 1)) ph_thin(ws, out, lds, wv, l);
        SEAM(); }
#if DBG_CHECK == 3
        if (l == 0) { Frame F = make_frame(ws, out, lds, wv); dbg_conv(F); }
#endif
        _Pragma("unroll") for (int r_ = 0; r_ < NREP(2); ++r_) { if (RUN(pb + 2)) ph_attn(ws, out, lds, wv);
        SEAM(); }
#if DBG_CHECK == 1
        if (l == 0) dbg_entry(ws, out, lds, wv, INP(2), nullptr);
#endif
        _Pragma("unroll") for (int r_ = 0; r_ < NREP(3); ++r_) { if (RUN(pb + 3)) ph_mixc(ws, out, lds, wv, l);
        SEAM();
        if (RUN(pb + 4)) ph_mixa(ws, out, lds, wv, l);
        SEAM(); }
#if DBG_CHECK == 4
        if (l == 0) { Frame F = make_frame(ws, out, lds, wv); dbg_mix(F); }
#endif
        _Pragma("unroll") for (int r_ = 0; r_ < NREP(5); ++r_) { if (RUN(pb + 5)) ph_outproj(ws, out, lds, wv, l);
        SEAM(); }
#if DBG_CHECK == 5
        if (l == 0) { Frame F = make_frame(ws, out, lds, wv); dbg_out(F); }
        SEAM();
#endif
        if (RUN(pb + 6)) ph_ln1(ws, out, lds, wv, l);
        SEAM();
        _Pragma("unroll") for (int r_ = 0; r_ < NREP(7); ++r_) { if (RUN(pb + 7)) ph_plegate(ws, out, lds, wv, l);
        SEAM();
        if (RUN(pb + 8)) ph_pleproj(ws, out, lds, wv, l);
        SEAM(); }
        _Pragma("unroll") for (int r_ = 0; r_ < NREP(9); ++r_) { if (RUN(pb + 9)) { if (!moe) ph_ffn_up_dense(ws, out, lds, wv, mi); else ph_ffn_up_moe(ws, out, lds, wv, mi); }
        SEAM(); }
        if (RUN(pb + 10)) { if (!moe) ph_ffn_down_dense(ws, out, lds, wv, mi); else ph_ffn_down_moe(ws, out, lds, wv, mi); }
        SEAM();
        if (RUN(pb + 11)) ph_ln2(ws, out, lds, wv, l);
        if (l + 1 < DEPTH) SEAM();
    }
#if DBG_CHECK
    SEAM();
    { Frame F = make_frame(ws, out, lds, wv); dbg_finish(F); }
#endif
#undef RUN
#undef SEAM
}

extern "C" void kernel_launch(void* const* d_in, const int* in_sizes, int n_in, void* d_out, int out_size, void* d_ws, size_t ws_size, hipStream_t stream) {
    static int grid = 0;
    if (grid == 0) {
        if (n_in != 24 || in_sizes[0] != M * D || out_size != M * D || ws_size < WS_END) { fprintf(stderr, "kernel_launch: unexpected problem shape / workspace (%d inputs, ws %zu < %zu)\n", n_in, ws_size, (size_t)WS_END); grid = -1; return; }
        int dev = 0, cus = 0, per_cu = 0;
        if (hipGetDevice(&dev) != hipSuccess || hipDeviceGetAttribute(&cus, hipDeviceAttributeMultiprocessorCount, dev) != hipSuccess) { grid = -1; return; }
        if (hipFuncSetAttribute((const void*)fwd_kernel, hipFuncAttributeMaxDynamicSharedMemorySize, LDS_BYTES) != hipSuccess) { fprintf(stderr, "kernel_launch: hipFuncSetAttribute failed\n"); grid = -1; return; }
        if (hipOccupancyMaxActiveBlocksPerMultiprocessor(&per_cu, (const void*)fwd_kernel, NTHR, LDS_BYTES) != hipSuccess || per_cu < 1) fprintf(stderr, "kernel_launch: occupancy query reports %d\n", per_cu);
        (void)hipGetLastError();
        grid = cus;
    }
    if (grid < 0) return;
    (void)hipMemsetAsync((char*)d_ws + WS_CTL, 0, CTL_ZERO_BYTES, stream);
    Args a{};
    for (int i = 0; i < 24; ++i) a.in[i] = (const float*)d_in[i];
    a.out = (float*)d_out; a.ws = (unsigned char*)d_ws; a.ph = 0; a.pad = 0;
#if MK_SINGLE
    hipLaunchKernelGGL(fwd_kernel, dim3(grid), dim3(NTHR), LDS_BYTES, stream, a);
#else
    for (int ph = 0; ph < N_PHASES; ++ph) { a.ph = ph; hipLaunchKernelGGL(fwd_kernel, dim3(grid), dim3(NTHR), LDS_BYTES, stream, a); }
#endif
}
```

```cpp
#include <hip/hip_runtime.h>
#include <hip/hip_bf16.h>
#include <cstdio>
#include <cstdint>

#ifndef MK_SINGLE
#define MK_SINGLE 1
#endif
#ifndef DBG_CHECK
#define DBG_CHECK 0
#endif
#ifndef DBG_TIME
#define DBG_TIME -1
#endif
#ifndef ATTN_EX
#define ATTN_EX 1
#endif
#ifndef EPI_PROBE
#define EPI_PROBE 0
#endif
#ifndef BAR_PROBE
#define BAR_PROBE 0
#endif
#ifndef ATTN_PROBE
#define ATTN_PROBE 0
#endif
#ifndef REP_MASK
#define REP_MASK 0
#endif
#define NREP(k) ((((REP_MASK) >> (k)) & 1) ? 2 : 1)

#define LAS __attribute__((address_space(3)))
#define GAS __attribute__((address_space(1)))
typedef unsigned short bf16_t;
typedef short bf16x8 __attribute__((ext_vector_type(8)));
typedef short s16x4 __attribute__((ext_vector_type(4)));
typedef float f32x2 __attribute__((ext_vector_type(2)));
typedef float f32x4 __attribute__((ext_vector_type(4)));
typedef float f32x16 __attribute__((ext_vector_type(16)));
typedef unsigned u32x2 __attribute__((ext_vector_type(2)));
typedef unsigned u32x4 __attribute__((ext_vector_type(4)));
typedef __bf16 bf16x2_t __attribute__((ext_vector_type(2)));

constexpr int D = 1024, BATCH = 8, SEQ = 4096, M = BATCH * SEQ, DEPTH = 4;
constexpr int NH = 8, HD = 64, AW = 512, CW = 512, CKW = 31, MOBA = 256, NBLK = SEQ / MOBA;
constexpr int FF = 3584, NE = 8, PLED = 256, NIN = 4608;
constexpr float LN_EPS = 1e-5f;
constexpr float ALPHA = 1.6817928305074290f;
constexpr float LOG2E = 1.4426950408889634f;
constexpr float QSCALE = 0.125f * LOG2E;
constexpr int NWAVES = 8, NTHR = 512;
constexpr int MAXPANEL = 264;
constexpr int MAXROWS = MAXPANEL * 256;

constexpr size_t MiB = 1u << 20;
constexpr size_t WS_CTL = 0, CTL_ZERO_BYTES = 1 * MiB;
constexpr size_t SZ_WIN = (size_t)NIN * D * 2, SZ_WC = (size_t)D * CW * 2, SZ_WA = (size_t)D * AW * 2, SZ_WOUT = (size_t)D * D * 2, SZ_WPG = (size_t)D * D * 2, SZ_WPP = (size_t)D * PLED * 2;
constexpr size_t SZ_WGU = (size_t)2 * FF * D * 2, SZ_WD = (size_t)D * FF * 2;
constexpr size_t WS_WIN = 2 * MiB;
constexpr size_t WS_WC = WS_WIN + DEPTH * SZ_WIN;
constexpr size_t WS_WA = WS_WC + DEPTH * SZ_WC;
constexpr size_t WS_WOUT = WS_WA + DEPTH * SZ_WA;
constexpr size_t WS_WPG = WS_WOUT + DEPTH * SZ_WOUT;
constexpr size_t WS_WPP = WS_WPG + DEPTH * SZ_WPG;
constexpr size_t WS_WGU = WS_WPP + DEPTH * SZ_WPP;
constexpr size_t WS_WD = WS_WGU + 2 * SZ_WGU;
constexpr size_t WS_EWGU = WS_WD + 2 * SZ_WD;
constexpr size_t WS_EWD = WS_EWGU + NE * SZ_WGU;
constexpr size_t WS_XB = WS_EWD + NE * SZ_WD;
constexpr size_t WS_YB = WS_XB + (size_t)M * D * 2;
constexpr size_t WS_PB = WS_YB + (size_t)M * D * 4;
constexpr size_t WS_PLE = WS_PB + (size_t)M * PLED * 2;
constexpr size_t WS_KM = WS_PLE + (size_t)M * D * 2;
constexpr size_t WS_ROUTE = WS_KM + (size_t)128 * 512 * 4;
constexpr size_t WS_RTOK = WS_ROUTE + (size_t)M * 32;
constexpr size_t WS_RDST = WS_RTOK + (size_t)MAXROWS * 4;
constexpr size_t WS_RGATE = WS_RDST + (size_t)MAXROWS * 4;
constexpr size_t WS_ST = WS_RGATE + (size_t)MAXROWS * 4;
constexpr size_t WS_U = ((WS_ST + (size_t)M * 8 + 4095) / 4096) * 4096;
constexpr size_t WS_H0 = WS_U;
constexpr size_t WS_Q = WS_H0 + (size_t)M * 512 * 2;
constexpr size_t WS_K = WS_Q + (size_t)M * 512 * 2;
constexpr size_t WS_VT = WS_K + (size_t)M * 512 * 2;
constexpr size_t WS_SG = WS_VT + (size_t)M * 512 * 2;
constexpr size_t WS_HC = WS_SG + (size_t)M * 2048 * 2;
constexpr size_t WS_HA = WS_HC + (size_t)M * 512 * 2;
constexpr size_t WS_MIX = WS_HA + (size_t)M * 512 * 2;
constexpr size_t WS_U_END_TM = WS_MIX + (size_t)M * D * 2;
constexpr size_t WS_H = WS_U;
constexpr size_t WS_U_END_FF = WS_H + (size_t)MAXROWS * FF * 2;
constexpr size_t WS_PG = ((WS_U_END_FF > WS_U_END_TM ? WS_U_END_FF : WS_U_END_TM) + 4095) / 4096 * 4096;
constexpr size_t WS_END = WS_PG + (size_t)M * D;

constexpr int CW_BAR = 4096;
constexpr int CW_GCNT = 16384;
constexpr int CW_DBG = 32768;

constexpr int RING_BYTES = 131072;
constexpr int LDSCTL_OFF = RING_BYTES, MISC_OFF = LDSCTL_OFF + 320;
constexpr int LDS_BYTES = 147456;

#define RLX_AGENT __ATOMIC_RELAXED, __HIP_MEMORY_SCOPE_AGENT
#define LDS_WAIT() asm volatile("s_waitcnt lgkmcnt(0)" ::: "memory")
#define VM_WAIT() asm volatile("s_waitcnt vmcnt(0)" ::: "memory")

__device__ __forceinline__ unsigned cvtpk(float lo, float hi) { f32x2 v = {lo, hi}; bf16x2_t b = __builtin_convertvector(v, bf16x2_t); return __builtin_bit_cast(unsigned, b); }
__device__ __forceinline__ float bf_lo(unsigned w) { return __uint_as_float(w << 16); }
typedef _Float16 f16x2_t __attribute__((ext_vector_type(2)));
__device__ __forceinline__ unsigned pkh(float lo, float hi) { f16x2_t h = {(_Float16)lo, (_Float16)hi}; return __builtin_bit_cast(unsigned, h); }
__device__ __forceinline__ float h_lo(unsigned w) { return (float)__builtin_bit_cast(f16x2_t, w)[0]; }
__device__ __forceinline__ float h_hi(unsigned w) { return (float)__builtin_bit_cast(f16x2_t, w)[1]; }
__device__ __forceinline__ float bf_hi(unsigned w) { return __uint_as_float(w & 0xffff0000u); }
__device__ __forceinline__ float sigmoidf_(float x) { return __builtin_amdgcn_rcpf(1.0f + __builtin_amdgcn_exp2f(-x * LOG2E)); }

__device__ __forceinline__ int phase_tid(int wv) {
    int w = wv, ln; asm volatile("v_mbcnt_lo_u32_b32 %1, -1, 0\n\tv_mbcnt_hi_u32_b32 %1, -1, %1" : "+s"(w), "=&v"(ln));
    return w * 64 + ln;
}
__device__ __forceinline__ int lane_here() { int ln; asm volatile("v_mbcnt_lo_u32_b32 %0, -1, 0\n\tv_mbcnt_hi_u32_b32 %0, -1, %0" : "=&v"(ln)); return ln; }
namespace pg8 {
constexpr int BM = 256, BK = 64, HALF = 128, HTB = HALF * BK * 2, STAGE_BYTES = 8 * HTB, NXCD = 8, WGM = 8;
__host__ __device__ __forceinline__ int lds_byte(int r, int c) { const int st = (r >> 4) * 2 + (c >> 5), rr = r & 15, cc = c & 31, ob = rr * 64 + cc * 2; return st * 1024 + (ob ^ (((ob >> 9) & 1) << 5)); }
__host__ __device__ __forceinline__ void stage_rc(int b, int& R, int& C) { const int st = b / 1024, sb = b % 1024, swz = sb ^ (((sb >> 9) & 1) << 5); R = (st >> 1) * 16 + swz / 64; C = (st & 1) * 32 + (swz % 64) / 2; }
__host__ __device__ __forceinline__ int perm32(int rho) { const int n = rho >> 4, i = rho & 15; return 8 * (i >> 2) + 4 * n + (i & 3); }

struct Unit { const char* a; const char* b; int pm, pn, ty; };

__device__ __forceinline__ bool static_order(int i, int G, int c, int nM, int nN, int& pm, int& pn) {
    const int nwg = nM * nN; const long L = (long)i * G + c; if (L >= nwg) return false;
    int wgid = (int)L; { const int q = nwg / NXCD, r = nwg % NXCD, xcd = wgid % NXCD, off = wgid / NXCD; wgid = (xcd < r ? xcd * (q + 1) : r * (q + 1) + (xcd - r) * q) + off; }
    const int nig = WGM * nN, gid = wgid / nig, fm = gid * WGM, gsz = (nM - fm) < WGM ? (nM - fm) : WGM;
    pm = fm + ((wgid % nig) % gsz); pn = (wgid % nig) / gsz; return true;
}

template <class Epi, class Sched, bool GATHER>
__device__ __forceinline__ void gemm_phase(LAS unsigned char* lds, const int wv, const int K, const Sched& S, const Epi& E, const int* gidx) {
    const int tid = phase_tid(wv),
              wid = __builtin_amdgcn_readfirstlane(tid >> 6), lane = tid & 63, wr = wid >> 2, wc = wid & 3, fr = lane & 15, fq = lane >> 4;
    const int nt = K / BK;
    const size_t kstep = (size_t)(BK * 2);
    const size_t hstep = (size_t)HALF * K * 2;
    unsigned vA0[2], vA1[2], voffB[2];
#pragma unroll
    for (int i = 0; i < 2; ++i) { int R, C; stage_rc(tid * 16 + i * 8192, R, C); const int Rb = Epi::PERM ? ((R & ~31) + perm32(R & 31)) : R;
        vA0[i] = (unsigned)(R * K + C) * 2u; vA1[i] = vA0[i]; voffB[i] = (unsigned)(Rb * K + C) * 2u; }
    const size_t ah = GATHER ? (size_t)0 : hstep;
    const unsigned ldsw = (unsigned)wid * 1024u;
    const int aoff = lds_byte(wr * 64 + fr, fq * 8), boff = lds_byte(wc * 32 + fr, fq * 8);
#define PG8_SA(b, h) (((b) * 2 + (h)) * HTB)
#define PG8_SB(b, h) ((4 + (b) * 2 + (h)) * HTB)
#define PG8_STAGE(bufoff, gbase, voff) do { _Pragma("unroll") for (int _i = 0; _i < 2; ++_i) \
        __builtin_amdgcn_global_load_lds((const unsigned*)((const char*)(gbase) + (voff)[_i]), (LAS unsigned*)(lds + (bufoff) + ldsw + _i * 8192), 16, 0, 0); } while (0)
#define PG8_LDA(dst, b, h) do { _Pragma("unroll") for (int m = 0; m < 4; ++m) _Pragma("unroll") for (int k = 0; k < 2; ++k) dst[m][k] = *(const LAS bf16x8*)(lds + PG8_SA(b, h) + aoff + m * 2048 + k * 1024); } while (0)
#define PG8_LDB(dst, b, h) do { _Pragma("unroll") for (int n = 0; n < 2; ++n) _Pragma("unroll") for (int k = 0; k < 2; ++k) dst[n][k] = *(const LAS bf16x8*)(lds + PG8_SB(b, h) + boff + n * 2048 + k * 1024); } while (0)
#define PG8_MMA(ai, bj, At, Bt) do { __builtin_amdgcn_s_setprio(1); _Pragma("unroll") for (int m = 0; m < 4; ++m) _Pragma("unroll") for (int n = 0; n < 2; ++n) _Pragma("unroll") for (int k = 0; k < 2; ++k) \
        acc[ai][bj][m][n] = __builtin_amdgcn_mfma_f32_16x16x32_bf16(Bt[n][k], At[m][k], acc[ai][bj][m][n], 0, 0, 0); __builtin_amdgcn_s_setprio(0); } while (0)
#define PG8_WAIT_V(n) asm volatile("s_waitcnt vmcnt(" #n ")" ::: "memory")
#define PG8_WAIT_L(n) asm volatile("s_waitcnt lgkmcnt(" #n ")" ::: "memory")
#define PG8_BAR __builtin_amdgcn_s_barrier()
#define PG8_SCHED __builtin_amdgcn_sched_barrier(0)
    Unit cur, nxt; int ui = 0;
    if (!S.next(0, cur)) return;
#define PG8_GATHER(pm_, o0, o1) do { int t_ = tid; asm volatile("" : "+v"(t_)); _Pragma("unroll") for (int i = 0; i < 2; ++i) { int R, C; stage_rc(t_ * 16 + i * 8192, R, C); const int* gp_ = gidx + (pm_) * BM + R; \
        o0[i] = (unsigned)(gp_[0] * K + C) * 2u; o1[i] = (unsigned)(gp_[HALF] * K + C) * 2u; } } while (0)
    if constexpr (GATHER) PG8_GATHER(cur.pm, vA0, vA1);
    unsigned nA0[2] = {vA0[0], vA0[1]}, nA1[2] = {vA1[0], vA1[1]};
    f32x4 acc[2][2][4][2];
#pragma unroll
    for (int a = 0; a < 2; ++a)
#pragma unroll
        for (int b = 0; b < 2; ++b)
#pragma unroll
            for (int m = 0; m < 4; ++m)
#pragma unroll
                for (int n = 0; n < 2; ++n) acc[a][b][m][n] = (f32x4){0.f, 0.f, 0.f, 0.f};
    bf16x8 At[4][2], B0[2][2], B1[2][2];
    const char* cA = cur.a; const char* cB = cur.b;
    PG8_STAGE(PG8_SB(0, 0), cB, voffB); PG8_STAGE(PG8_SB(0, 1), cB + hstep, voffB); PG8_STAGE(PG8_SA(0, 0), cA, vA0); PG8_STAGE(PG8_SA(0, 1), cA + ah, vA1);
    if (wr == 1) PG8_BAR;
    PG8_WAIT_V(2); PG8_BAR;
    PG8_STAGE(PG8_SB(1, 0), cB + kstep, voffB); PG8_STAGE(PG8_SA(1, 0), cA + kstep, vA0); PG8_STAGE(PG8_SB(1, 1), cB + hstep + kstep, voffB);
    PG8_WAIT_V(6); PG8_BAR;
    for (;;) {
        const bool has_next = S.next(ui + 1, nxt);
        const char* nA = has_next ? nxt.a : cA; const char* nB = has_next ? nxt.b : cB;
        if constexpr (GATHER) {
            if (has_next) PG8_GATHER(nxt.pm, nA0, nA1);
        }
        for (int t = 0; t < nt; t += 2) {
            const bool last = (t == nt - 2);
            const char* a1 = cA + (size_t)(t + 1) * kstep;
            const char* a2 = last ? nA : cA + (size_t)(t + 2) * kstep; const char* b2 = last ? nB : cB + (size_t)(t + 2) * kstep;
            const char* a3 = a2 + kstep; const char* b3 = b2 + kstep;
            unsigned w0[2], w1[2];
            if constexpr (GATHER) { w0[0] = last ? nA0[0] : vA0[0]; w0[1] = last ? nA0[1] : vA0[1]; w1[0] = last ? nA1[0] : vA1[0]; w1[1] = last ? nA1[1] : vA1[1]; }
            else { w0[0] = vA0[0]; w0[1] = vA0[1]; w1[0] = vA1[0]; w1[1] = vA1[1]; }
            PG8_LDB(B0, 0, 0); PG8_LDB(B1, 0, 1); PG8_SCHED; PG8_LDA(At, 0, 0); PG8_STAGE(PG8_SA(1, 1), a1 + ah, vA1);
            PG8_WAIT_V(8); PG8_WAIT_L(0); PG8_BAR; PG8_MMA(0, 0, At, B0); PG8_MMA(0, 1, At, B1); PG8_BAR; PG8_SCHED;
            PG8_LDA(At, 0, 1); PG8_STAGE(PG8_SB(0, 0), b2, voffB); PG8_STAGE(PG8_SB(0, 1), b2 + hstep, voffB); PG8_STAGE(PG8_SA(0, 0), a2, w0);
            PG8_WAIT_V(8); PG8_WAIT_L(0); PG8_BAR; PG8_MMA(1, 0, At, B0); PG8_MMA(1, 1, At, B1); PG8_BAR; PG8_SCHED;
            PG8_LDB(B0, 1, 0); PG8_LDB(B1, 1, 1); PG8_SCHED; PG8_LDA(At, 1, 0); PG8_STAGE(PG8_SA(0, 1), a2 + ah, w1);
            PG8_WAIT_V(8); PG8_WAIT_L(0); PG8_BAR; PG8_MMA(0, 0, At, B0); PG8_MMA(0, 1, At, B1); PG8_BAR; PG8_SCHED;
            PG8_LDA(At, 1, 1); PG8_STAGE(PG8_SB(1, 0), b3, voffB); PG8_STAGE(PG8_SB(1, 1), b3 + hstep, voffB); PG8_STAGE(PG8_SA(1, 0), a3, w0);
            PG8_WAIT_V(8); PG8_WAIT_L(0); PG8_BAR; PG8_MMA(1, 0, At, B0); PG8_MMA(1, 1, At, B1); PG8_BAR; PG8_SCHED;
        }
        if (wr == 0) PG8_BAR;
        { const int le_ = lane_here(); E(acc, cur, wr, wc, le_ & 15, le_ >> 4); }
        if (EPI_PROBE && Epi::REPEATABLE) { asm volatile("" ::: "memory"); E(acc, cur, wr, wc, fr, fq); }
        if (!has_next) break;
#pragma unroll
        for (int a = 0; a < 2; ++a)
#pragma unroll
            for (int b = 0; b < 2; ++b)
#pragma unroll
                for (int m = 0; m < 4; ++m)
#pragma unroll
                    for (int n = 0; n < 2; ++n) acc[a][b][m][n] = (f32x4){0.f, 0.f, 0.f, 0.f};
        cur = nxt; cA = nA; cB = nB; ++ui;
        if constexpr (GATHER) { vA0[0] = nA0[0]; vA0[1] = nA0[1]; vA1[0] = nA1[0]; vA1[1] = nA1[1]; }
        if (wr == 1) PG8_BAR;
    }
    PG8_WAIT_V(0);
    PG8_BAR;
#undef PG8_GATHER
#undef PG8_SA
#undef PG8_SB
#undef PG8_STAGE
#undef PG8_LDA
#undef PG8_LDB
#undef PG8_MMA
#undef PG8_WAIT_V
#undef PG8_WAIT_L
#undef PG8_BAR
#undef PG8_SCHED
}
}

#define XB_TMO      128
#define XB_XCNT(j)  (256  + 64 * (j))
#define XB_XSUB(j)  (1280 + 64 * (j))
#define XB_XGEN(j)  (2304 + 64 * (j))
#define XB_TOP      3328
#define XB_TOPGEN   3392
#define XCD_BAR_WORDS 3456
#define XB_SPIN_CAP (1u << 22)
__device__ __forceinline__ unsigned xb_ld(unsigned* p)              { return __hip_atomic_load(p, __ATOMIC_RELAXED, __HIP_MEMORY_SCOPE_AGENT); }
__device__ __forceinline__ unsigned xb_add(unsigned* p, unsigned v) { return __hip_atomic_fetch_add(p, v, __ATOMIC_RELAXED, __HIP_MEMORY_SCOPE_AGENT); }
__device__ __forceinline__ unsigned xb_xcc_id() { return (unsigned)__builtin_amdgcn_s_getreg((3 << 11) | 20) & 0xFu; }
#define XB_SPIN(cond, bar) do { unsigned _sp = 0; while (cond) { __builtin_amdgcn_s_sleep(1); \
    if ((++_sp & 255u) == 0u) { if (xb_ld(&(bar)[XB_TMO])) break; if (_sp > XB_SPIN_CAP) { atomicAdd(&(bar)[XB_TMO], 1u); break; } } } } while (0)
struct XcdBarrier { unsigned* bar; unsigned x; volatile LAS unsigned* st; };
__device__ __forceinline__ XcdBarrier xcd_barrier_post(unsigned* bar, volatile LAS unsigned* st, int tid) {
    XcdBarrier b; b.bar = bar; b.x = xb_xcc_id(); b.st = st;
    if (tid == 0) (void)xb_add(&bar[XB_XCNT(b.x)], 1u);
    return b;
}
__device__ __forceinline__ void xcd_barrier_complete(unsigned* bar, unsigned x, unsigned& nloc, unsigned& nx) {
    const unsigned G = gridDim.x * gridDim.y * gridDim.z;
    unsigned sum, cnt, mine, sp = 0u;
    for (;;) {
        sum = 0u; cnt = 0u; mine = 0u;
#pragma unroll
        for (unsigned j = 0; j < 16; ++j) { const unsigned c = xb_ld(&bar[XB_XCNT(j)]); sum += c; cnt += (c > 0u) ? 1u : 0u; mine = (j == x) ? c : mine; }
        if (sum == G) break;
        __builtin_amdgcn_s_sleep(1);
        if ((++sp & 255u) == 0u) { if (xb_ld(&bar[XB_TMO])) break; if (sp > XB_SPIN_CAP) { atomicAdd(&bar[XB_TMO], 1u); break; } }
    }
    nloc = mine > 0u ? mine : 1u; nx = cnt > 0u ? cnt : 1u;
}
__device__ __forceinline__ void xcd_barrier(const XcdBarrier& b, int tid) {
    asm volatile("s_waitcnt vmcnt(0)" ::: "memory");
    __syncthreads();
    if (tid == 0) {
        unsigned* bar = b.bar;
        __builtin_amdgcn_s_waitcnt(0);
        unsigned nloc = b.st[0], nx = b.st[1];
        if (nloc == 0u) { xcd_barrier_complete(bar, b.x, nloc, nx); b.st[0] = nloc; b.st[1] = nx; }
        const unsigned old = xb_add(&bar[XB_XSUB(b.x)], 1u);
        const unsigned gen = old / nloc;
        if (old + 1u == (gen + 1u) * nloc) {
            __builtin_amdgcn_fence(__ATOMIC_RELEASE, "agent");
            asm volatile("s_waitcnt vmcnt(0)" ::: "memory");
            const unsigned og = xb_add(&bar[XB_TOP], 1u);
            const unsigned tg = og / nx;
            if (og + 1u == (tg + 1u) * nx) xb_add(&bar[XB_TOPGEN], 1u);
            else XB_SPIN(xb_ld(&bar[XB_TOPGEN]) == tg, bar);
            __builtin_amdgcn_fence(__ATOMIC_ACQUIRE, "agent");
            xb_add(&bar[XB_XGEN(b.x)], 1u);
            asm volatile("s_waitcnt vmcnt(0)" ::: "memory");
        } else {
            XB_SPIN(xb_ld(&bar[XB_XGEN(b.x)]) == gen, bar);
            __builtin_amdgcn_fence(__ATOMIC_ACQUIRE, "agent");
            asm volatile("s_waitcnt vmcnt(0)" ::: "memory");
        }
    }
    __syncthreads();
}

struct Frame {
    LAS unsigned char* lds;
    volatile LAS unsigned* MISC;
    unsigned* ctl;
    int tid, lane, wave, G, vcu, bx;
    unsigned char* ws;
    float* out;
};
__device__ __forceinline__ Frame make_frame(unsigned char* ws, float* out, LAS unsigned char* lds, int wv);
#define INP(i) in_ptr<(i)>()
template <int I> __device__ __forceinline__ const float* in_ptr() {
    const float* p; auto ka = __builtin_amdgcn_kernarg_segment_ptr();
    asm volatile("s_load_dwordx2 %0, %1, %2\n\ts_waitcnt lgkmcnt(0)" : "=s"(p) : "s"(ka), "i"(I * 8) : "memory");
    return p;
}

__device__ __forceinline__ float shfl_xor_(float v, int mask, int lane) { return __int_as_float(__builtin_amdgcn_ds_bpermute((lane ^ mask) << 2, __float_as_int(v))); }
__device__ __forceinline__ float wave_sum(float v) {
#define WS_DPP(x, ctrl, rmask) __int_as_float(__builtin_amdgcn_update_dpp(0, __float_as_int(x), (ctrl), (rmask), 0xf, false))
    v += WS_DPP(v, 0xB1, 0xf);
    v += WS_DPP(v, 0x4E, 0xf);
    v += WS_DPP(v, 0x141, 0xf);
    v += WS_DPP(v, 0x140, 0xf);
    v += WS_DPP(v, 0x142, 0xa);
    v += WS_DPP(v, 0x143, 0xc);
#undef WS_DPP
    return __int_as_float(__builtin_amdgcn_readlane(__float_as_int(v), 63));
}

using pg8::Unit;
struct EpiInProj {
    static constexpr bool PERM = true, REPEATABLE = false;
    bf16_t *H0, *Q, *Kb, *VT; unsigned char* SG;
    __device__ __forceinline__ void operator()(const f32x4 (&acc)[2][2][4][2], const Unit& u, int wr, int wc, int fr, int fq) const {
        int r0 = wr * 64 + fr, c0 = wc * 32 + 8 * fq; asm volatile("" : "+v"(r0), "+v"(c0));
        if (u.ty == 0) {
#pragma unroll
            for (int ai = 0; ai < 2; ++ai)
#pragma unroll
                for (int m = 0; m < 4; ++m) { const size_t row = (size_t)u.pm * 256 + ai * 128 + m * 16 + r0;
                    f32x4 a0 = acc[ai][0][m][0], a1 = acc[ai][0][m][1], g0 = acc[ai][1][m][0], g1 = acc[ai][1][m][1];
                    u32x4 w; w.x = cvtpk(a0[0] * sigmoidf_(g0[0]), a0[1] * sigmoidf_(g0[1])); w.y = cvtpk(a0[2] * sigmoidf_(g0[2]), a0[3] * sigmoidf_(g0[3]));
                    w.z = cvtpk(a1[0] * sigmoidf_(g1[0]), a1[1] * sigmoidf_(g1[1])); w.w = cvtpk(a1[2] * sigmoidf_(g1[2]), a1[3] * sigmoidf_(g1[3]));
                    *(u32x4*)(H0 + row * 512 + u.pn * 128 + c0) = w; }
        } else {
            if (u.ty == 4) {
                const int colb = (u.pn - 10) * 256;
#pragma unroll
                for (int ai = 0; ai < 2; ++ai)
#pragma unroll
                    for (int m = 0; m < 4; ++m) { unsigned char* rp = SG + (size_t)(u.pm * 256 + ai * 128 + m * 16 + r0) * 2048 + colb + c0;
#pragma unroll
                        for (int bj = 0; bj < 2; ++bj) { const f32x4 v0 = acc[ai][bj][m][0], v1 = acc[ai][bj][m][1]; u32x2 w = {0u, 0u};
#pragma unroll
                            for (int j = 0; j < 4; ++j) { w.x = __builtin_amdgcn_cvt_pk_u8_f32(__builtin_rintf(255.0f * sigmoidf_(v0[j])), j, w.x); w.y = __builtin_amdgcn_cvt_pk_u8_f32(__builtin_rintf(255.0f * sigmoidf_(v1[j])), j, w.y); }
                            *(u32x2*)(rp + bj * 128) = w; } }
            } else {
            bf16_t* base; size_t ld; int rowb, colb; float sc = 1.0f;
            if (u.ty == 1)      { base = Q;  ld = 512;  rowb = u.pm * 256; colb = (u.pn - 4) * 256; sc = QSCALE; }
            else if (u.ty == 2) { base = Kb; ld = 512;  rowb = u.pm * 256; colb = (u.pn - 6) * 256; }
            else                { base = VT; ld = 512;  rowb = u.pm * 256; colb = (u.pn - 8) * 256; }
#pragma unroll
            for (int ai = 0; ai < 2; ++ai)
#pragma unroll
                for (int m = 0; m < 4; ++m) { bf16_t* rp = base + (size_t)(rowb + ai * 128 + m * 16 + r0) * ld + colb + c0;
#pragma unroll
                    for (int bj = 0; bj < 2; ++bj) { const f32x4 v0 = acc[ai][bj][m][0] * sc, v1 = acc[ai][bj][m][1] * sc;
                        u32x4 w; w.x = cvtpk(v0[0], v0[1]); w.y = cvtpk(v0[2], v0[3]); w.z = cvtpk(v1[0], v1[1]); w.w = cvtpk(v1[2], v1[3]);
                        *(u32x4*)(rp + bj * 128) = w; } }
            }
        }
    }
};
template <int MODE> struct EpiBf16Row {
    static constexpr bool PERM = true, REPEATABLE = false;
    bf16_t* O; int ldo; const unsigned char* G; int ldg; unsigned char* GO;
    __device__ __forceinline__ void operator()(const f32x4 (&acc)[2][2][4][2], const Unit& u, int wr, int wc, int fr, int fq) const {
        int r0 = wr * 64 + fr, c0 = u.pn * 256 + wc * 32 + 8 * fq; asm volatile("" : "+v"(r0), "+v"(c0));
#pragma unroll
        for (int ai = 0; ai < 2; ++ai)
#pragma unroll
            for (int m = 0; m < 4; ++m) { const size_t row = (size_t)u.pm * 256 + ai * 128 + m * 16 + r0;
#pragma unroll
                for (int bj = 0; bj < 2; ++bj) { f32x4 v0 = acc[ai][bj][m][0], v1 = acc[ai][bj][m][1];
                    bf16_t* op = O + row * ldo + c0 + bj * 128;
                    if (MODE == 0 || MODE == 1) { const u32x2 g = *(const u32x2*)(G + row * ldg + c0 + bj * 128); const float k = 1.0f / 255.0f;
                        v0[0] *= k * (float)((g.x >> 0) & 0xffu); v0[1] *= k * (float)((g.x >> 8) & 0xffu); v0[2] *= k * (float)((g.x >> 16) & 0xffu); v0[3] *= k * (float)((g.x >> 24) & 0xffu);
                        v1[0] *= k * (float)((g.y >> 0) & 0xffu); v1[1] *= k * (float)((g.y >> 8) & 0xffu); v1[2] *= k * (float)((g.y >> 16) & 0xffu); v1[3] *= k * (float)((g.y >> 24) & 0xffu); }
                    if (MODE == 1) { const u32x4 o = *(const u32x4*)op;
                        v0[0] += bf_lo(o.x); v0[1] += bf_hi(o.x); v0[2] += bf_lo(o.y); v0[3] += bf_hi(o.y); v1[0] += bf_lo(o.z); v1[1] += bf_hi(o.z); v1[2] += bf_lo(o.w); v1[3] += bf_hi(o.w); }
                    if (MODE == 2) { u32x2 w8 = {0u, 0u};
#pragma unroll
                        for (int j = 0; j < 4; ++j) { w8.x = __builtin_amdgcn_cvt_pk_u8_f32(__builtin_rintf(255.0f * sigmoidf_(v0[j])), j, w8.x); w8.y = __builtin_amdgcn_cvt_pk_u8_f32(__builtin_rintf(255.0f * sigmoidf_(v1[j])), j, w8.y); }
                        *(u32x2*)(GO + row * 1024 + c0 + bj * 128) = w8; continue; }
                    u32x4 w; w.x = cvtpk(v0[0], v0[1]); w.y = cvtpk(v0[2], v0[3]); w.z = cvtpk(v1[0], v1[1]); w.w = cvtpk(v1[2], v1[3]);
                    *(u32x4*)op = w; } }
    }
};
struct EpiSwiGLU {
    static constexpr bool PERM = true, REPEATABLE = true;
    bf16_t* H;
    __device__ __forceinline__ void operator()(const f32x4 (&acc)[2][2][4][2], const Unit& u, int wr, int wc, int fr, int fq) const {
        int r0 = wr * 64 + fr, c0 = u.pn * 128 + wc * 32 + 8 * fq; asm volatile("" : "+v"(r0), "+v"(c0));
#pragma unroll
        for (int ai = 0; ai < 2; ++ai)
#pragma unroll
            for (int m = 0; m < 4; ++m) { const size_t row = (size_t)u.pm * 256 + ai * 128 + m * 16 + r0;
                const f32x4 g0 = acc[ai][0][m][0], g1 = acc[ai][0][m][1], u0 = acc[ai][1][m][0], u1 = acc[ai][1][m][1];
                float h0[4], h1[4];
#pragma unroll
                for (int j = 0; j < 4; ++j) { h0[j] = g0[j] * sigmoidf_(g0[j]) * u0[j]; h1[j] = g1[j] * sigmoidf_(g1[j]) * u1[j]; }
                u32x4 w; w.x = cvtpk(h0[0], h0[1]); w.y = cvtpk(h0[2], h0[3]); w.z = cvtpk(h1[0], h1[1]); w.w = cvtpk(h1[2], h1[3]);
                *(u32x4*)(H + row * FF + c0) = w; }
    }
};
template <int MODE> struct EpiResF32 {
    static constexpr bool PERM = true, REPEATABLE = false;
    const float* Xin; unsigned short* Y; const bf16_t* P; const float* ST; const float* G; const float* B;
    __device__ __forceinline__ void operator()(const f32x4 (&acc)[2][2][4][2], const Unit& u, int wr, int wc, int fr, int fq) const {
        int r0 = wr * 64 + fr, c0 = u.pn * 256 + wc * 32 + 8 * fq; asm volatile("" : "+v"(r0), "+v"(c0));
        f32x4 gv[2][2], bv[2][2];
        if (!Xin) {
#pragma unroll
            for (int bj = 0; bj < 2; ++bj)
#pragma unroll
                for (int n = 0; n < 2; ++n) { gv[bj][n] = *(const f32x4*)(G + c0 + bj * 128 + n * 4); bv[bj][n] = *(const f32x4*)(B + c0 + bj * 128 + n * 4); }
        }
#pragma unroll
        for (int ai = 0; ai < 2; ++ai)
#pragma unroll
            for (int m = 0; m < 4; ++m) { const size_t row = (size_t)u.pm * 256 + ai * 128 + m * 16 + r0; const size_t off = row * D + c0;
                f32x2 st = {0.f, 1.f}; if (!Xin) st = *(const f32x2*)(ST + row * 2);
#pragma unroll
                for (int bj = 0; bj < 2; ++bj) { const size_t o = off + bj * 128;
                    f32x4 x0, x1;
                    if (Xin) { x0 = *(const f32x4*)(Xin + o); x1 = *(const f32x4*)(Xin + o + 4); }
                    else { const u32x4 yh = *(const u32x4*)(Y + o);
                        x0[0] = h_lo(yh.x); x0[1] = h_hi(yh.x); x0[2] = h_lo(yh.y); x0[3] = h_hi(yh.y); x1[0] = h_lo(yh.z); x1[1] = h_hi(yh.z); x1[2] = h_lo(yh.w); x1[3] = h_hi(yh.w);
                        x0 = (x0 - st[0]) * st[1] * gv[bj][0] + bv[bj][0]; x1 = (x1 - st[0]) * st[1] * gv[bj][1] + bv[bj][1]; }
                    f32x4 v0 = acc[ai][bj][m][0] + x0 * ALPHA, v1 = acc[ai][bj][m][1] + x1 * ALPHA;
                    if (MODE == 1) { const u32x4 p = *(const u32x4*)(P + o);
                        v0[0] += bf_lo(p.x); v0[1] += bf_hi(p.x); v0[2] += bf_lo(p.y); v0[3] += bf_hi(p.y); v1[0] += bf_lo(p.z); v1[1] += bf_hi(p.z); v1[2] += bf_lo(p.w); v1[3] += bf_hi(p.w); }
                    u32x4 w; w.x = pkh(v0[0], v0[1]); w.y = pkh(v0[2], v0[3]); w.z = pkh(v1[0], v1[1]); w.w = pkh(v1[2], v1[3]);
                    *(u32x4*)(Y + o) = w; } }
    }
};
struct EpiMoeDown {
    static constexpr bool PERM = true, REPEATABLE = false;
    bf16_t* Ys; const int* rdst; const float* rgate;
    __device__ __forceinline__ void operator()(const f32x4 (&acc)[2][2][4][2], const Unit& u, int wr, int wc, int fr, int fq) const {
        int r0 = wr * 64 + fr, c0 = u.pn * 256 + wc * 32 + 8 * fq; asm volatile("" : "+v"(r0), "+v"(c0));
#pragma unroll
        for (int ai = 0; ai < 2; ++ai)
#pragma unroll
            for (int m = 0; m < 4; ++m) { const int prow = u.pm * 256 + ai * 128 + m * 16 + r0; const int dst = rdst[prow]; const float gt = rgate[prow];
                if (dst >= 0) {
#pragma unroll
                    for (int bj = 0; bj < 2; ++bj) { const f32x4 v0 = acc[ai][bj][m][0] * gt, v1 = acc[ai][bj][m][1] * gt;
                        u32x4 w; w.x = cvtpk(v0[0], v0[1]); w.y = cvtpk(v0[2], v0[3]); w.z = cvtpk(v1[0], v1[1]); w.w = cvtpk(v1[2], v1[3]);
                        *(u32x4*)(Ys + (size_t)dst * D + c0 + bj * 128) = w; } } }
    }
};

struct SchedGrid {
    const char* A; const char* B; int nM, nN, G, c; size_t tstep; bool rev = false;
    __device__ __forceinline__ bool next(int i, Unit& u) const { int pm, pn; if (!pg8::static_order(i, G, c, nM, nN, pm, pn)) return false; if (rev) pm = nM - 1 - pm; u.pm = pm; u.pn = pn; u.ty = 0; u.a = A + (size_t)pm * tstep; u.b = B + (size_t)pn * tstep; return true; }
};
struct SchedInProj {
    const char* X; const char* W; int G, c; size_t tstep;
    __device__ __forceinline__ bool next(int i, Unit& u) const { int pm, pn; if (!pg8::static_order(i, G, c, M / 256, 18, pm, pn)) return false; u.pm = pm; u.pn = pn;
        u.ty = pn < 4 ? 0 : pn < 6 ? 1 : pn < 8 ? 2 : pn < 10 ? 3 : 4;
        const char* xp = X + (size_t)pm * tstep; const char* wp = W + (size_t)pn * tstep;
        u.a = xp; u.b = wp; return true; }
};
struct SchedMoe {
    const char* A; const char* B; int npan, nN, G, c; size_t tstepA, tstepB; int pstart[NE + 1]; bool gather; bool rev = false;
    __device__ __forceinline__ bool next(int i, Unit& u) const { int pm, pn; if (!pg8::static_order(i, G, c, npan, nN, pm, pn)) return false; if (rev) pm = npan - 1 - pm; u.pm = pm; u.pn = pn; u.ty = 0;
        int e = 0;
#pragma unroll
        for (int j = 1; j < NE; ++j) e += (pm >= pstart[j]) ? 1 : 0;
        u.a = gather ? A : A + (size_t)pm * tstepA; u.b = B + ((size_t)e * nN + pn) * tstepB; return true; }
};

__device__ __forceinline__ void tr_load(f32x4 (&v)[8], const float* W, int ldw, int k0, int c0, int lane) {
    const int lr = lane >> 3, lc = (lane & 7) * 4;
#pragma unroll
    for (int i = 0; i < 8; ++i) v[i] = *(const f32x4*)(W + (size_t)(k0 + 8 * i + lr) * ldw + c0 + lc);
}
__device__ __forceinline__ void tr_store(const f32x4 (&v)[8], int k0, bf16_t* WT, int K, int nrow0, LAS float* scr, int lane) {
    const int lr = lane >> 3, lc = (lane & 7) * 4;
#pragma unroll
    for (int i = 0; i < 8; ++i) { LAS float* d = scr + (8 * i + lr) * 33 + lc; d[0] = v[i][0]; d[1] = v[i][1]; d[2] = v[i][2]; d[3] = v[i][3]; }
    LDS_WAIT(); asm volatile("" ::: "memory");
    const int c = lane & 7;
#pragma unroll
    for (int j = 0; j < 4; ++j) { const int n = (lane >> 3) + 8 * j; const LAS float* s = scr + (8 * c) * 33 + n;
        u32x4 o; o.x = cvtpk(s[0 * 33], s[1 * 33]); o.y = cvtpk(s[2 * 33], s[3 * 33]); o.z = cvtpk(s[4 * 33], s[5 * 33]); o.w = cvtpk(s[6 * 33], s[7 * 33]);
        *(u32x4*)(WT + (size_t)(nrow0 + n) * K + k0 + 8 * c) = o; }
    LDS_WAIT(); asm volatile("" ::: "memory");
}
struct Job { const float* s0; const float* s1; bf16_t* dst; int ld, K, N, fam; };
__device__ __forceinline__ void run_job(Frame& F, const Job& jb, int rot) {
    LAS float* scr = (LAS float*)(F.lds + F.wave * 16384);
    const int NGW = F.G * NWAVES; int gw = (F.vcu * NWAVES + F.wave + rot) % NGW;
    const int nblk = jb.N / 32, nitems = (jb.K / 64) * nblk;
#define TR_DECODE(it_, src_, c0_, n0_, k0_) const int kb_ = (it_) / nblk, nb_ = (it_) - kb_ * nblk; n0_ = nb_ * 32; k0_ = kb_ * 64; src_ = jb.s0; c0_ = n0_; \
        if (jb.fam == 0) { if (n0_ < 1024) { const int t = n0_ >> 8, w = n0_ & 255; c0_ = (w < 128) ? 128 * t + w : 512 + 128 * t + (w - 128); } } \
        else if (jb.fam == 2) { const int t = n0_ >> 8, w = n0_ & 255; src_ = (w < 128) ? jb.s0 : jb.s1; c0_ = 128 * t + (w & 127); }
    f32x4 va[8], vb[8]; int n0a = 0, k0a = 0, n0b = 0, k0b = 0;
    if (gw < nitems) { const float* src; int c0; TR_DECODE(gw, src, c0, n0a, k0a) tr_load(va, src, jb.ld, k0a, c0, F.lane); }
    for (int it = gw; it < nitems; it += 2 * NGW) {
        const bool hb = it + NGW < nitems;
        if (hb) { const float* src; int c0; TR_DECODE(it + NGW, src, c0, n0b, k0b) tr_load(vb, src, jb.ld, k0b, c0, F.lane); }
        tr_store(va, k0a, jb.dst, jb.K, n0a, scr, F.lane);
        if (it + 2 * NGW < nitems) { const float* src; int c0; TR_DECODE(it + 2 * NGW, src, c0, n0a, k0a) tr_load(va, src, jb.ld, k0a, c0, F.lane); }
        if (hb) tr_store(vb, k0b, jb.dst, jb.K, n0b, scr, F.lane);
    }
#undef TR_DECODE
}
__device__ __forceinline__ Job base_job(Frame& F, int j) {
    Job jb; jb.s1 = nullptr; jb.fam = 1;
    if (j < 24) { const int l = j / 6, k = j - l * 6;
        if (k == 0)      { jb.s0 = INP(3) + (size_t)l * D * NIN;  jb.ld = NIN; jb.K = D;    jb.N = NIN; jb.dst = (bf16_t*)(F.ws + WS_WIN + l * SZ_WIN); jb.fam = 0; }
        else if (k == 1) { jb.s0 = INP(8) + (size_t)l * CW * D;   jb.ld = D;   jb.K = CW;   jb.N = D;   jb.dst = (bf16_t*)(F.ws + WS_WC + l * SZ_WC); }
        else if (k == 2) { jb.s0 = INP(9) + (size_t)l * AW * D;   jb.ld = D;   jb.K = AW;   jb.N = D;   jb.dst = (bf16_t*)(F.ws + WS_WA + l * SZ_WA); }
        else if (k == 3) { jb.s0 = INP(10) + (size_t)l * D * D;   jb.ld = D;   jb.K = D;    jb.N = D;   jb.dst = (bf16_t*)(F.ws + WS_WOUT + l * SZ_WOUT); }
        else if (k == 4) { jb.s0 = INP(13) + (size_t)l * D * D;   jb.ld = D;   jb.K = D;    jb.N = D;   jb.dst = (bf16_t*)(F.ws + WS_WPG + l * SZ_WPG); }
        else             { jb.s0 = INP(14) + (size_t)l * PLED * D; jb.ld = D;  jb.K = PLED; jb.N = D;   jb.dst = (bf16_t*)(F.ws + WS_WPP + l * SZ_WPP); }
    } else { const int i = (j - 24) >> 1, k = (j - 24) & 1;
        if (k == 0) { jb.s0 = INP(17) + (size_t)i * D * FF; jb.s1 = INP(18) + (size_t)i * D * FF; jb.ld = FF; jb.K = D; jb.N = 2 * FF; jb.dst = (bf16_t*)(F.ws + WS_WGU + i * SZ_WGU); jb.fam = 2; }
        else        { jb.s0 = INP(19) + (size_t)i * FF * D; jb.ld = D; jb.K = FF; jb.N = D; jb.dst = (bf16_t*)(F.ws + WS_WD + i * SZ_WD); }
    }
    return jb;
}
__device__ __forceinline__ Job expert_job(Frame& F, int mi, int j) {
    Job jb; const int e = j >> 1, k = j & 1; const size_t eo = (size_t)(mi * NE + e) * D * FF;
    if (k == 0) { jb.s0 = INP(21) + eo; jb.s1 = INP(22) + eo; jb.ld = FF; jb.K = D; jb.N = 2 * FF; jb.dst = (bf16_t*)(F.ws + WS_EWGU + e * SZ_WGU); jb.fam = 2; }
    else        { jb.s0 = INP(23) + eo; jb.s1 = nullptr;       jb.ld = D;  jb.K = FF; jb.N = D;     jb.dst = (bf16_t*)(F.ws + WS_EWD + e * SZ_WD);   jb.fam = 1; }
    return jb;
}
__device__ __forceinline__ void cvt_rows(Frame& F, const float* src, bf16_t* dst, size_t n, int part = -1, int nparts = 0) {
    if (part < 0) { part = F.vcu; nparts = F.G; }
    const size_t nch = n / 8, stride = (size_t)nparts * NTHR;
    for (size_t i0 = (size_t)part * NTHR + F.tid; i0 < nch; i0 += 4 * stride) {
        f32x4 a[4], b[4];
#pragma unroll
        for (int u = 0; u < 4; ++u) { const size_t i = i0 + u * stride; if (i < nch) { a[u] = *(const f32x4*)(src + i * 8); b[u] = *(const f32x4*)(src + i * 8 + 4); } }
#pragma unroll
        for (int u = 0; u < 4; ++u) { const size_t i = i0 + u * stride; if (i < nch) { u32x4 w; w.x = cvtpk(a[u][0], a[u][1]); w.y = cvtpk(a[u][2], a[u][3]); w.z = cvtpk(b[u][0], b[u][1]); w.w = cvtpk(b[u][2], b[u][3]); *(u32x4*)(dst + i * 8) = w; } }
    }
}
__device__ __forceinline__ void prologue_phase(Frame& F) {
    for (int j = 0; j < 28; ++j) { const Job jb = base_job(F, j); run_job(F, jb, (j * 397) & 2047); }
    for (int j = 0; j < 16; ++j) { const Job jb = expert_job(F, 0, j); run_job(F, jb, (j * 397 + 100) & 2047); }
    cvt_rows(F, INP(0), (bf16_t*)(F.ws + WS_XB), (size_t)M * D);
}

__device__ __forceinline__ void thin_phase(Frame& F, int l) {
    const int tid = F.tid, lane = F.lane, wave = F.wave;
    {   const bf16_t* Kb = (const bf16_t*)(F.ws + WS_K); float* KM = (float*)(F.ws + WS_KM); LAS float* ps = (LAS float*)F.lds;
        const int GH = F.G / 2;
        if (F.vcu >= GH) cvt_rows(F, INP(1) + (size_t)l * M * PLED, (bf16_t*)(F.ws + WS_PB), (size_t)M * PLED, F.vcu - GH, F.G - GH);
        else for (int u = F.vcu; u < M / 256; u += GH) {
            float s[8] = {0.f, 0.f, 0.f, 0.f, 0.f, 0.f, 0.f, 0.f};
#pragma unroll 1
            for (int i0 = 0; i0 < 32; i0 += 16) { u32x4 kv[16];
#pragma unroll
                for (int i = 0; i < 16; ++i) kv[i] = *(const u32x4*)(Kb + ((size_t)u * 256 + wave + 8 * (i0 + i)) * 512 + lane * 8);
#pragma unroll
                for (int i = 0; i < 16; ++i) { const u32x4 v = kv[i];
                    s[0] += bf_lo(v.x); s[1] += bf_hi(v.x); s[2] += bf_lo(v.y); s[3] += bf_hi(v.y); s[4] += bf_lo(v.z); s[5] += bf_hi(v.z); s[6] += bf_lo(v.w); s[7] += bf_hi(v.w); } }
            __syncthreads();
#pragma unroll
            for (int j = 0; j < 8; ++j) ps[wave * 512 + lane * 8 + j] = s[j];
            __syncthreads();
            float t = 0.f;
#pragma unroll
            for (int w = 0; w < 8; ++w) t += ps[w * 512 + tid];
            KM[(size_t)u * 512 + tid] = t * (1.0f / 256.0f);
        }
        __syncthreads();
    }
    {   const bf16_t* H0 = (const bf16_t*)(F.ws + WS_H0); bf16_t* HC = (bf16_t*)(F.ws + WS_HC);
        LAS float* wl = (LAS float*)F.lds; LAS bf16_t* xt = (LAS bf16_t*)(F.lds + 63488);
        const float* cw = INP(4) + (size_t)l * CKW * CW;
        { f32x4 wv8[8];
#pragma unroll
          for (int k = 0; k < 8; ++k) { const int i = tid + k * NTHR; if (i < CKW * CW / 4) wv8[k] = ((const f32x4*)cw)[i]; }
#pragma unroll
          for (int k = 0; k < 8; ++k) { const int i = tid + k * NTHR; if (i < CKW * CW / 4) { const int j_ = i >> 7, q_ = i & 127; ((LAS f32x4*)wl)[(j_ * 2 + (q_ & 1)) * 64 + (q_ >> 1)] = wv8[k]; } } }
        const f32x4 cb0 = *(const f32x4*)(INP(5) + l * CW + lane * 8), cb1 = *(const f32x4*)(INP(5) + l * CW + lane * 8 + 4);
        const f32x4 lg0 = *(const f32x4*)(INP(6) + l * CW + lane * 8), lg1 = *(const f32x4*)(INP(6) + l * CW + lane * 8 + 4);
        const f32x4 lb0 = *(const f32x4*)(INP(7) + l * CW + lane * 8), lb1 = *(const f32x4*)(INP(7) + l * CW + lane * 8 + 4);
        u32x4 xv8[8];
#define CONV_LOAD(u_) do { const int b_ = (u_) / (SEQ / 32), t0_ = ((u_) % (SEQ / 32)) * 32; _Pragma("unroll") for (int k = 0; k < 8; ++k) { const int i = tid + k * NTHR, row = i >> 6, ch = i & 63, t = t0_ - 30 + row; \
            xv8[k] = (u32x4){0u, 0u, 0u, 0u}; if (i < 62 * 64 && t >= 0) xv8[k] = *(const u32x4*)(H0 + ((size_t)(b_ * SEQ + t)) * 512 + ch * 8); } } while (0)
        if (F.vcu < BATCH * (SEQ / 32)) CONV_LOAD(F.vcu);
        for (int u = F.vcu; u < BATCH * (SEQ / 32); u += F.G) {
            const int b = u / (SEQ / 32), t0 = (u % (SEQ / 32)) * 32;
            __syncthreads();
#pragma unroll
            for (int k = 0; k < 8; ++k) { const int i = tid + k * NTHR, row = i >> 6, ch = i & 63; if (i < 62 * 64) *(LAS u32x4*)(xt + row * 512 + ch * 8) = xv8[k]; }
            __syncthreads();
            if (u + F.G < BATCH * (SEQ / 32)) CONV_LOAD(u + F.G);
            float acc[4][8];
#pragma unroll
            for (int tt = 0; tt < 4; ++tt)
#pragma unroll
                for (int c = 0; c < 8; ++c) acc[tt][c] = 0.f;
#pragma unroll 4
            for (int j = 0; j < CKW; ++j) {
                const f32x4 w0 = *(const LAS f32x4*)(wl + (j * 2) * 256 + lane * 4), w1 = *(const LAS f32x4*)(wl + (j * 2 + 1) * 256 + lane * 4);
#pragma unroll
                for (int tt = 0; tt < 4; ++tt) { const u32x4 xv = *(const LAS u32x4*)(xt + (wave * 4 + tt + j) * 512 + lane * 8);
                    acc[tt][0] += w0[0] * bf_lo(xv.x); acc[tt][1] += w0[1] * bf_hi(xv.x); acc[tt][2] += w0[2] * bf_lo(xv.y); acc[tt][3] += w0[3] * bf_hi(xv.y);
                    acc[tt][4] += w1[0] * bf_lo(xv.z); acc[tt][5] += w1[1] * bf_hi(xv.z); acc[tt][6] += w1[2] * bf_lo(xv.w); acc[tt][7] += w1[3] * bf_hi(xv.w); }
            }
#pragma unroll
            for (int tt = 0; tt < 4; ++tt) {
                float v[8]; float s = 0.f;
#pragma unroll
                for (int c = 0; c < 8; ++c) { v[c] = acc[tt][c] + (c < 4 ? cb0[c] : cb1[c - 4]); s += v[c]; }
                const float mean = wave_sum(s) * (1.0f / CW); float q = 0.f;
#pragma unroll
                for (int c = 0; c < 8; ++c) { v[c] -= mean; q += v[c] * v[c]; }
                const float rstd = 1.0f / sqrtf(wave_sum(q) * (1.0f / CW) + LN_EPS);
#pragma unroll
                for (int c = 0; c < 8; ++c) { const float y = v[c] * rstd * (c < 4 ? lg0[c] : lg1[c - 4]) + (c < 4 ? lb0[c] : lb1[c - 4]); v[c] = y * sigmoidf_(y); }
                u32x4 w; w.x = cvtpk(v[0], v[1]); w.y = cvtpk(v[2], v[3]); w.z = cvtpk(v[4], v[5]); w.w = cvtpk(v[6], v[7]);
                *(u32x4*)(HC + ((size_t)(b * SEQ + t0 + wave * 4 + tt)) * 512 + lane * 8) = w;
            }
        }
#undef CONV_LOAD
        __syncthreads();
    }
    if (l == 2) { for (int j = 0; j < 16; ++j) { const Job jb = expert_job(F, 1, j); run_job(F, jb, (j * 397) & 2047); } }
}

template <int MODE> __device__ __forceinline__ void ln_phase(Frame& F, int l, bool dummy) {
    const int tid = F.tid, lane = F.lane, wave = F.wave; const bool moe = (l & 1) != 0; const bool route = (MODE == 1) && moe && !dummy; const int mi = l >> 1;
    unsigned short* YB = (unsigned short*)(F.ws + WS_YB); bf16_t* XB = (bf16_t*)(F.ws + WS_XB);
    const float* gp = (MODE == 1 ? INP(11) : INP(15)) + l * D; const float* bp = (MODE == 1 ? INP(12) : INP(16)) + l * D;
    f32x4 g[4], bb[4], g1[4], b1v[4];
#pragma unroll
    for (int j = 0; j < 4; ++j) { g[j] = *(const f32x4*)(gp + 4 * lane + 256 * j); bb[j] = *(const f32x4*)(bp + 4 * lane + 256 * j); }
    if (MODE == 2 && moe) { const float* g1p = INP(11) + l * D; const float* b1p = INP(12) + l * D;
#pragma unroll
        for (int j = 0; j < 4; ++j) { g1[j] = *(const f32x4*)(g1p + 4 * lane + 256 * j); b1v[j] = *(const f32x4*)(b1p + 4 * lane + 256 * j); } }
    float* ST = (float*)(F.ws + WS_ST);
    LAS float* wr = (LAS float*)F.lds;
    LAS float* rt = (LAS float*)(F.lds + 32768);
    LAS int* lcnt = (LAS int*)(F.lds + 32768 + 2048);
    LAS int* lrk = (LAS int*)(F.lds + 32768 + 2048 + 64);
    if (route) { const float* rw = INP(20) + (size_t)mi * D * NE;
        f32x4 rv[4];
#pragma unroll
        for (int q = 0; q < 4; ++q) rv[q] = ((const f32x4*)rw)[tid + q * NTHR];
#pragma unroll
        for (int q = 0; q < 4; ++q) { const int i = tid + q * NTHR, kk = i >> 1, hf = i & 1, j_ = kk >> 8, ln_ = (kk & 255) >> 2, kp_ = kk & 3; ((LAS f32x4*)wr)[((j_ * 4 + kp_) * 2 + hf) * 64 + ln_] = rv[q]; }
        if (tid < 8) lcnt[tid] = 0; __syncthreads(); }
    for (int c = F.vcu; c < M / 128; c += F.G) {
        const bf16_t* Pp = (const bf16_t*)(F.ws + WS_PLE); const bf16_t* Ysp = (const bf16_t*)F.out;
        u32x2 nv[4], np[4], ny0[4], ny1[4]; f32x2 nst;
#define LN_LOAD(rw) do { _Pragma("unroll") for (int j = 0; j < 4; ++j) { nv[j] = *(const u32x2*)(YB + (rw) * D + 4 * lane + 256 * j); \
            if (MODE == 2 && moe) { if (j == 0) nst = *(const f32x2*)(ST + (rw) * 2); np[j] = *(const u32x2*)(Pp + (rw) * D + 4 * lane + 256 * j); ny0[j] = *(const u32x2*)(Ysp + (2 * (rw)) * D + 4 * lane + 256 * j); ny1[j] = *(const u32x2*)(Ysp + (2 * (rw) + 1) * D + 4 * lane + 256 * j); } } } while (0)
        LN_LOAD((size_t)c * 8 + wave);
        for (int i = 0; i < 16; ++i) {
            const int rl = wave + 8 * i; const size_t row = (size_t)i * (M / 16) + (size_t)c * 8 + wave;
            f32x4 v[4]; float s = 0.f;
#pragma unroll
            for (int j = 0; j < 4; ++j) { v[j][0] = h_lo(nv[j].x); v[j][1] = h_hi(nv[j].x); v[j][2] = h_lo(nv[j].y); v[j][3] = h_hi(nv[j].y); }
            if (MODE == 2 && moe) {
#pragma unroll
                for (int j = 0; j < 4; ++j) { const u32x2 p = np[j], y0 = ny0[j], y1 = ny1[j];
                    v[j] = (v[j] - nst[0]) * nst[1] * g1[j] + b1v[j];
                    v[j][0] = v[j][0] * ALPHA + bf_lo(p.x) + bf_lo(y0.x) + bf_lo(y1.x); v[j][1] = v[j][1] * ALPHA + bf_hi(p.x) + bf_hi(y0.x) + bf_hi(y1.x);
                    v[j][2] = v[j][2] * ALPHA + bf_lo(p.y) + bf_lo(y0.y) + bf_lo(y1.y); v[j][3] = v[j][3] * ALPHA + bf_hi(p.y) + bf_hi(y0.y) + bf_hi(y1.y); }
            }
            if (MODE == 2 && moe && l != DEPTH - 1) {
#pragma unroll
                for (int j = 0; j < 4; ++j) { u32x2 w; w.x = pkh(v[j][0], v[j][1]); w.y = pkh(v[j][2], v[j][3]); *(u32x2*)(YB + row * D + 4 * lane + 256 * j) = w;
                    v[j][0] = h_lo(w.x); v[j][1] = h_hi(w.x); v[j][2] = h_lo(w.y); v[j][3] = h_hi(w.y); } }
            if (i + 1 < 16) LN_LOAD(row + M / 16);
#pragma unroll
            for (int j = 0; j < 4; ++j) s += (v[j][0] + v[j][1]) + (v[j][2] + v[j][3]);
            const float mean = wave_sum(s) * (1.0f / D); float q = 0.f;
#pragma unroll
            for (int j = 0; j < 4; ++j) { v[j] = v[j] - mean; q += (v[j][0] * v[j][0] + v[j][1] * v[j][1]) + (v[j][2] * v[j][2] + v[j][3] * v[j][3]); }
            const float rstd = 1.0f / sqrtf(wave_sum(q) * (1.0f / D) + LN_EPS);
            const bool last = (MODE == 2) && (l == DEPTH - 1); bf16_t* ob = XB; (void)dummy;
            if (lane == 0) *(f32x2*)(ST + row * 2) = (f32x2){mean, rstd};
#pragma unroll
            for (int j = 0; j < 4; ++j) { v[j] = v[j] * rstd * g[j] + bb[j]; if (last) *(f32x4*)(F.out + row * D + 4 * lane + 256 * j) = v[j];
                u32x2 w; w.x = cvtpk(v[j][0], v[j][1]); w.y = cvtpk(v[j][2], v[j][3]); if (!last) *(u32x2*)(ob + row * D + 4 * lane + 256 * j) = w; }
            if (route) {
                float lg[NE];
#pragma unroll
                for (int e = 0; e < NE; ++e) lg[e] = 0.f;
#pragma unroll
                for (int j = 0; j < 4; ++j)
#pragma unroll
                    for (int k = 0; k < 4; ++k) { const f32x4 w0 = *(const LAS f32x4*)(wr + (((j * 4 + k) * 2 + 0) * 64 + lane) * 4), w1 = *(const LAS f32x4*)(wr + (((j * 4 + k) * 2 + 1) * 64 + lane) * 4); const float xv = v[j][k];
                        lg[0] += xv * w0[0]; lg[1] += xv * w0[1]; lg[2] += xv * w0[2]; lg[3] += xv * w0[3]; lg[4] += xv * w1[0]; lg[5] += xv * w1[1]; lg[6] += xv * w1[2]; lg[7] += xv * w1[3]; }
#pragma unroll
                for (int e = 0; e < NE; ++e) lg[e] = wave_sum(lg[e]);
                float b1 = lg[0]; int i1 = 0;
#pragma unroll
                for (int e = 1; e < NE; ++e) if (lg[e] > b1) { b1 = lg[e]; i1 = e; }
                float b2 = -INFINITY; int i2 = 0;
#pragma unroll
                for (int e = 0; e < NE; ++e) if (e != i1 && lg[e] > b2) { b2 = lg[e]; i2 = e; }
                const float p1 = 1.0f / (1.0f + __expf(b2 - b1));
                if (lane == 0) { rt[rl * 4 + 0] = __int_as_float(i1); rt[rl * 4 + 1] = __int_as_float(i2); rt[rl * 4 + 2] = p1; rt[rl * 4 + 3] = 1.0f - p1; }
            }
        }
#undef LN_LOAD
        if (route) {
            __syncthreads();
            int e1 = 0, e2 = 0;
            if (tid < 128) { e1 = __float_as_int(rt[tid * 4 + 0]); e2 = __float_as_int(rt[tid * 4 + 1]); lrk[tid * 2 + 0] = atomicAdd((int*)&lcnt[e1], 1); lrk[tid * 2 + 1] = atomicAdd((int*)&lcnt[e2], 1); }
            __syncthreads();
            if (tid < 8) { const int n = lcnt[tid]; lcnt[8 + tid] = (int)__hip_atomic_fetch_add(F.ctl + CW_GCNT + (mi * NE + tid) * 64, (unsigned)n, RLX_AGENT); }
            __syncthreads();
            if (tid < 128) { int* ro = (int*)(F.ws + WS_ROUTE) + ((size_t)(tid >> 3) * (M / 16) + (size_t)c * 8 + (tid & 7)) * 8;
                ro[0] = e1; ro[1] = e2; ro[2] = lcnt[8 + e1] + lrk[tid * 2 + 0]; ro[3] = lcnt[8 + e2] + lrk[tid * 2 + 1]; ((float*)ro)[4] = rt[tid * 4 + 2]; ((float*)ro)[5] = rt[tid * 4 + 3]; }
            __syncthreads();
            if (tid < 8) lcnt[tid] = 0;
            __syncthreads();
        }
    }
}
__device__ __forceinline__ void moe_starts(Frame& F, int mi, int (&pstart)[NE + 1]) {
    int acc = 0;
#pragma unroll
    for (int e = 0; e < NE; ++e) { pstart[e] = acc; const int n = (int)__hip_atomic_load(F.ctl + CW_GCNT + (mi * NE + e) * 64, RLX_AGENT); acc += (n + 255) >> 8; }
    pstart[NE] = acc;
}
__device__ __forceinline__ void route_build(Frame& F, int mi) {
    int pstart[NE + 1]; moe_starts(F, mi, pstart);
    int* rtok = (int*)(F.ws + WS_RTOK); int* rdst = (int*)(F.ws + WS_RDST); float* rgate = (float*)(F.ws + WS_RGATE);
    for (int t = F.vcu * NTHR + F.tid; t < M; t += F.G * NTHR) { const int* ro = (const int*)(F.ws + WS_ROUTE) + (size_t)t * 8;
        int e1 = ro[0], e2 = ro[1], r1 = ro[2], r2 = ro[3]; const float p1 = ((const float*)ro)[4], p2 = ((const float*)ro)[5];
        int s1 = 0, s2 = 0;
#pragma unroll
        for (int e = 0; e < NE; ++e) { s1 = (e == e1) ? pstart[e] : s1; s2 = (e == e2) ? pstart[e] : s2; }
        const int q1 = s1 * 256 + r1, q2 = s2 * 256 + r2;
        rtok[q1] = t; rdst[q1] = 2 * t; rgate[q1] = p1; rtok[q2] = t; rdst[q2] = 2 * t + 1; rgate[q2] = p2; }
    if (F.vcu < NE) { const int e = F.vcu; const int n = (int)__hip_atomic_load(F.ctl + CW_GCNT + (mi * NE + e) * 64, RLX_AGENT);
        for (int q = pstart[e] * 256 + n + F.tid; q < pstart[e + 1] * 256; q += NTHR) { rtok[q] = 0; rdst[q] = -1; rgate[q] = 0.f; } }
}

__device__ __forceinline__ int crow(int r, int hi) { return (r & 3) + 8 * (r >> 2) + 4 * hi; }
__device__ __forceinline__ float pl32_max(float m) { auto rr = __builtin_amdgcn_permlane32_swap(__float_as_uint(m), __float_as_uint(m), false, false); return fmaxf(__uint_as_float(rr[0]), __uint_as_float(rr[1])); }
__device__ __forceinline__ float pl32_sum(float m) { auto rr = __builtin_amdgcn_permlane32_swap(__float_as_uint(m), __float_as_uint(m), false, false); return __uint_as_float(rr[0]) + __uint_as_float(rr[1]); }
__device__ __forceinline__ int rel_bucket_dev(int n) {
    if (n < 16) return n;
    const int large = 16 + (int)(__log2f((float)n * (1.0f / 16.0f)) * (16.0f / 3.0f));
    return large < 31 ? large : 31;
}
constexpr int AT_TILE = 8192, AT_SLOT = 2 * AT_TILE, AT_K = 0, AT_V = 3 * AT_SLOT, AT_LUT = 6 * AT_SLOT, AT_WSF = AT_LUT + 512, AT_END = AT_WSF + NWAVES * 256, AT_OST = 0;
static_assert(AT_END <= RING_BYTES, "attention LDS");
constexpr float AT_THR = 8.0f;
typedef short v4i16_t __attribute__((ext_vector_type(4)));
__device__ __forceinline__ float max3f_(float a, float b, float c) { return __builtin_fmaxf(__builtin_fmaxf(a, b), c); }
__device__ __forceinline__ void at_qk(f32x16& p0, f32x16& p1, const LAS unsigned char* kb, const bf16x8 (&qf)[4], float cinit) {
#pragma unroll
    for (int x = 0; x < 16; ++x) { p0[x] = cinit; p1[x] = cinit; }
#pragma unroll
    for (int d0 = 0; d0 < 4; ++d0) {
        const bf16x8 a0 = *(const LAS bf16x8*)(kb + d0 * 2048), a1 = *(const LAS bf16x8*)(kb + d0 * 2048 + 512);
        p0 = __builtin_amdgcn_mfma_f32_32x32x16_bf16(a0, qf[d0], p0, 0, 0, 0);
        p1 = __builtin_amdgcn_mfma_f32_32x32x16_bf16(a1, qf[d0], p1, 0, 0, 0);
    }
}
__device__ __forceinline__ void attn_phase(Frame& F) {
    const int tid = F.tid, lane = F.lane, wid = F.wave, r = lane & 31, hh = lane >> 5;
    const bf16_t* Q = (const bf16_t*)(F.ws + WS_Q); const bf16_t* Kb = (const bf16_t*)(F.ws + WS_K); const bf16_t* Vb = (const bf16_t*)(F.ws + WS_VT);
    const float* KM = (const float*)(F.ws + WS_KM); bf16_t* HA = (bf16_t*)(F.ws + WS_HA); const float* rel_bias = INP(2);
    LAS unsigned char* L = F.lds; LAS float* lut = (LAS float*)(L + AT_LUT); LAS float* wsf = (LAS float*)(L + AT_WSF) + wid * 64; LAS bf16_t* ost = (LAS bf16_t*)(L + AT_OST) + wid * 2048;
    const int kdo = lane * 512 + wid * 8;
    const int vdo = (16 * (wid & 3) + (lane >> 2)) * 512 + (wid >> 2) * 32 + (lane & 3) * 8;
    const int kro = hh * 1024 + r * 16;
    const int vro = ((lane >> 4) & 1) * 32 + (lane & 3) * 8 + (4 * hh + ((lane & 15) >> 2)) * 64;
    for (int n = F.vcu; n < BATCH * NH * NBLK; n += F.G) {
        const int ii = n >> 8, w = n & 255, bh = w >> 2, s4 = w & 3; const int qb = (ii == 0) ? s4 : (ii == 1) ? 7 - s4 : (ii == 2) ? 8 + s4 : 15 - s4;
        const int b = bh >> 3, h = bh & 7;
        const int q0 = qb * 256 + wid * 32;
        const bf16_t* Kh = Kb + (size_t)b * SEQ * 512 + h * 64; const bf16_t* Vh = Vb + (size_t)b * SEQ * 512 + h * 64;
        const int NS = 2 * (qb + 1);
#define AT_KP(i) (((i) < 2) ? qb * 256 + (i) * 128 : ((i) - 2) * 128)
#define AT_DMA(i) do { const int kp_ = AT_KP(i); const int sl_ = ((i) % 3) * AT_SLOT; _Pragma("unroll") for (int t_ = 0; t_ < 2; ++t_) { \
            __builtin_amdgcn_global_load_lds((const unsigned*)(Kh + (size_t)(kp_ + 64 * t_) * 512 + kdo), (LAS unsigned*)(L + AT_K + sl_ + t_ * AT_TILE + wid * 1024), 16, 0, 0); \
            __builtin_amdgcn_global_load_lds((const unsigned*)(Vh + (size_t)(kp_ + 64 * t_) * 512 + vdo), (LAS unsigned*)(L + AT_V + sl_ + t_ * AT_TILE + wid * 1024), 16, 0, 0); } } while (0)
        asm volatile("s_waitcnt vmcnt(0)" ::: "memory");
        __syncthreads();
        if (tid < 128) lut[tid] = rel_bias[rel_bucket_dev(tid) * NH + h] * LOG2E;
        AT_DMA(0); AT_DMA(1);
        bf16x8 qf[4];
#pragma unroll
        for (int d0 = 0; d0 < 4; ++d0) qf[d0] = *(const bf16x8*)(Q + ((size_t)(b * SEQ + q0 + r)) * 512 + h * 64 + d0 * 16 + hh * 8);
        unsigned selmask = 0u;
        if (qb > 0) {
            f32x16 sc;
#pragma unroll
            for (int i = 0; i < 16; ++i) sc[i] = 0.f;
#pragma unroll
            for (int d0 = 0; d0 < 4; ++d0) {
                f32x4 k0 = {0.f, 0.f, 0.f, 0.f}, k1 = {0.f, 0.f, 0.f, 0.f};
                if (r < 16) { const float* kp = KM + ((size_t)(b * NBLK + r)) * 512 + h * 64 + d0 * 16 + hh * 8; k0 = *(const f32x4*)kp; k1 = *(const f32x4*)(kp + 4); }
                u32x4 hi4, lo4;
                hi4.x = cvtpk(k0[0], k0[1]); hi4.y = cvtpk(k0[2], k0[3]); hi4.z = cvtpk(k1[0], k1[1]); hi4.w = cvtpk(k1[2], k1[3]);
                lo4.x = cvtpk(k0[0] - bf_lo(hi4.x), k0[1] - bf_hi(hi4.x)); lo4.y = cvtpk(k0[2] - bf_lo(hi4.y), k0[3] - bf_hi(hi4.y));
                lo4.z = cvtpk(k1[0] - bf_lo(hi4.z), k1[1] - bf_hi(hi4.z)); lo4.w = cvtpk(k1[2] - bf_lo(hi4.w), k1[3] - bf_hi(hi4.w));
                sc = __builtin_amdgcn_mfma_f32_32x32x16_bf16(__builtin_bit_cast(bf16x8, hi4), qf[d0], sc, 0, 0, 0);
                sc = __builtin_amdgcn_mfma_f32_32x32x16_bf16(__builtin_bit_cast(bf16x8, lo4), qf[d0], sc, 0, 0, 0);
            }
            float full[16];
#pragma unroll
            for (int g = 0; g < 8; ++g) { const float mine = sc[g], other = shfl_xor_(mine, 32, lane);
                full[crow(g, 0)] = hh ? other : mine; full[crow(g, 1)] = hh ? mine : other; }
#pragma unroll
            for (int p = 0; p < 3; ++p) { float best = -INFINITY; int bi = -1;
#pragma unroll
                for (int j = 0; j < 16; ++j) { const bool ok = (j < qb) && !((selmask >> j) & 1u) && (full[j] > best); best = ok ? full[j] : best; bi = ok ? j : bi; }
                if (bi >= 0) selmask |= 1u << bi; }
        }
        float mref = 0.f, l_run = 0.f; f32x16 o0, o1; bool first = true;
#pragma unroll
        for (int i = 0; i < 16; ++i) { o0[i] = 0.f; o1[i] = 0.f; }
        const float bconst = rel_bias[31 * NH + h] * LOG2E;
        for (int i = 0; i < NS; ++i) {
            if (i + 1 < NS) asm volatile("s_waitcnt vmcnt(4) lgkmcnt(0)" ::: "memory"); else asm volatile("s_waitcnt vmcnt(0) lgkmcnt(0)" ::: "memory");
            __builtin_amdgcn_s_barrier(); asm volatile("" ::: "memory");
            if (i + 2 < NS) AT_DMA(i + 2);
            const int sl = (i % 3) * AT_SLOT; const bool own = i < 2; const int kpA = AT_KP(i), kpB = kpA + 64; const int jblk = (i - 2) >> 1;
            const bool sel = own ? true : (((selmask >> jblk) & 1u) != 0u);
            const bool doA = own ? !(i * 128 > wid * 32 + 31) : __any(sel), doB = own ? !(i * 128 + 64 > wid * 32 + 31) : doA;
            if (doA && ATTN_PROBE != 1) {
                const bool lutA = own || (q0 - (kpA + 63) < 113), lutB = own || (q0 - (kpB + 63) < 113);
                const float cc = sel ? bconst - mref : -INFINITY;
                f32x16 a0, a1, b0, b1;
                at_qk(a0, a1, L + AT_K + sl + kro, qf, lutA ? -mref : cc);
                if (doB) at_qk(b0, b1, L + AT_K + sl + AT_TILE + kro, qf, lutB ? -mref : cc);
                else {
#pragma unroll
                    for (int x = 0; x < 16; ++x) { b0[x] = -INFINITY; b1[x] = -INFINITY; } }
#define AT_BIAS(P0, P1, KP) do { const int qpos = q0 + r; \
                    _Pragma("unroll") for (int x = 0; x < 16; ++x) { const int d0_ = qpos - ((KP) + crow(x, hh)), d1_ = d0_ - 32; \
                        float e0 = lut[d0_ < 0 ? 0 : (d0_ > 127 ? 127 : d0_)], e1 = lut[d1_ < 0 ? 0 : (d1_ > 127 ? 127 : d1_)]; asm volatile("" : "+v"(e0), "+v"(e1));     \
                        P0[x] = (d0_ < 0 || !sel) ? -INFINITY : P0[x] + e0; P1[x] = (d1_ < 0 || !sel) ? -INFINITY : P1[x] + e1; } } while (0)
                if (lutA) AT_BIAS(a0, a1, kpA);
                if (doB && lutB) AT_BIAS(b0, b1, kpB);
#undef AT_BIAS
                float mt0 = __builtin_fmaxf(a0[0], a1[0]), mt1 = __builtin_fmaxf(b0[0], b1[0]);
#pragma unroll
                for (int x = 1; x < 16; ++x) { mt0 = max3f_(mt0, a0[x], a1[x]); mt1 = max3f_(mt1, b0[x], b1[x]); }
                const float mt = pl32_max(__builtin_fmaxf(mt0, mt1));
                if (__any(first ? true : (mt > AT_THR))) {
                    const float dl = first ? mt : __builtin_fmaxf(mt, 0.f); const float alpha = first ? 0.f : __builtin_amdgcn_exp2f(-dl);
                    mref += dl; l_run *= alpha;
                    if (hh == 0) wsf[r] = alpha;
#pragma unroll
                    for (int x = 0; x < 16; ++x) { const float a_ = wsf[crow(x, hh)]; o0[x] *= a_; o1[x] *= a_; a0[x] -= dl; a1[x] -= dl; b0[x] -= dl; b1[x] -= dl; }
                    first = false;
                }
                float ls0 = 0.f, ls1 = 0.f, ls2 = 0.f, ls3 = 0.f;
#pragma unroll
                for (int x = 0; x < 16; ++x) { a0[x] = __builtin_amdgcn_exp2f(a0[x]); a1[x] = __builtin_amdgcn_exp2f(a1[x]); b0[x] = __builtin_amdgcn_exp2f(b0[x]); b1[x] = __builtin_amdgcn_exp2f(b1[x]);
                    ls0 += a0[x]; ls1 += a1[x]; ls2 += b0[x]; ls3 += b1[x]; }
                l_run += (ls0 + ls1) + (ls2 + ls3);
                const LAS unsigned char* va = L + AT_V + sl + vro; const LAS unsigned char* vbp = va + AT_TILE;
#define AT_PACK(P, B) (u32x4){cvtpk(P[B], P[B + 1]), cvtpk(P[B + 2], P[B + 3]), cvtpk(P[B + 4], P[B + 5]), cvtpk(P[B + 6], P[B + 7])}
#define AT_VFRAG(ptr) ({ const v4i16_t lo_ = __builtin_amdgcn_ds_read_tr16_b64_v4i16((LAS v4i16_t*)(ptr)), hi_ = __builtin_amdgcn_ds_read_tr16_b64_v4i16((LAS v4i16_t*)((ptr) + 512)); \
                    (bf16x8){lo_[0], lo_[1], lo_[2], lo_[3], hi_[0], hi_[1], hi_[2], hi_[3]}; })
#pragma unroll
                for (int ks = 0; ks < 4; ++ks) {
                    const u32x4 pa = (ks == 0) ? AT_PACK(a0, 0) : (ks == 1) ? AT_PACK(a0, 8) : (ks == 2) ? AT_PACK(a1, 0) : AT_PACK(a1, 8);
                    const bf16x8 fa = AT_VFRAG(va + ks * 1024), fb = AT_VFRAG(va + 4096 + ks * 1024);
                    o0 = __builtin_amdgcn_mfma_f32_32x32x16_bf16(__builtin_bit_cast(bf16x8, pa), fa, o0, 0, 0, 0);
                    o1 = __builtin_amdgcn_mfma_f32_32x32x16_bf16(__builtin_bit_cast(bf16x8, pa), fb, o1, 0, 0, 0);
                    if (doB) {
                        const u32x4 pb = (ks == 0) ? AT_PACK(b0, 0) : (ks == 1) ? AT_PACK(b0, 8) : (ks == 2) ? AT_PACK(b1, 0) : AT_PACK(b1, 8);
                        const bf16x8 fc = AT_VFRAG(vbp + ks * 1024), fd = AT_VFRAG(vbp + 4096 + ks * 1024);
                        o0 = __builtin_amdgcn_mfma_f32_32x32x16_bf16(__builtin_bit_cast(bf16x8, pb), fc, o0, 0, 0, 0);
                        o1 = __builtin_amdgcn_mfma_f32_32x32x16_bf16(__builtin_bit_cast(bf16x8, pb), fd, o1, 0, 0, 0);
                    }
                }
#undef AT_PACK
#undef AT_VFRAG
            }
        }
        const float lt = (ATTN_PROBE == 1) ? 1.0f : pl32_sum(l_run);
        if (hh == 0) wsf[r] = 1.0f / lt;
        asm volatile("s_waitcnt lgkmcnt(0)" ::: "memory"); __builtin_amdgcn_s_barrier(); asm volatile("" ::: "memory");
#pragma unroll
        for (int x = 0; x < 16; ++x) { const int qq = crow(x, hh); const float a = wsf[qq];
            ost[qq * 64 + r] = (bf16_t)(cvtpk(o0[x] * a, 0.f) & 0xffffu); ost[qq * 64 + 32 + r] = (bf16_t)(cvtpk(o1[x] * a, 0.f) & 0xffffu); }
        bf16_t* Ow = HA + ((size_t)(b * SEQ + q0)) * 512 + h * 64;
#pragma unroll
        for (int i = 0; i < 4; ++i) { const int row = i * 8 + (lane >> 3), ch = lane & 7; const u32x4 v = *(const LAS u32x4*)(ost + row * 64 + ch * 8); *(u32x4*)(Ow + (size_t)row * 512 + ch * 8) = v; }
#undef AT_KP
#undef AT_DMA
    }
    __syncthreads();
}
namespace attn_ex {
using bf16=__hip_bfloat16;
using bf16x8=__attribute__((ext_vector_type(8)))short;
using s16x4=__attribute__((ext_vector_type(4)))short;
using f32x16=__attribute__((ext_vector_type(16)))float;
using u32x4=__attribute__((ext_vector_type(4)))unsigned;
constexpr int BATCH=8,NHEAD=8,SEQ=4096,D=64,DM=NHEAD*D;
constexpr int NW=8,QBLK=32,QB=QBLK*NW,KVBLK=64,NQB=SEQ/QB;
constexpr int ATTN_PITCH=DM, ATTN_UNIT_ROWS=QB;
__device__ __forceinline__ int crow(int r,int hi){return (r&3)+8*(r>>2)+4*hi;}
#define SBAR() __builtin_amdgcn_sched_barrier(0)
__device__ __forceinline__ void cmask(f32x16&p0,f32x16&p1,int jb,int qrel,int hi){
  const float NEG=-INFINITY; int kb=64*jb+4*hi;
  #pragma unroll
  for(int r=0;r<16;++r){int kv=kb+(r&3)+8*(r>>2); if(kv>qrel)p0[r]=NEG; if(kv+32>qrel)p1[r]=NEG;}
}


__device__ __forceinline__ void lutmask(f32x16&p0,f32x16&p1,int kp,int qpos,bool sel,int hi,const __attribute__((address_space(3))) float*lut){
  const float NEG=-INFINITY;
  #pragma unroll
  for(int r=0;r<16;++r){ const int d0=qpos-(kp+crow(r,hi)), d1=d0-32;
    float e0=lut[d0<0?0:(d0>127?127:d0)], e1=lut[d1<0?0:(d1>127?127:d1)]; asm volatile("":"+v"(e0),"+v"(e1));
    p0[r]=(d0<0||!sel)?NEG:p0[r]+e0; p1[r]=(d1<0||!sel)?NEG:p1[r]+e1; }
}
constexpr int NSLOT=3, SLOTB=8192;
constexpr int LDS_K=0, LDS_V=NSLOT*SLOTB, LDS_WS=2*NSLOT*SLOTB, LDS_OST=LDS_WS+NW*64*4, LDS_LUT=LDS_OST+NW*4096, LDS_BYTES=LDS_LUT+512;
constexpr float C2=0.125f*1.4426950408889634f;
__device__ __forceinline__ void glds16(const void*gsrc,unsigned lds_dst){unsigned keep;
  asm volatile("s_mov_b32 %0, m0\n\ts_mov_b32 m0, %2\n\ts_nop 0\n\tglobal_load_lds_dwordx4 %1, off\n\ts_mov_b32 m0, %0":"=&s"(keep):"v"(gsrc),"s"(lds_dst):"memory");}
__device__ __forceinline__ float max3f(float a,float b,float c){float r;asm("v_max3_f32 %0, %1, %2, %3":"=v"(r):"v"(a),"v"(b),"v"(c));return r;}
__device__ __forceinline__ float max2f(float a,float b){float r;asm("v_max_f32_e32 %0, %1, %2":"=v"(r):"v"(a),"v"(b));return r;}
__device__ __forceinline__ float fadd_s(float a,float b){float r;asm("v_add_f32_e32 %0, %1, %2":"=v"(r):"v"(a),"v"(b));return r;}
__device__ __forceinline__ float fsub_s(float a,float b){float r;asm("v_sub_f32_e32 %0, %1, %2":"=v"(r):"v"(a),"v"(b));return r;}
typedef float f32x2_t __attribute__((ext_vector_type(2))); typedef __bf16 bf16x2_t __attribute__((ext_vector_type(2)));
__device__ __forceinline__ unsigned cvtpk_s(float lo,float hi){f32x2_t v={lo,hi};bf16x2_t b=__builtin_convertvector(v,bf16x2_t);return __builtin_bit_cast(unsigned,b);}
#define WAIT_BAR(N) asm volatile("s_waitcnt vmcnt(" #N ") lgkmcnt(0)\n\ts_barrier":::"memory")

__device__ __forceinline__ void qkt(f32x16&p0,f32x16&p1,const char*Kslot,const bf16x8*qr,const f32x16&negm,int r32,int hi){
  const char*kb=Kslot+hi*1024+r32*16;
  #pragma unroll
  for(int d0=0;d0<4;++d0){
    const bf16x8 b0=*reinterpret_cast<const bf16x8*>(kb+d0*2048);
    const bf16x8 b1=*reinterpret_cast<const bf16x8*>(kb+d0*2048+512);
    if(d0==0){p0=__builtin_amdgcn_mfma_f32_32x32x16_bf16(b0,qr[0],negm,0,0,0);p1=__builtin_amdgcn_mfma_f32_32x32x16_bf16(b1,qr[0],negm,0,0,0);}
    else{p0=__builtin_amdgcn_mfma_f32_32x32x16_bf16(b0,qr[d0],p0,0,0,0);p1=__builtin_amdgcn_mfma_f32_32x32x16_bf16(b1,qr[d0],p1,0,0,0);}}
}
typedef __attribute__((address_space(3))) const char* lds_cptr;
typedef short v4i16_t __attribute__((ext_vector_type(4)));
__device__ __forceinline__ void kload8(bf16x8*kf,lds_cptr kp){
  kf[0]=*(const __attribute__((address_space(3))) bf16x8*)(kp);      kf[1]=*(const __attribute__((address_space(3))) bf16x8*)(kp+512);
  kf[2]=*(const __attribute__((address_space(3))) bf16x8*)(kp+2048); kf[3]=*(const __attribute__((address_space(3))) bf16x8*)(kp+2560);
  kf[4]=*(const __attribute__((address_space(3))) bf16x8*)(kp+4096); kf[5]=*(const __attribute__((address_space(3))) bf16x8*)(kp+4608);
  kf[6]=*(const __attribute__((address_space(3))) bf16x8*)(kp+6144); kf[7]=*(const __attribute__((address_space(3))) bf16x8*)(kp+6656);
}
__device__ __forceinline__ void kload2(bf16x8*kf,lds_cptr kp,int j){ kf[2*j]=*(const __attribute__((address_space(3))) bf16x8*)(kp+j*2048); kf[2*j+1]=*(const __attribute__((address_space(3))) bf16x8*)(kp+j*2048+512); }
__device__ __forceinline__ s16x4 vtr(lds_cptr p){ return __builtin_bit_cast(s16x4,__builtin_amdgcn_ds_read_tr16_b64_v4i16((__attribute__((address_space(3))) v4i16_t*)p)); }
__device__ __forceinline__ float rowmax(const f32x16&p0,const f32x16&p1){
  float a=max3f(p0[0],p0[1],p1[0]),b=max3f(p0[2],p0[3],p1[1]);a=max3f(a,p1[2],p1[3]);
  #pragma unroll
  for(int r=4;r<16;r+=4){a=max3f(a,p0[r],p0[r+1]);b=max3f(b,p0[r+2],p0[r+3]);a=max3f(a,p1[r],p1[r+1]);b=max3f(b,p1[r+2],p1[r+3]);}
  const float m=max2f(a,b);
  auto rr=__builtin_amdgcn_permlane32_swap(__float_as_uint(m),__float_as_uint(m),false,false);
  return max2f(__uint_as_float(rr[0]),__uint_as_float(rr[1]));
}
__device__ __forceinline__ void pv(f32x16*o,int vb,bf16x8 pa0,bf16x8 pa1,bf16x8 pa2,bf16x8 pa3){
  #pragma unroll
  for(int d0=0;d0<2;++d0){s16x4 lo[4],hi[4];
    #pragma unroll
    for(int ks=0;ks<4;++ks){
      asm volatile("ds_read_b64_tr_b16 %0,%1 offset:%c2":"=&v"(lo[ks]):"v"(vb),"i"(d0*4096+ks*1024):"memory");
      asm volatile("ds_read_b64_tr_b16 %0,%1 offset:%c2":"=&v"(hi[ks]):"v"(vb),"i"(d0*4096+ks*1024+512):"memory");}
    asm volatile("s_waitcnt lgkmcnt(0)":::"memory");SBAR();
    #define PK(k) (bf16x8){lo[k][0],lo[k][1],lo[k][2],lo[k][3],hi[k][0],hi[k][1],hi[k][2],hi[k][3]}
    o[d0]=__builtin_amdgcn_mfma_f32_32x32x16_bf16(pa0,PK(0),o[d0],0,0,0);
    o[d0]=__builtin_amdgcn_mfma_f32_32x32x16_bf16(pa1,PK(1),o[d0],0,0,0);
    o[d0]=__builtin_amdgcn_mfma_f32_32x32x16_bf16(pa2,PK(2),o[d0],0,0,0);
    o[d0]=__builtin_amdgcn_mfma_f32_32x32x16_bf16(pa3,PK(3),o[d0],0,0,0);
    #undef PK
  }
}

#ifndef ATTN_STORE16
#define ATTN_STORE16(p,v) (*(u32x4*)(p)=(v))
#endif
template<int THRL> __device__ __forceinline__ void attn_unit(int b,int h,int qb,const bf16*Q,const bf16*__restrict__ K,const bf16*__restrict__ V,bf16*O,char*shm,const float*KMp,const float*rel_bias,const int tid){
  const int lane=tid&63,r32=lane&31,hi=lane>>5; const int wid=__builtin_amdgcn_readfirstlane(tid>>6);
  const long rowbase=(long)b*SEQ; const int q0=qb*QB;
  const bf16*Qw=Q+(rowbase+q0+wid*QBLK)*DM+h*D;
  const bf16*Kh=K+rowbase*DM+h*D,*Vh=V+rowbase*DM+h*D;
  const unsigned lds0=(unsigned)(uintptr_t)shm;
  float*wsf=(float*)(shm+LDS_WS)+wid*64;
  const bf16*ksrc=Kh+(long)lane*DM+wid*8;
  const bf16*vsrc=Vh+(long)(16*(wid&3)+(lane>>2))*DM+(wid>>2)*32+(lane&3)*8;
  const unsigned kdst=lds0+LDS_K+wid*1024, vdst=lds0+LDS_V+wid*1024;
  #define TPOS(t) (((t)<4)?(q0+64*(t)):(64*((t)-4)))
  #define DMA_K(t,slot) glds16(ksrc+(long)TPOS(t)*DM,(unsigned)__builtin_amdgcn_readfirstlane(kdst+(slot)))
  #define DMA_V(t,slot) glds16(vsrc+(long)TPOS(t)*DM,(unsigned)__builtin_amdgcn_readfirstlane(vdst+(slot)))
  const int vb0=(int)(lds0+LDS_V)+((lane>>4)&1)*32+(lane&3)*8+(4*hi+((lane&15)>>2))*64;
  const char*Kbase=shm+LDS_K; bf16x8 kf[8];
  const lds_cptr shm3=(lds_cptr)shm; const lds_cptr kp0=shm3+LDS_K+hi*1024+r32*16; const lds_cptr vp0=shm3+LDS_V+((lane>>4)&1)*32+(lane&3)*8+(4*hi+((lane&15)>>2))*64;
  const int NT=(q0+QB)/KVBLK;
  const __attribute__((address_space(3))) float*lutp=(const __attribute__((address_space(3))) float*)((lds_cptr)shm+LDS_LUT);
  if(tid<128)((__attribute__((address_space(3))) float*)((__attribute__((address_space(3))) char*)shm+LDS_LUT))[tid]=rel_bias[rel_bucket_dev(tid)*NHEAD+h]*1.4426950408889634f;
  DMA_K(0,0);DMA_V(0,0);DMA_K(1,SLOTB);
  bf16x8 qr[4];
  #pragma unroll
  for(int d0=0;d0<4;++d0)qr[d0]=*reinterpret_cast<const bf16x8*>(&Qw[(long)r32*DM+d0*16+hi*8]);
  unsigned selmask=0u;
  if(qb>0){ f32x16 sc=f32x16{};
    #pragma unroll
    for(int d0=0;d0<4;++d0){ f32x4 k0={0.f,0.f,0.f,0.f},k1={0.f,0.f,0.f,0.f};
      if(r32<16){const float*kp=KMp+((size_t)(b*16+r32))*512+h*64+d0*16+hi*8;k0=*(const f32x4*)kp;k1=*(const f32x4*)(kp+4);}
      u32x4 hi4,lo4; hi4.x=cvtpk_s(k0[0],k0[1]);hi4.y=cvtpk_s(k0[2],k0[3]);hi4.z=cvtpk_s(k1[0],k1[1]);hi4.w=cvtpk_s(k1[2],k1[3]);
      #define BLO(w) __uint_as_float((w)<<16)
      #define BHI(w) __uint_as_float((w)&0xffff0000u)
      lo4.x=cvtpk_s(k0[0]-BLO(hi4.x),k0[1]-BHI(hi4.x));lo4.y=cvtpk_s(k0[2]-BLO(hi4.y),k0[3]-BHI(hi4.y));lo4.z=cvtpk_s(k1[0]-BLO(hi4.z),k1[1]-BHI(hi4.z));lo4.w=cvtpk_s(k1[2]-BLO(hi4.w),k1[3]-BHI(hi4.w));
      #undef BLO
      #undef BHI
      sc=__builtin_amdgcn_mfma_f32_32x32x16_bf16(__builtin_bit_cast(bf16x8,hi4),qr[d0],sc,0,0,0);
      sc=__builtin_amdgcn_mfma_f32_32x32x16_bf16(__builtin_bit_cast(bf16x8,lo4),qr[d0],sc,0,0,0); }
    float full[16];
    #pragma unroll
    for(int g=0;g<8;++g){const float mine=sc[g],other=shfl_xor_(mine,32,lane);full[crow(g,0)]=hi?other:mine;full[crow(g,1)]=hi?mine:other;}
    #pragma unroll
    for(int p=0;p<3;++p){float best=-INFINITY;int bi=-1;
      #pragma unroll
      for(int j=0;j<16;++j){const bool ok=(j<qb)&&!((selmask>>j)&1u)&&(full[j]>best);best=ok?full[j]:best;bi=ok?j:bi;}
      if(bi>=0)selmask|=1u<<bi;} }
  const float bconst=rel_bias[31*NHEAD+h]*1.4426950408889634f;
  #define TSEL(t) (((t)<4)?true:(((selmask>>(((t)-4)>>2))&1u)!=0u))
  #define TCLS(t) (((t)<4) ? ((64*(t)>32*wid+31) ? 2 : ((32*wid-64*(t)-63>=113) ? 1 : 0)) : (((t)>=NT-4) ? ((256+32*wid-64*((t)-(NT-4))-63>=113) ? 1 : 0) : 1))
  #define TLUT(t) (TCLS(t)==0)
  #define SETNEG(t) do{ const int cl_=TCLS(t); const float nm_=(cl_==0)?-mhat:((cl_==2)?-INFINITY:((TSEL(t)?bconst:-INFINITY)-mhat)); _Pragma("unroll") for(int r=0;r<16;++r)negm[r]=nm_; asm volatile("":"+v"(negm)); }while(0)
  float mhat=0.f,l_reg=0.f;f32x16 o[2];o[0]=f32x16{};o[1]=f32x16{};f32x16 negm=f32x16{};asm volatile("":"+v"(negm));
  const int qrel=wid*QBLK+r32;
  #define CMASK(P0,P1,t) do{ if(TLUT(t)) lutmask(P0,P1,TPOS(t),q0+qrel,TSEL(t),hi,lutp); }while(0)
  bool resc=false;
  #define START(P0,P1) do{ const float rm=rowmax(P0,P1); resc=false; \
    { const float dl=rm; mhat=fadd_s(mhat,dl); \
      _Pragma("unroll") for(int r=0;r<16;++r){P0[r]=fsub_s(P0[r],dl);P1[r]=fsub_s(P1[r],dl);} \
      _Pragma("unroll") for(int r=0;r<16;++r)negm[r]=-mhat; asm volatile("":"+v"(negm)); } \
    _Pragma("unroll") for(int r=0;r<16;++r)P0[r]=__builtin_amdgcn_exp2f(P0[r]); }while(0)
  #define RESC() do{ if(resc){ asm volatile("s_waitcnt lgkmcnt(0)":::"memory"); \
      _Pragma("unroll") for(int d_=0;d_<2;++d_) _Pragma("unroll") for(int r=0;r<16;++r)o[d_][r]*=wsf[crow(r,hi)]; } }while(0)
  f32x16 pA0,pA1,pB0,pB1;
  int sl_prev=0,sl_cur=0,sl_next=SLOTB;
  #define ROT() do{sl_prev=sl_cur;sl_cur=sl_next;sl_next=(sl_next==(NSLOT-1)*SLOTB)?0:sl_next+SLOTB;}while(0)
  DMA_K(2,2*SLOTB);
  WAIT_BAR(3);
  SETNEG(0); qkt(pA0,pA1,Kbase,qr,negm,r32,hi);asm volatile("s_nop 15\n\ts_nop 7":"+v"(pA0),"+v"(pA1));CMASK(pA0,pA1,0);
  START(pA0,pA1);
  _Pragma("unroll") for(int r=0;r<16;++r)pA1[r]=__builtin_amdgcn_exp2f(pA1[r]);
  WAIT_BAR(0);
  DMA_K(3,0);DMA_V(1,SLOTB);
  ROT();
  kload8(kf,kp0+sl_cur);
  WAIT_BAR(2);
  s16x4 vlo[8],vhi[8]; u32x4 pw0,pw1,pw2,pw3;
  #define PKW(P,B) cvtpk_s(P[B],P[B+1])
  #define PAF(k) __builtin_bit_cast(bf16x8,pw##k)
  #define VFR(i) (bf16x8){vlo[i][0],vlo[i][1],vlo[i][2],vlo[i][3],vhi[i][0],vhi[i][1],vhi[i][2],vhi[i][3]}
  #define PIN(x) asm volatile("":"+v"(x))
  #define MX3(a,b,c) __builtin_fmaxf(__builtin_fmaxf((a),(b)),(c))
  #define GAPA(MF,A0,A1,A2,A3,W0,W1,PW) do{ MF; sacc+=A0; sacc+=A1; sacc+=A2; sacc+=A3; PIN(sacc); W0; W1; PIN(PW); SBAR(); }while(0)
  #define EX(v) __builtin_amdgcn_exp2f(v)
  #define GAPB(MF,X,B) do{ MF; X[B]=EX(X[B]); X[B+1]=EX(X[B+1]); X[B+2]=EX(X[B+2]); X[B+3]=EX(X[B+3]); PIN(X); SBAR(); }while(0)
  #define VRD(i) do{ vlo[i]=vtr(vp_+(((i)>>2)*4096+((i)&3)*1024)); vhi[i]=vtr(vp_+(((i)>>2)*4096+((i)&3)*1024+512)); }while(0)
  #define KRD(G,j) do{ if(G){ kload2(kf,kp0+sl_next,j); SBAR(); } }while(0)
  #define STEP(C0,C1,P0,P1,t,GK,GV,GL) do{ SETNEG(t); SBAR(); \
    const lds_cptr vp_=vp0+sl_prev; \
    VRD(0); SBAR(); float sacc=(P0[0]+P0[1]); \
    GAPA(C0=__builtin_amdgcn_mfma_f32_32x32x16_bf16(kf[0],qr[0],negm,0,0,0), P0[2],P0[3],P0[4],P0[5],     pw0[0]=PKW(P0,0), pw0[1]=PKW(P0,2), pw0); \
    VRD(4); SBAR(); GAPA(C1=__builtin_amdgcn_mfma_f32_32x32x16_bf16(kf[1],qr[0],negm,0,0,0), P0[6],P0[7],P0[8],P0[9],     pw0[2]=PKW(P0,4), pw0[3]=PKW(P0,6), pw0); \
    VRD(1); SBAR(); GAPA(C0=__builtin_amdgcn_mfma_f32_32x32x16_bf16(kf[2],qr[1],C0,0,0,0),   P0[10],P0[11],P0[12],P0[13], pw1[0]=PKW(P0,8), pw1[1]=PKW(P0,10), pw1); \
    VRD(5); SBAR(); GAPA(C1=__builtin_amdgcn_mfma_f32_32x32x16_bf16(kf[3],qr[1],C1,0,0,0),   P0[14],P0[15],P1[0],P1[1],   pw1[2]=PKW(P0,12),pw1[3]=PKW(P0,14), pw1); \
    VRD(2); SBAR(); GAPA(C0=__builtin_amdgcn_mfma_f32_32x32x16_bf16(kf[4],qr[2],C0,0,0,0),   P1[2],P1[3],P1[4],P1[5],     pw2[0]=PKW(P1,0), pw2[1]=PKW(P1,2), pw2); \
    VRD(6); SBAR(); GAPA(C1=__builtin_amdgcn_mfma_f32_32x32x16_bf16(kf[5],qr[2],C1,0,0,0),   P1[6],P1[7],P1[8],P1[9],     pw2[2]=PKW(P1,4), pw2[3]=PKW(P1,6), pw2); \
    VRD(3); SBAR(); GAPA(C0=__builtin_amdgcn_mfma_f32_32x32x16_bf16(kf[6],qr[3],C0,0,0,0),   P1[10],P1[11],P1[12],P1[13], pw3[0]=PKW(P1,8), pw3[1]=PKW(P1,10), pw3); \
    VRD(7); SBAR(); GAPA(C1=__builtin_amdgcn_mfma_f32_32x32x16_bf16(kf[7],qr[3],C1,0,0,0),   P1[14],P1[15],0.f,0.f,       pw3[2]=PKW(P1,12),pw3[3]=PKW(P1,14), pw3); \
    l_reg+=sacc; \
    if(GK){DMA_K((t)+3,sl_cur);} if(GV){DMA_V((t)+1,sl_next);} \
    CMASK(C0,C1,t); \
    { float a=MX3(C0[0],C0[1],C1[0]),b=MX3(C0[2],C0[3],C1[1]); a=MX3(a,C1[2],C1[3]); \
      _Pragma("unroll") for(int r=4;r<16;r+=4){a=MX3(a,C0[r],C0[r+1]);b=MX3(b,C0[r+2],C0[r+3]);a=MX3(a,C1[r],C1[r+1]);b=MX3(b,C1[r+2],C1[r+3]);} \
      float rm=__builtin_fmaxf(a,b); { auto rr=__builtin_amdgcn_permlane32_swap(__float_as_uint(rm),__float_as_uint(rm),false,false); rm=__builtin_fmaxf(__uint_as_float(rr[0]),__uint_as_float(rr[1])); } \
      resc=false; \
      if(__builtin_expect(__any(rm>(float)THRL),0)){ const float dl=__builtin_fmaxf(rm,0.f); mhat+=dl; \
        _Pragma("unroll") for(int r=0;r<16;++r){C0[r]-=dl;C1[r]-=dl;} \
        _Pragma("unroll") for(int r=0;r<16;++r)negm[r]=-mhat; asm volatile("":"+v"(negm)); \
        const float f=__builtin_amdgcn_exp2f(-dl); l_reg*=f; if(hi==0)wsf[r32]=f; resc=true; } } \
    SBAR(); \
    GAPB(o[0]=__builtin_amdgcn_mfma_f32_32x32x16_bf16(PAF(0),VFR(0),o[0],0,0,0), C0,0); \
    GAPB(o[1]=__builtin_amdgcn_mfma_f32_32x32x16_bf16(PAF(0),VFR(4),o[1],0,0,0), C0,4); \
    KRD(GL,0); GAPB(o[0]=__builtin_amdgcn_mfma_f32_32x32x16_bf16(PAF(1),VFR(1),o[0],0,0,0), C0,8); \
    KRD(GL,1); GAPB(o[1]=__builtin_amdgcn_mfma_f32_32x32x16_bf16(PAF(1),VFR(5),o[1],0,0,0), C0,12); \
    KRD(GL,2); GAPB(o[0]=__builtin_amdgcn_mfma_f32_32x32x16_bf16(PAF(2),VFR(2),o[0],0,0,0), C1,0); \
    KRD(GL,3); GAPB(o[1]=__builtin_amdgcn_mfma_f32_32x32x16_bf16(PAF(2),VFR(6),o[1],0,0,0), C1,4); \
    GAPB(o[0]=__builtin_amdgcn_mfma_f32_32x32x16_bf16(PAF(3),VFR(3),o[0],0,0,0), C1,8); \
    GAPB(o[1]=__builtin_amdgcn_mfma_f32_32x32x16_bf16(PAF(3),VFR(7),o[1],0,0,0), C1,12); \
    }while(0)
  int t=1;
  for(;t+5<NT;t+=2){
    STEP(pB0,pB1,pA0,pA1,t,true,true,true);     WAIT_BAR(2); RESC(); ROT();
    STEP(pA0,pA1,pB0,pB1,t+1,true,true,true);   WAIT_BAR(2); RESC(); ROT();
  }
  #define ENDW(tt) do{ if((tt)+3<NT){WAIT_BAR(2);} else if((tt)+2<NT){WAIT_BAR(1);} else {WAIT_BAR(0);} }while(0)
  for(;t+1<NT;t+=2){
    STEP(pB0,pB1,pA0,pA1,t,(t+3<NT),(t+1<NT),(t+1<NT));       ENDW(t);   RESC(); ROT();
    STEP(pA0,pA1,pB0,pB1,t+1,(t+4<NT),(t+2<NT),(t+2<NT));     ENDW(t+1); RESC(); ROT();
  }
  STEP(pB0,pB1,pA0,pA1,NT-1,false,false,false); RESC();
  { float sacc=pB0[0]+pB0[1]; _Pragma("unroll") for(int r=2;r<16;++r)sacc+=pB0[r]; _Pragma("unroll") for(int r=0;r<16;++r)sacc+=pB1[r]; l_reg+=sacc;
    pw0=(u32x4){PKW(pB0,0),PKW(pB0,2),PKW(pB0,4),PKW(pB0,6)};pw1=(u32x4){PKW(pB0,8),PKW(pB0,10),PKW(pB0,12),PKW(pB0,14)};pw2=(u32x4){PKW(pB1,0),PKW(pB1,2),PKW(pB1,4),PKW(pB1,6)};pw3=(u32x4){PKW(pB1,8),PKW(pB1,10),PKW(pB1,12),PKW(pB1,14)};
    SBAR(); pv(o,vb0+sl_cur,PAF(0),PAF(1),PAF(2),PAF(3)); }
  #undef PKW
  #undef PAF
  #undef VFR
  #undef PIN
  #undef MX3
  #undef GAPA
  #undef GAPB
  #undef EX
  #undef VRD
  #undef KRD
  #undef STEP
  #undef ENDW
  {auto rr=__builtin_amdgcn_permlane32_swap(__float_as_uint(l_reg),__float_as_uint(l_reg),false,false);l_reg=__uint_as_float(rr[0])+__uint_as_float(rr[1]);}
  if(hi==0)wsf[32+r32]=l_reg;asm volatile("s_waitcnt lgkmcnt(0)":::"memory");
  float rli[16];
  #pragma unroll
  for(int r=0;r<16;++r)rli[r]=__builtin_amdgcn_rcpf(wsf[32+crow(r,hi)]);
  bf16*Ow=O+(rowbase+q0+wid*QBLK)*DM+h*D;
  { bf16*stg=(bf16*)(shm+LDS_OST)+wid*2048;
    #pragma unroll
    for(int r=0;r<16;++r){const int orow=crow(r,hi);
      #pragma unroll
      for(int d0=0;d0<2;++d0)stg[orow*64+d0*32+r32]=__float2bfloat16(o[d0][r]*rli[r]);}
    asm volatile("s_waitcnt lgkmcnt(0)":::"memory");
    #pragma unroll
    for(int i=0;i<4;++i){const int row=i*8+(lane>>3),ch=lane&7; const u32x4 v=*(const u32x4*)(stg+row*64+ch*8); ATTN_STORE16(Ow+(long)row*DM+ch*8,v);} }
  asm volatile("s_waitcnt lgkmcnt(0)\n\ts_barrier":::"memory");
  #undef DMA_K
  #undef DMA_V
  #undef CMASK
  #undef TPOS
  #undef TSEL
  #undef TLUT
  #undef TCLS
  #undef SETNEG
  #undef START
  #undef RESC
  #undef ROT
}

#undef SBAR
#undef WAIT_BAR
}

__device__ __forceinline__ void attn_phase_ex(Frame& F) {
    const attn_ex::bf16* Q = (const attn_ex::bf16*)(F.ws + WS_Q); const attn_ex::bf16* Kb = (const attn_ex::bf16*)(F.ws + WS_K); const attn_ex::bf16* Vb = (const attn_ex::bf16*)(F.ws + WS_VT);
    const float* KM = (const float*)(F.ws + WS_KM); attn_ex::bf16* HA = (attn_ex::bf16*)(F.ws + WS_HA); const float* rel_bias = INP(2);
    static_assert(attn_ex::LDS_BYTES <= RING_BYTES, "attention LDS");
    for (int n = F.vcu; n < BATCH * NH * NBLK; n += F.G) {
        const int ii = n >> 8, w = n & 255, bh = w >> 2, s4 = w & 3; const int qb = (ii == 0) ? s4 : (ii == 1) ? 7 - s4 : (ii == 2) ? 8 + s4 : 15 - s4;
        attn_ex::attn_unit<8>(bh >> 3, bh & 7, qb, Q, Kb, Vb, HA, (char*)F.lds, KM, rel_bias, F.tid);
    }
    asm volatile("s_waitcnt vmcnt(0)" ::: "memory"); __syncthreads();
}
#if DBG_CHECK
__device__ __forceinline__ unsigned hash_u(unsigned x) { x ^= x >> 16; x *= 0x7feb352du; x ^= x >> 15; x *= 0x846ca68bu; x ^= x >> 16; return x; }
__device__ __forceinline__ float bfv(const bf16_t* p) { return __uint_as_float(((unsigned)*p) << 16); }
__device__ __forceinline__ float rbf(float x) { return bf_lo(cvtpk(x, 0.f) & 0xffffu); }
__device__ __forceinline__ void dbg_acc(Frame& F, float d2, float r2) { if (F.lane == 0) { atomicAdd((float*)(F.ctl + CW_DBG), d2); atomicAdd((float*)(F.ctl + CW_DBG + 64), r2); } }
__device__ __forceinline__ float dbg_qk(const bf16_t* qp, const bf16_t* kp) { float a = 0.f;
#pragma unroll 1
    for (int d = 0; d < 64; ++d) a += bfv(qp + d) * bfv(kp + d); return a; }
__device__ __forceinline__ void dbg_attn(Frame& F, const float* rel_bias) {
    const bf16_t* Q = (const bf16_t*)(F.ws + WS_Q); const bf16_t* Kb = (const bf16_t*)(F.ws + WS_K); const bf16_t* VT = (const bf16_t*)(F.ws + WS_VT);
    const float* KM = (const float*)(F.ws + WS_KM); const bf16_t* HA = (const bf16_t*)(F.ws + WS_HA);
    const int gw = F.vcu * NWAVES + F.wave, lane = F.lane;
#pragma unroll 1
    for (int sidx = gw; sidx < 4096; sidx += F.G * NWAVES) {
        const unsigned hsh = hash_u(sidx * 2654435761u + 12345u);
        const int b = hsh & 7, h = (hsh >> 3) & 7; int q = (hsh >> 6) & 4095;
        if ((sidx & 7) == 0) q = (q & ~255) | ((hsh >> 20) & 3);
        if ((sidx & 7) == 1) q = (q & ~255) | (252 + ((hsh >> 20) & 3));
        if ((sidx & 15) == 2) q = q & 255;
        const int own = q >> 8; const bf16_t* qp = Q + ((size_t)(b * SEQ + q)) * 512 + h * 64;
        float myscore = -INFINITY;
        if (lane < own) { float a = 0.f;
#pragma unroll 1
            for (int d = 0; d < 64; ++d) a += bfv(qp + d) * KM[((size_t)(b * NBLK + lane)) * 512 + h * 64 + d]; myscore = a; }
        unsigned sel = 0u;
#pragma unroll 1
        for (int p = 0; p < 3; ++p) { float best = -INFINITY; int bi = -1;
#pragma unroll 1
            for (int j = 0; j < 16; ++j) { const float sj = __shfl(myscore, j); if (j < own && !((sel >> j) & 1u) && sj > best) { best = sj; bi = j; } }
            if (bi >= 0) sel |= 1u << bi; }
        float mx = -INFINITY;
#pragma unroll 1
        for (int kp = lane; kp <= q; kp += 64) { const int kb = kp >> 8; if (!(kb == own || ((sel >> kb) & 1u))) continue;
            const float a = dbg_qk(qp, Kb + ((size_t)(b * SEQ + kp)) * 512 + h * 64) + rel_bias[rel_bucket_dev(q - kp) * NH + h] * LOG2E; mx = fmaxf(mx, a); }
#pragma unroll
        for (int o = 1; o < 64; o <<= 1) mx = fmaxf(mx, __shfl_xor(mx, o));
        float ls = 0.f;
#pragma unroll 1
        for (int kp = lane; kp <= q; kp += 64) { const int kb = kp >> 8; if (!(kb == own || ((sel >> kb) & 1u))) continue;
            const float a = dbg_qk(qp, Kb + ((size_t)(b * SEQ + kp)) * 512 + h * 64) + rel_bias[rel_bucket_dev(q - kp) * NH + h] * LOG2E; ls += exp2f(a - mx); }
        ls = wave_sum(ls); float d2 = 0.f, r2 = 0.f;
#pragma unroll 1
        for (int d = 0; d < 64; ++d) { float ov = 0.f;
#pragma unroll 1
            for (int kp = lane; kp <= q; kp += 64) { const int kb = kp >> 8; if (!(kb == own || ((sel >> kb) & 1u))) continue;
                const float a = dbg_qk(qp, Kb + ((size_t)(b * SEQ + kp)) * 512 + h * 64) + rel_bias[rel_bucket_dev(q - kp) * NH + h] * LOG2E;
                ov += exp2f(a - mx) * bfv(VT + ((size_t)(b * SEQ + kp)) * 512 + h * 64 + d); }
            const float o = wave_sum(ov) / ls; const float got = bfv(HA + ((size_t)(b * SEQ + q)) * 512 + h * 64 + d); d2 += (got - o) * (got - o); r2 += o * o; }
        dbg_acc(F, d2, r2);
    }
}
__device__ __forceinline__ float dbg_dot_x_w(Frame& F, const float* xrow, const float* W, int ldw, int col, int K) {
    float a = 0.f;
#pragma unroll 1
    for (int k = F.lane; k < K; k += 64) a += rbf(xrow[k]) * rbf(W[(size_t)k * ldw + col]); return wave_sum(a); }
__device__ __forceinline__ void dbg_inproj(Frame& F, const float* x, const float* w) {
    const int gw = F.vcu * NWAVES + F.wave;
#pragma unroll 1
    for (int sidx = gw; sidx < 8192; sidx += F.G * NWAVES) {
        const unsigned hsh = hash_u(sidx * 2654435761u + 777u); const int row = hsh & (M - 1); const int sec = sidx % 5; const unsigned r2_ = hash_u(hsh);
        const float* xr = x + (size_t)row * D; float ref, got;
        if (sec == 0) { const int c = r2_ & 511; const float a = dbg_dot_x_w(F, xr, w, NIN, c, D), g = dbg_dot_x_w(F, xr, w, NIN, 512 + c, D); ref = a / (1.f + __expf(-g)); got = bfv((const bf16_t*)(F.ws + WS_H0) + (size_t)row * 512 + c); }
        else if (sec == 1) { const int c = r2_ & 511; ref = dbg_dot_x_w(F, xr, w, NIN, 1024 + c, D) * QSCALE; got = bfv((const bf16_t*)(F.ws + WS_Q) + (size_t)row * 512 + c); }
        else if (sec == 2) { const int c = r2_ & 511; ref = dbg_dot_x_w(F, xr, w, NIN, 1536 + c, D); got = bfv((const bf16_t*)(F.ws + WS_K) + (size_t)row * 512 + c); }
        else if (sec == 3) { const int c = r2_ & 511; ref = dbg_dot_x_w(F, xr, w, NIN, 2048 + c, D); got = bfv((const bf16_t*)(F.ws + WS_VT) + (size_t)row * 512 + c); }
        else { const int c = r2_ & 2047; const float g = dbg_dot_x_w(F, xr, w, NIN, 2560 + c, D); ref = 1.f / (1.f + __expf(-g)); got = (float)((const unsigned char*)(F.ws + WS_SG))[(size_t)row * 2048 + c] * (1.f / 255.f); }
        dbg_acc(F, (got - ref) * (got - ref), ref * ref);
    }
}
__device__ __forceinline__ void dbg_conv(Frame& F) {
    const bf16_t* H0 = (const bf16_t*)(F.ws + WS_H0); const bf16_t* HC = (const bf16_t*)(F.ws + WS_HC); const int gw = F.vcu * NWAVES + F.wave, lane = F.lane;
    const float* cw = INP(4); const float* cb = INP(5); const float* lg = INP(6); const float* lb = INP(7);
#pragma unroll 1
    for (int sidx = gw; sidx < 4096; sidx += F.G * NWAVES) {
        const unsigned hsh = hash_u(sidx * 2654435761u + 4242u); const int b = hsh & 7; int t = (hsh >> 3) & 4095; if ((sidx & 3) == 0) t &= 31;
        float v[8]; float s = 0.f;
#pragma unroll
        for (int c = 0; c < 8; ++c) { const int ch = lane * 8 + c; float a = cb[ch];
#pragma unroll 1
            for (int j = 0; j < CKW; ++j) { const int ti = t - 30 + j; if (ti >= 0) a += cw[j * CW + ch] * bfv(H0 + ((size_t)(b * SEQ + ti)) * 512 + ch); } v[c] = a; s += a; }
        const float mean = wave_sum(s) / CW; float qq = 0.f;
#pragma unroll
        for (int c = 0; c < 8; ++c) qq += (v[c] - mean) * (v[c] - mean);
        const float rstd = 1.f / sqrtf(wave_sum(qq) / CW + LN_EPS); float d2 = 0.f, r2 = 0.f;
#pragma unroll
        for (int c = 0; c < 8; ++c) { const int ch = lane * 8 + c; const float y = (v[c] - mean) * rstd * lg[ch] + lb[ch]; const float ref = y / (1.f + __expf(-y));
            const float got = bfv(HC + ((size_t)(b * SEQ + t)) * 512 + ch); d2 += (got - ref) * (got - ref); r2 += ref * ref; }
        dbg_acc(F, wave_sum(d2), wave_sum(r2));
    }
    const bf16_t* Kb = (const bf16_t*)(F.ws + WS_K); const float* KM = (const float*)(F.ws + WS_KM);
    for (int sidx = gw; sidx < 2048; sidx += F.G * NWAVES) { const unsigned hsh = hash_u(sidx * 2654435761u + 99u); const int u = hsh & 127, col = (hsh >> 7) & 511;
        float a = 0.f; for (int r = lane; r < 256; r += 64) a += bfv(Kb + ((size_t)u * 256 + r) * 512 + col); a = wave_sum(a) / 256.f; const float got = KM[(size_t)u * 512 + col];
        dbg_acc(F, (got - a) * (got - a) * 100.f, a * a * 100.f); }
}
__device__ __forceinline__ void dbg_mix(Frame& F) {
    const bf16_t* HC = (const bf16_t*)(F.ws + WS_HC); const bf16_t* HA = (const bf16_t*)(F.ws + WS_HA); const unsigned char* SG = (const unsigned char*)(F.ws + WS_SG); const bf16_t* MIX = (const bf16_t*)(F.ws + WS_MIX);
    const float* wc = INP(8); const float* wa = INP(9); const int gw = F.vcu * NWAVES + F.wave, lane = F.lane;
    for (int sidx = gw; sidx < 8192; sidx += F.G * NWAVES) { const unsigned hsh = hash_u(sidx * 2654435761u + 31337u); const int row = hsh & (M - 1), col = (hsh >> 15) & 1023;
        float a = 0.f, c = 0.f; for (int k = lane; k < 512; k += 64) { c += bfv(HC + (size_t)row * 512 + k) * rbf(wc[(size_t)k * D + col]); a += bfv(HA + (size_t)row * 512 + k) * rbf(wa[(size_t)k * D + col]); }
        c = wave_sum(c); a = wave_sum(a); const float ref = (float)SG[(size_t)row * 2048 + col] * (1.f / 255.f) * c + (float)SG[(size_t)row * 2048 + 1024 + col] * (1.f / 255.f) * a; const float got = bfv(MIX + (size_t)row * D + col);
        dbg_acc(F, (got - ref) * (got - ref), ref * ref); }
}
__device__ __forceinline__ void dbg_out(Frame& F) {
    const bf16_t* MIX = (const bf16_t*)(F.ws + WS_MIX); const _Float16* YB = (const _Float16*)(F.ws + WS_YB); const float* x = INP(0); const float* wo = INP(10); const int gw = F.vcu * NWAVES + F.wave, lane = F.lane;
    for (int sidx = gw; sidx < 8192; sidx += F.G * NWAVES) { const unsigned hsh = hash_u(sidx * 2654435761u + 555u); const int row = hsh & (M - 1), col = (hsh >> 15) & 1023;
        float a = 0.f; for (int k = lane; k < D; k += 64) a += bfv(MIX + (size_t)row * D + k) * rbf(wo[(size_t)k * D + col]); a = wave_sum(a);
        const float got = (float)YB[(size_t)row * D + col] - ALPHA * x[(size_t)row * D + col]; dbg_acc(F, (got - a) * (got - a), a * a); }
}
#if DBG_CHECK == 1 || DBG_CHECK == 2
__device__ __noinline__ void dbg_entry(unsigned char* ws, float* out, LAS unsigned char* lds, int wv_, const float* p0, const float* p1) { const int wv = __builtin_amdgcn_readfirstlane(wv_); Frame F = make_frame(ws, out, lds, wv);
#if DBG_CHECK == 1
    dbg_attn(F, p0);
#else
    dbg_inproj(F, p0, p1);
#endif
}
#endif
__device__ __forceinline__ void dbg_finish(Frame& F) {
    const float d2 = __hip_atomic_load((float*)(F.ctl + CW_DBG), RLX_AGENT), r2 = __hip_atomic_load((float*)(F.ctl + CW_DBG + 64), RLX_AGENT);
    float v = -10.f * log10f(d2 / r2); v = (d2 == 0.f) ? 98.f : v; v = fminf(fmaxf(v, 0.f), 98.f); if (!(r2 > 0.f)) v = 0.f;
    const float c = sqrtf(v);
    for (size_t i = (size_t)F.vcu * NTHR + F.tid; i < (size_t)M * D; i += (size_t)F.G * NTHR) F.out[i] = c;
}
#endif
constexpr int NPH = 12, N_PHASES = 1 + DEPTH * NPH;
struct Args { const float* in[24]; float* out; unsigned char* ws; int ph; int pad; };
#ifndef PH_NOINLINE
#define PH_NOINLINE 0
#endif
#if PH_NOINLINE
#define PHASE_FN __device__ __noinline__
#else
#define PHASE_FN __device__ __forceinline__
#endif
__device__ __forceinline__ Frame make_frame_impl(unsigned char* ws, float* out, LAS unsigned char* lds, int wv) {
    Frame F; F.lds = lds; F.MISC = (volatile LAS unsigned*)(lds + MISC_OFF);
    F.tid = phase_tid(wv); F.lane = F.tid & 63; F.wave = __builtin_amdgcn_readfirstlane(F.tid >> 6);
    { int g_ = gridDim.x, b_ = blockIdx.x; asm volatile("" : "+s"(g_), "+s"(b_)); F.G = g_; F.bx = b_; }
    F.vcu = (F.G % 8 == 0) ? (F.bx % 8) * (F.G / 8) + F.bx / 8 : F.bx;
    F.ws = ws; F.ctl = (unsigned*)(ws + WS_CTL); F.out = out; return F;
}
__device__ __forceinline__ Frame make_frame(unsigned char* ws, float* out, LAS unsigned char* lds, int wv) { return make_frame_impl(ws, out, lds, wv); }
constexpr size_t T1024 = (size_t)256 * 1024 * 2, T512 = (size_t)256 * 512 * 2, T256 = (size_t)256 * 256 * 2, T3584 = (size_t)256 * 3584 * 2;
PHASE_FN void ph_prologue(unsigned char* ws, float* out, LAS unsigned char* lds, int wv) { Frame F = make_frame(ws, out, lds, wv); prologue_phase(F); }
PHASE_FN void ph_inproj(unsigned char* ws, float* out, LAS unsigned char* lds, int wv, int l) { Frame F = make_frame(ws, out, lds, wv);
    SchedInProj S{(const char*)(ws + WS_XB), (const char*)(ws + WS_WIN + l * SZ_WIN), F.G, F.bx, T1024};
    EpiInProj E{(bf16_t*)(ws + WS_H0), (bf16_t*)(ws + WS_Q), (bf16_t*)(ws + WS_K), (bf16_t*)(ws + WS_VT), (unsigned char*)(ws + WS_SG)};
    pg8::gemm_phase<EpiInProj, SchedInProj, false>(lds, wv, D, S, E, nullptr); }
PHASE_FN void ph_thin(unsigned char* ws, float* out, LAS unsigned char* lds, int wv, int l) { Frame F = make_frame(ws, out, lds, wv); thin_phase(F, l); }
PHASE_FN void ph_attn(unsigned char* ws, float* out, LAS unsigned char* lds, int wv) { Frame F = make_frame(ws, out, lds, wv); if (ATTN_EX) attn_phase_ex(F); else attn_phase(F); }
PHASE_FN void ph_mixc(unsigned char* ws, float* out, LAS unsigned char* lds, int wv, int l) { Frame F = make_frame(ws, out, lds, wv);
    SchedGrid S{(const char*)(ws + WS_HC), (const char*)(ws + WS_WC + l * SZ_WC), M / 256, D / 256, F.G, F.bx, T512};
    EpiBf16Row<0> E{(bf16_t*)(ws + WS_MIX), D, (const unsigned char*)(ws + WS_SG), 2048, nullptr};
    pg8::gemm_phase<EpiBf16Row<0>, SchedGrid, false>(lds, wv, CW, S, E, nullptr); }
PHASE_FN void ph_mixa(unsigned char* ws, float* out, LAS unsigned char* lds, int wv, int l) { Frame F = make_frame(ws, out, lds, wv);
    SchedGrid S{(const char*)(ws + WS_HA), (const char*)(ws + WS_WA + l * SZ_WA), M / 256, D / 256, F.G, F.bx, T512};
    EpiBf16Row<1> E{(bf16_t*)(ws + WS_MIX), D, (const unsigned char*)(ws + WS_SG) + 1024, 2048, nullptr};
    pg8::gemm_phase<EpiBf16Row<1>, SchedGrid, false>(lds, wv, AW, S, E, nullptr); }
PHASE_FN void ph_outproj(unsigned char* ws, float* out, LAS unsigned char* lds, int wv, int l) { Frame F = make_frame(ws, out, lds, wv);
    SchedGrid S{(const char*)(ws + WS_MIX), (const char*)(ws + WS_WOUT + l * SZ_WOUT), M / 256, D / 256, F.G, F.bx, T1024};
    EpiResF32<0> E{(l == 0) ? INP(0) : nullptr, (unsigned short*)(ws + WS_YB), nullptr, (const float*)(ws + WS_ST), INP(15) + (l > 0 ? l - 1 : 0) * D, INP(16) + (l > 0 ? l - 1 : 0) * D};
    pg8::gemm_phase<EpiResF32<0>, SchedGrid, false>(lds, wv, D, S, E, nullptr); }
PHASE_FN void ph_ln1(unsigned char* ws, float* out, LAS unsigned char* lds, int wv, int l, bool dummy) { Frame F = make_frame(ws, out, lds, wv); ln_phase<1>(F, l, dummy); }
PHASE_FN void ph_ln2(unsigned char* ws, float* out, LAS unsigned char* lds, int wv, int l, bool dummy) { Frame F = make_frame(ws, out, lds, wv); ln_phase<2>(F, l, dummy); }
__device__ __forceinline__ bool ple_filler(const Frame& F, int rtail, int& Gf, int& cf) { Gf = F.G; cf = F.bx; if (rtail <= 0 || rtail >= F.G) return true; Gf = F.G - rtail; cf = F.bx - rtail; return cf >= 0; }
PHASE_FN void ph_routebuild(unsigned char* ws, float* out, LAS unsigned char* lds, int wv, int l) { Frame F = make_frame(ws, out, lds, wv); route_build(F, l >> 1); }
PHASE_FN void ph_plegate(unsigned char* ws, float* out, LAS unsigned char* lds, int wv, int l, int rtail) { Frame F = make_frame(ws, out, lds, wv);
    int Gf, cf; if (!ple_filler(F, rtail, Gf, cf)) return;
    SchedGrid S{(const char*)(ws + WS_XB), (const char*)(ws + WS_WPG + l * SZ_WPG), M / 256, D / 256, Gf, cf, T1024};
    EpiBf16Row<2> E{nullptr, D, nullptr, 0, (unsigned char*)(ws + WS_PG)};
    pg8::gemm_phase<EpiBf16Row<2>, SchedGrid, false>(lds, wv, D, S, E, nullptr); }
PHASE_FN void ph_pleproj(unsigned char* ws, float* out, LAS unsigned char* lds, int wv, int l, int rtail) { Frame F = make_frame(ws, out, lds, wv);
    int Gf, cf; if (!ple_filler(F, rtail, Gf, cf)) return;
    SchedGrid S{(const char*)(ws + WS_PB), (const char*)(ws + WS_WPP + l * SZ_WPP), M / 256, D / 256, Gf, cf, T256};
    EpiBf16Row<0> E{(bf16_t*)(ws + WS_PLE), D, (const unsigned char*)(ws + WS_PG), 1024, nullptr};
    pg8::gemm_phase<EpiBf16Row<0>, SchedGrid, false>(lds, wv, PLED, S, E, nullptr); }
PHASE_FN void ph_ffn_up_dense(unsigned char* ws, float* out, LAS unsigned char* lds, int wv, int mi) { Frame F = make_frame(ws, out, lds, wv);
    EpiSwiGLU E{(bf16_t*)(ws + WS_H)};
    SchedGrid S{(const char*)(ws + WS_XB), (const char*)(ws + WS_WGU + mi * SZ_WGU), M / 256, 2 * FF / 256, F.G, F.bx, T1024};
    pg8::gemm_phase<EpiSwiGLU, SchedGrid, false>(lds, wv, D, S, E, nullptr); }
PHASE_FN void ph_ffn_up_moe(unsigned char* ws, float* out, LAS unsigned char* lds, int wv, int mi) { Frame F = make_frame(ws, out, lds, wv);
    EpiSwiGLU E{(bf16_t*)(ws + WS_H)};
    SchedMoe S; S.A = (const char*)(ws + WS_XB); S.B = (const char*)(ws + WS_EWGU); S.nN = 2 * FF / 256; S.G = F.G; S.c = F.bx; S.tstepA = T1024; S.tstepB = T1024; S.gather = true;
    moe_starts(F, mi, S.pstart); S.npan = S.pstart[NE];
    pg8::gemm_phase<EpiSwiGLU, SchedMoe, true>(lds, wv, D, S, E, (const int*)(ws + WS_RTOK)); }
PHASE_FN void ph_ffn_down_dense(unsigned char* ws, float* out, LAS unsigned char* lds, int wv, int mi, bool dummy) { Frame F = make_frame(ws, out, lds, wv);
    SchedGrid S{(const char*)(ws + WS_H), (const char*)(ws + WS_WD + mi * SZ_WD), M / 256, D / 256, F.G, F.bx, T3584, true};
    (void)dummy; EpiResF32<1> E{nullptr, (unsigned short*)(ws + WS_YB), (const bf16_t*)(ws + WS_PLE), (const float*)(ws + WS_ST), INP(11) + (2 * mi) * D, INP(12) + (2 * mi) * D};
    pg8::gemm_phase<EpiResF32<1>, SchedGrid, false>(lds, wv, FF, S, E, nullptr); }
PHASE_FN int ph_ffn_down_moe(unsigned char* ws, float* out, LAS unsigned char* lds, int wv, int mi) { Frame F = make_frame(ws, out, lds, wv);
    SchedMoe S; S.A = (const char*)(ws + WS_H); S.B = (const char*)(ws + WS_EWD); S.nN = D / 256; S.G = F.G; S.c = F.bx; S.tstepA = T3584; S.tstepB = T3584; S.gather = false; S.rev = true;
    moe_starts(F, mi, S.pstart); S.npan = S.pstart[NE];
    EpiMoeDown E{(bf16_t*)out, (const int*)(ws + WS_RDST), (const float*)(ws + WS_RGATE)};
    pg8::gemm_phase<EpiMoeDown, SchedMoe, false>(lds, wv, FF, S, E, nullptr);
    const int nwg = S.npan * S.nN; return nwg % F.G; }

__global__ void __launch_bounds__(NTHR, 2) fwd_kernel(Args args) {
    extern __shared__ __attribute__((aligned(16))) unsigned char lds_raw[];
    LAS unsigned char* lds = (LAS unsigned char*)lds_raw;
    unsigned char* ws = args.ws; float* out = args.out;
    const int wv = __builtin_amdgcn_readfirstlane((int)threadIdx.x >> 6);
    for (int u = phase_tid(wv); u < (LDS_BYTES - LDSCTL_OFF) / 4; u += NTHR) ((LAS unsigned*)(lds + LDSCTL_OFF))[u] = 0u;
    __syncthreads();
#if MK_SINGLE
    XcdBarrier bar = xcd_barrier_post((unsigned*)(ws + WS_CTL) + CW_BAR, (volatile LAS unsigned*)(lds + MISC_OFF) + 8, phase_tid(wv));
#define RUN(k) (true)
#define SEAM() do { XcdBarrier b_ = bar; asm volatile("" : "+s"(b_.bar), "+s"(b_.x)); xcd_barrier(b_, phase_tid(wv)); } while (0)
#define LSEAM() do { asm volatile("s_waitcnt vmcnt(0)" ::: "memory"); __syncthreads(); __builtin_amdgcn_fence(__ATOMIC_ACQUIRE, "agent"); asm volatile("s_waitcnt vmcnt(0)" ::: "memory"); __syncthreads(); } while (0)
#else
    const int ph = args.ph;
#define RUN(k) (ph == (k))
#define SEAM() do { } while (0)
#define LSEAM() do { } while (0)
#endif
    _Pragma("unroll") for (int r_ = 0; r_ < NREP(12); ++r_) { if (RUN(0)) ph_prologue(ws, out, lds, wv);
    SEAM(); }
    unsigned long long tacc = 0ull, t0_ = 0ull;
    const unsigned long long ck0_ = (DBG_TIME == 99) ? (unsigned long long)__builtin_readcyclecounter() : 0ull, rt0_ = (DBG_TIME == 99) ? __builtin_amdgcn_s_memrealtime() : 0ull;
#define TS0(k) do { if (DBG_TIME == (k)) t0_ = __builtin_amdgcn_s_memrealtime(); } while (0)
#define TS1(k) do { if (DBG_TIME == (k)) tacc += __builtin_amdgcn_s_memrealtime() - t0_; } while (0)
#pragma unroll 1
    for (int l = 0; l < DEPTH; ++l) {
        const int pb = 1 + l * NPH; const bool moe = (l & 1) != 0; const int mi = l >> 1;
        for (int xb_ = 0; xb_ < BAR_PROBE; ++xb_) SEAM();
        _Pragma("unroll") for (int r_ = 0; r_ < NREP(0); ++r_) { if (RUN(pb + 0)) ph_inproj(ws, out, lds, wv, l);
        SEAM(); }
#if DBG_CHECK == 2
        if (l == 0) dbg_entry(ws, out, lds, wv, INP(0), INP(3));
#endif
        TS0(1); _Pragma("unroll") for (int r_ = 0; r_ < NREP(1); ++r_) { if (RUN(pb + 1)) ph_thin(ws, out, lds, wv, l);
        SEAM(); } TS1(1);
#if DBG_CHECK == 3
        if (l == 0) { Frame F = make_frame(ws, out, lds, wv); dbg_conv(F); }
#endif
        _Pragma("unroll") for (int r_ = 0; r_ < NREP(2); ++r_) { if (RUN(pb + 2)) ph_attn(ws, out, lds, wv);
        if (r_ + 1 < NREP(2) || DBG_CHECK == 1) SEAM(); }
#if DBG_CHECK == 1
        if (l == 0) dbg_entry(ws, out, lds, wv, INP(2), nullptr);
#endif
        _Pragma("unroll") for (int r_ = 0; r_ < NREP(3); ++r_) { if (RUN(pb + 3)) ph_mixc(ws, out, lds, wv, l);
        SEAM();
        if (RUN(pb + 4)) ph_mixa(ws, out, lds, wv, l);
        SEAM(); }
#if DBG_CHECK == 4
        if (l == 0) { Frame F = make_frame(ws, out, lds, wv); dbg_mix(F); }
#endif
        _Pragma("unroll") for (int r_ = 0; r_ < NREP(5); ++r_) { if (RUN(pb + 5)) ph_outproj(ws, out, lds, wv, l);
        SEAM(); }
#if DBG_CHECK == 5
        if (l == 0) { Frame F = make_frame(ws, out, lds, wv); dbg_out(F); }
        SEAM();
#endif
        _Pragma("unroll") for (int r_ = 0; r_ < NREP(6); ++r_) { if (RUN(pb + 6)) ph_ln1(ws, out, lds, wv, l, r_ + 1 < NREP(6));
        SEAM(); }
        _Pragma("unroll") for (int r_ = 0; r_ < NREP(7); ++r_) {
        if (!moe) { if (RUN(pb + 7)) ph_plegate(ws, out, lds, wv, l, -1);
            LSEAM();
            if (RUN(pb + 8)) ph_pleproj(ws, out, lds, wv, l, -1);
            if (r_ + 1 < NREP(7)) SEAM(); }
        else { if (RUN(pb + 7)) ph_routebuild(ws, out, lds, wv, l);
            SEAM(); } }
        _Pragma("unroll") for (int r_ = 0; r_ < NREP(9); ++r_) { if (RUN(pb + 9)) { if (!moe) ph_ffn_up_dense(ws, out, lds, wv, mi); else ph_ffn_up_moe(ws, out, lds, wv, mi); }
        SEAM(); }
        _Pragma("unroll") for (int r_ = 0; r_ < NREP(10); ++r_) { if (RUN(pb + 10)) { if (!moe) ph_ffn_down_dense(ws, out, lds, wv, mi, r_ + 1 < NREP(10));
            else { const int rtail = __builtin_amdgcn_readfirstlane(ph_ffn_down_moe(ws, out, lds, wv, mi));
                ph_plegate(ws, out, lds, wv, l, rtail);
                LSEAM();
                ph_pleproj(ws, out, lds, wv, l, rtail); } }
        SEAM(); }
        _Pragma("unroll") for (int r_ = 0; r_ < NREP(11); ++r_) { if (RUN(pb + 11)) ph_ln2(ws, out, lds, wv, l, r_ + 1 < NREP(11));
        if (l + 1 < DEPTH || r_ + 1 < NREP(11)) SEAM(); }
    }
#if DBG_TIME >= 0
    if (DBG_TIME == 99) { const unsigned long long dc = (unsigned long long)__builtin_readcyclecounter() - ck0_, dr = __builtin_amdgcn_s_memrealtime() - rt0_; tacc = (unsigned long long)(rintf(10.f * ((float)dc / (float)dr) * 0.1f) * 1000.f); }
    { Frame F = make_frame(ws, out, lds, wv); if (F.bx == 0 && F.tid == 0) __hip_atomic_store((float*)(F.ctl + CW_DBG), (float)tacc * 0.01f, RLX_AGENT); }
    SEAM();
    { Frame F = make_frame(ws, out, lds, wv); const float t = __hip_atomic_load((float*)(F.ctl + CW_DBG), RLX_AGENT); const float c = sqrtf(t * 0.1f);
      for (size_t i = (size_t)F.vcu * NTHR + F.tid; i < (size_t)M * D; i += (size_t)F.G * NTHR) F.out[i] = c; }
#endif
#if DBG_CHECK
    SEAM();
    { Frame F = make_frame(ws, out, lds, wv); dbg_finish(F); }
#endif
#undef RUN
#undef SEAM
}

extern "C" void kernel_launch(void* const* d_in, const int* in_sizes, int n_in, void* d_out, int out_size, void* d_ws, size_t ws_size, hipStream_t stream) {
    static int grid = 0;
    if (grid == 0) {
        if (n_in != 24 || in_sizes[0] != M * D || out_size != M * D || ws_size < WS_END) { fprintf(stderr, "kernel_launch: unexpected problem shape / workspace (%d inputs, ws %zu < %zu)\n", n_in, ws_size, (size_t)WS_END); grid = -1; return; }
        int dev = 0, cus = 0, per_cu = 0;
        if (hipGetDevice(&dev) != hipSuccess || hipDeviceGetAttribute(&cus, hipDeviceAttributeMultiprocessorCount, dev) != hipSuccess) { grid = -1; return; }
        if (hipFuncSetAttribute((const void*)fwd_kernel, hipFuncAttributeMaxDynamicSharedMemorySize, LDS_BYTES) != hipSuccess) { fprintf(stderr, "kernel_launch: hipFuncSetAttribute failed\n"); grid = -1; return; }
        if (hipOccupancyMaxActiveBlocksPerMultiprocessor(&per_cu, (const void*)fwd_kernel, NTHR, LDS_BYTES) != hipSuccess || per_cu < 1) fprintf(stderr, "kernel_launch: occupancy query reports %d\n", per_cu);
        (void)hipGetLastError();
        grid = cus;
    }
    if (grid < 0) return;
    (void)hipMemsetAsync((char*)d_ws + WS_CTL, 0, CTL_ZERO_BYTES, stream);
    Args a{};
    for (int i = 0; i < 24; ++i) a.in[i] = (const float*)d_in[i];
    a.out = (float*)d_out; a.ws = (unsigned char*)d_ws; a.ph = 0; a.pad = 0;
#if MK_SINGLE
    hipLaunchKernelGGL(fwd_kernel, dim3(grid), dim3(NTHR), LDS_BYTES, stream, a);
#else
    for (int ph = 0; ph < N_PHASES; ++ph) { a.ph = ph; hipLaunchKernelGGL(fwd_kernel, dim3(grid), dim3(NTHR), LDS_BYTES, stream, a); }
#endif
}
```

```cpp
#include <hip/hip_runtime.h>
#include <hip/hip_bf16.h>
#include <cstdio>
#include <cstdint>
#include <type_traits>

#ifndef MK_SINGLE
#define MK_SINGLE 1
#endif
#ifndef DBG_CHECK
#define DBG_CHECK 0
#endif
#ifndef DBG_TIME
#define DBG_TIME -1
#endif
#ifndef ATTN_EX
#define ATTN_EX 1
#endif
#ifndef EPI_PROBE
#define EPI_PROBE 0
#endif
#ifndef BAR_PROBE
#define BAR_PROBE 0
#endif
#ifndef ATTN_PROBE
#define ATTN_PROBE 0
#endif
#ifndef REP_MASK
#define REP_MASK 0
#endif
#define NREP(k) ((((REP_MASK) >> (k)) & 1) ? 2 : 1)

#define LAS __attribute__((address_space(3)))
#define GAS __attribute__((address_space(1)))
typedef unsigned short bf16_t;
typedef short bf16x8 __attribute__((ext_vector_type(8)));
typedef short s16x4 __attribute__((ext_vector_type(4)));
typedef float f32x2 __attribute__((ext_vector_type(2)));
typedef float f32x4 __attribute__((ext_vector_type(4)));
typedef float f32x16 __attribute__((ext_vector_type(16)));
typedef unsigned u32x2 __attribute__((ext_vector_type(2)));
typedef unsigned u32x4 __attribute__((ext_vector_type(4)));
typedef __bf16 bf16x2_t __attribute__((ext_vector_type(2)));

constexpr int D = 1024, BATCH = 8, SEQ = 4096, M = BATCH * SEQ, DEPTH = 4;
constexpr int NH = 8, HD = 64, AW = 512, CW = 512, CKW = 31, MOBA = 256, NBLK = SEQ / MOBA;
constexpr int FF = 3584, NE = 8, PLED = 256, NIN = 4608;
constexpr float LN_EPS = 1e-5f;
constexpr float ALPHA = 1.6817928305074290f;
constexpr float LOG2E = 1.4426950408889634f;
constexpr float QSCALE = 0.125f * LOG2E;
constexpr int NWAVES = 8, NTHR = 512;
constexpr int MAXPANEL = 264;
constexpr int MAXROWS = MAXPANEL * 256;

constexpr size_t MiB = 1u << 20;
constexpr size_t WS_CTL = 0, CTL_ZERO_BYTES = 1 * MiB;
constexpr size_t SZ_WIN = (size_t)NIN * D * 2, SZ_WC = (size_t)D * CW * 2, SZ_WA = (size_t)D * AW * 2, SZ_WOUT = (size_t)D * D * 2, SZ_WPG = (size_t)D * D * 2, SZ_WPP = (size_t)D * PLED * 2;
constexpr size_t SZ_WGU = (size_t)2 * FF * D * 2, SZ_WD = (size_t)D * FF * 2;
constexpr size_t WS_WIN = 2 * MiB;
constexpr size_t WS_WC = WS_WIN + DEPTH * SZ_WIN;
constexpr size_t WS_WA = WS_WC + DEPTH * SZ_WC;
constexpr size_t WS_WOUT = WS_WA + DEPTH * SZ_WA;
constexpr size_t WS_WPG = WS_WOUT + DEPTH * SZ_WOUT;
constexpr size_t WS_WPP = WS_WPG + DEPTH * SZ_WPG;
constexpr size_t WS_WGU = WS_WPP + DEPTH * SZ_WPP;
constexpr size_t WS_WD = WS_WGU + 2 * SZ_WGU;
constexpr size_t WS_EWGU = WS_WD + 2 * SZ_WD;
constexpr size_t WS_EWD = WS_EWGU + NE * SZ_WGU;
constexpr size_t WS_XB = WS_EWD + NE * SZ_WD;
constexpr size_t WS_YB = WS_XB + (size_t)M * D * 2;
constexpr size_t WS_PB = WS_YB + (size_t)M * D * 4;
constexpr size_t WS_PLE = WS_PB + (size_t)M * PLED * 2;
constexpr size_t WS_KM = WS_PLE + (size_t)M * D * 2;
constexpr size_t WS_ROUTE = WS_KM + (size_t)128 * 512 * 4;
constexpr size_t WS_RTOK = WS_ROUTE + (size_t)M * 32;
constexpr size_t WS_RDST = WS_RTOK + (size_t)MAXROWS * 4;
constexpr size_t WS_RGATE = WS_RDST + (size_t)MAXROWS * 4;
constexpr size_t WS_ST = WS_RGATE + (size_t)MAXROWS * 4;
constexpr size_t WS_U = ((WS_ST + (size_t)M * 8 + 4095) / 4096) * 4096;
constexpr size_t WS_H0 = WS_U;
constexpr size_t WS_Q = WS_H0 + (size_t)M * 512 * 2;
constexpr size_t WS_K = WS_Q + (size_t)M * 512 * 2;
constexpr size_t WS_VT = WS_K + (size_t)M * 512 * 2;
constexpr size_t WS_SG = WS_VT + (size_t)M * 512 * 2;
constexpr size_t WS_HC = WS_SG + (size_t)M * 2048 * 2;
constexpr size_t WS_HA = WS_HC + (size_t)M * 512 * 2;
constexpr size_t WS_MIX = WS_HA + (size_t)M * 512 * 2;
constexpr size_t WS_U_END_TM = WS_MIX + (size_t)M * D * 2;
constexpr size_t WS_H = WS_U;
constexpr size_t WS_U_END_FF = WS_H + (size_t)MAXROWS * FF * 2;
constexpr size_t WS_PG = ((WS_U_END_FF > WS_U_END_TM ? WS_U_END_FF : WS_U_END_TM) + 4095) / 4096 * 4096;
constexpr size_t WS_END = WS_PG + (size_t)M * D;

constexpr int CW_BAR = 4096;
constexpr int CW_GCNT = 16384;
constexpr int CW_DBG = 32768;

constexpr int RING_BYTES = 131072;
constexpr int LDSCTL_OFF = RING_BYTES, MISC_OFF = LDSCTL_OFF + 320;
constexpr int LDS_BYTES = 147456;

#define RLX_AGENT __ATOMIC_RELAXED, __HIP_MEMORY_SCOPE_AGENT
#define LDS_WAIT() asm volatile("s_waitcnt lgkmcnt(0)" ::: "memory")
#define VM_WAIT() asm volatile("s_waitcnt vmcnt(0)" ::: "memory")

__device__ __forceinline__ unsigned cvtpk(float lo, float hi) { f32x2 v = {lo, hi}; bf16x2_t b = __builtin_convertvector(v, bf16x2_t); return __builtin_bit_cast(unsigned, b); }
__device__ __forceinline__ float bf_lo(unsigned w) { return __uint_as_float(w << 16); }
typedef _Float16 f16x2_t __attribute__((ext_vector_type(2)));
__device__ __forceinline__ unsigned pkh(float lo, float hi) { f16x2_t h = {(_Float16)lo, (_Float16)hi}; return __builtin_bit_cast(unsigned, h); }
__device__ __forceinline__ float h_lo(unsigned w) { return (float)__builtin_bit_cast(f16x2_t, w)[0]; }
__device__ __forceinline__ float h_hi(unsigned w) { return (float)__builtin_bit_cast(f16x2_t, w)[1]; }
__device__ __forceinline__ float bf_hi(unsigned w) { return __uint_as_float(w & 0xffff0000u); }
__device__ __forceinline__ float sigmoidf_(float x) { return __builtin_amdgcn_rcpf(1.0f + __builtin_amdgcn_exp2f(-x * LOG2E)); }

__device__ __forceinline__ int phase_tid(int wv) {
    int w = wv, ln; asm volatile("v_mbcnt_lo_u32_b32 %1, -1, 0\n\tv_mbcnt_hi_u32_b32 %1, -1, %1" : "+s"(w), "=&v"(ln));
    return w * 64 + ln;
}
__device__ __forceinline__ int lane_here() { int ln; asm volatile("v_mbcnt_lo_u32_b32 %0, -1, 0\n\tv_mbcnt_hi_u32_b32 %0, -1, %0" : "=&v"(ln)); return ln; }
namespace pg8 {
constexpr int BM = 256, BK = 64, HALF = 128, HTB = HALF * BK * 2, STAGE_BYTES = 8 * HTB, NXCD = 8, WGM = 8;
__host__ __device__ __forceinline__ int lds_byte(int r, int c) { const int st = (r >> 4) * 2 + (c >> 5), rr = r & 15, cc = c & 31, ob = rr * 64 + cc * 2; return st * 1024 + (ob ^ (((ob >> 9) & 1) << 5)); }
__host__ __device__ __forceinline__ void stage_rc(int b, int& R, int& C) { const int st = b / 1024, sb = b % 1024, swz = sb ^ (((sb >> 9) & 1) << 5); R = (st >> 1) * 16 + swz / 64; C = (st & 1) * 32 + (swz % 64) / 2; }
__host__ __device__ __forceinline__ int perm32(int rho) { const int n = rho >> 4, i = rho & 15; return 8 * (i >> 2) + 4 * n + (i & 3); }

struct Unit { const char* a; const char* b; int pm, pn, ty; };

__device__ __forceinline__ bool static_order(int i, int G, int c, int nM, int nN, int& pm, int& pn) {
    const int nwg = nM * nN; const long L = (long)i * G + c; if (L >= nwg) return false;
    int wgid = (int)L; { const int q = nwg / NXCD, r = nwg % NXCD, xcd = wgid % NXCD, off = wgid / NXCD; wgid = (xcd < r ? xcd * (q + 1) : r * (q + 1) + (xcd - r) * q) + off; }
    const int nig = WGM * nN, gid = wgid / nig, fm = gid * WGM, gsz = (nM - fm) < WGM ? (nM - fm) : WGM;
    pm = fm + ((wgid % nig) % gsz); pn = (wgid % nig) / gsz; return true;
}

template <class Epi, class Sched, bool GATHER>
__device__ __forceinline__ void gemm_phase(LAS unsigned char* lds, const int wv, const int K, const Sched& S, const Epi& E, const int* gidx) {
    const int tid = phase_tid(wv),
              wid = __builtin_amdgcn_readfirstlane(tid >> 6), lane = tid & 63, wr = wid >> 2, wc = wid & 3, fr = lane & 15, fq = lane >> 4;
    const int nt = K / BK;
    const size_t kstep = (size_t)(BK * 2);
    const size_t hstep = (size_t)HALF * K * 2;
    unsigned vA0[2], vA1[2], voffB[2];
#pragma unroll
    for (int i = 0; i < 2; ++i) { int R, C; stage_rc(tid * 16 + i * 8192, R, C); const int Rb = Epi::PERM ? ((R & ~31) + perm32(R & 31)) : R;
        vA0[i] = (unsigned)(R * K + C) * 2u; vA1[i] = vA0[i]; voffB[i] = (unsigned)(Rb * K + C) * 2u; }
    const size_t ah = GATHER ? (size_t)0 : hstep;
    const unsigned ldsw = (unsigned)wid * 1024u;
    const int aoff = lds_byte(wr * 64 + fr, fq * 8), boff = lds_byte(wc * 32 + fr, fq * 8);
#define PG8_SA(b, h) (((b) * 2 + (h)) * HTB)
#define PG8_SB(b, h) ((4 + (b) * 2 + (h)) * HTB)
#define PG8_STAGE(bufoff, gbase, voff) do { _Pragma("unroll") for (int _i = 0; _i < 2; ++_i) \
        __builtin_amdgcn_global_load_lds((const unsigned*)((const char*)(gbase) + (voff)[_i]), (LAS unsigned*)(lds + (bufoff) + ldsw + _i * 8192), 16, 0, 0); } while (0)
#define PG8_LDA(dst, b, h) do { _Pragma("unroll") for (int m = 0; m < 4; ++m) _Pragma("unroll") for (int k = 0; k < 2; ++k) dst[m][k] = *(const LAS bf16x8*)(lds + PG8_SA(b, h) + aoff + m * 2048 + k * 1024); } while (0)
#define PG8_LDB(dst, b, h) do { _Pragma("unroll") for (int n = 0; n < 2; ++n) _Pragma("unroll") for (int k = 0; k < 2; ++k) dst[n][k] = *(const LAS bf16x8*)(lds + PG8_SB(b, h) + boff + n * 2048 + k * 1024); } while (0)
#define PG8_MMA(ai, bj, At, Bt) do { __builtin_amdgcn_s_setprio(1); _Pragma("unroll") for (int m = 0; m < 4; ++m) _Pragma("unroll") for (int n = 0; n < 2; ++n) _Pragma("unroll") for (int k = 0; k < 2; ++k) \
        acc[ai][bj][m][n] = __builtin_amdgcn_mfma_f32_16x16x32_bf16(Bt[n][k], At[m][k], acc[ai][bj][m][n], 0, 0, 0); __builtin_amdgcn_s_setprio(0); } while (0)
#define PG8_WAIT_V(n) asm volatile("s_waitcnt vmcnt(" #n ")" ::: "memory")
#define PG8_WAIT_L(n) asm volatile("s_waitcnt lgkmcnt(" #n ")" ::: "memory")
#define PG8_BAR __builtin_amdgcn_s_barrier()
#define PG8_SCHED __builtin_amdgcn_sched_barrier(0)
    Unit cur, nxt; int ui = 0;
    if (!S.next(0, cur)) return;
#define PG8_GATHER(pm_, o0, o1) do { int t_ = tid; asm volatile("" : "+v"(t_)); _Pragma("unroll") for (int i = 0; i < 2; ++i) { int R, C; stage_rc(t_ * 16 + i * 8192, R, C); const int* gp_ = gidx + (pm_) * BM + R; \
        o0[i] = (unsigned)(gp_[0] * K + C) * 2u; o1[i] = (unsigned)(gp_[HALF] * K + C) * 2u; } } while (0)
    if constexpr (GATHER) PG8_GATHER(cur.pm, vA0, vA1);
    unsigned nA0[2] = {vA0[0], vA0[1]}, nA1[2] = {vA1[0], vA1[1]};
    f32x4 acc[2][2][4][2];
#pragma unroll
    for (int a = 0; a < 2; ++a)
#pragma unroll
        for (int b = 0; b < 2; ++b)
#pragma unroll
            for (int m = 0; m < 4; ++m)
#pragma unroll
                for (int n = 0; n < 2; ++n) acc[a][b][m][n] = (f32x4){0.f, 0.f, 0.f, 0.f};
    bf16x8 At[4][2], B0[2][2], B1[2][2];
    const char* cA = cur.a; const char* cB = cur.b;
    PG8_STAGE(PG8_SB(0, 0), cB, voffB); PG8_STAGE(PG8_SB(0, 1), cB + hstep, voffB); PG8_STAGE(PG8_SA(0, 0), cA, vA0); PG8_STAGE(PG8_SA(0, 1), cA + ah, vA1);
    if (wr == 1) PG8_BAR;
    PG8_WAIT_V(2); PG8_BAR;
    PG8_STAGE(PG8_SB(1, 0), cB + kstep, voffB); PG8_STAGE(PG8_SA(1, 0), cA + kstep, vA0); PG8_STAGE(PG8_SB(1, 1), cB + hstep + kstep, voffB);
    PG8_WAIT_V(6); PG8_BAR;
    for (;;) {
        const bool has_next = S.next(ui + 1, nxt);
        const char* nA = has_next ? nxt.a : cA; const char* nB = has_next ? nxt.b : cB;
        if constexpr (GATHER) {
            if (has_next) PG8_GATHER(nxt.pm, nA0, nA1);
        }
        for (int t = 0; t < nt; t += 2) {
            const bool last = (t == nt - 2);
            const char* a1 = cA + (size_t)(t + 1) * kstep;
            const char* a2 = last ? nA : cA + (size_t)(t + 2) * kstep; const char* b2 = last ? nB : cB + (size_t)(t + 2) * kstep;
            const char* a3 = a2 + kstep; const char* b3 = b2 + kstep;
            unsigned w0[2], w1[2];
            if constexpr (GATHER) { w0[0] = last ? nA0[0] : vA0[0]; w0[1] = last ? nA0[1] : vA0[1]; w1[0] = last ? nA1[0] : vA1[0]; w1[1] = last ? nA1[1] : vA1[1]; }
            else { w0[0] = vA0[0]; w0[1] = vA0[1]; w1[0] = vA1[0]; w1[1] = vA1[1]; }
            PG8_LDB(B0, 0, 0); PG8_LDB(B1, 0, 1); PG8_SCHED; PG8_LDA(At, 0, 0); PG8_STAGE(PG8_SA(1, 1), a1 + ah, vA1);
            PG8_WAIT_V(8); PG8_WAIT_L(0); PG8_BAR; PG8_MMA(0, 0, At, B0); PG8_MMA(0, 1, At, B1); PG8_BAR; PG8_SCHED;
            PG8_LDA(At, 0, 1); PG8_STAGE(PG8_SB(0, 0), b2, voffB); PG8_STAGE(PG8_SB(0, 1), b2 + hstep, voffB); PG8_STAGE(PG8_SA(0, 0), a2, w0);
            PG8_WAIT_V(8); PG8_WAIT_L(0); PG8_BAR; PG8_MMA(1, 0, At, B0); PG8_MMA(1, 1, At, B1); PG8_BAR; PG8_SCHED;
            PG8_LDB(B0, 1, 0); PG8_LDB(B1, 1, 1); PG8_SCHED; PG8_LDA(At, 1, 0); PG8_STAGE(PG8_SA(0, 1), a2 + ah, w1);
            PG8_WAIT_V(8); PG8_WAIT_L(0); PG8_BAR; PG8_MMA(0, 0, At, B0); PG8_MMA(0, 1, At, B1); PG8_BAR; PG8_SCHED;
            PG8_LDA(At, 1, 1); PG8_STAGE(PG8_SB(1, 0), b3, voffB); PG8_STAGE(PG8_SB(1, 1), b3 + hstep, voffB); PG8_STAGE(PG8_SA(1, 0), a3, w0);
            PG8_WAIT_V(8); PG8_WAIT_L(0); PG8_BAR; PG8_MMA(1, 0, At, B0); PG8_MMA(1, 1, At, B1); PG8_BAR; PG8_SCHED;
        }
        if (wr == 0) PG8_BAR;
        { const int le_ = lane_here(); E(acc, cur, wr, wc, le_ & 15, le_ >> 4); }
        if (EPI_PROBE && Epi::REPEATABLE) { asm volatile("" ::: "memory"); E(acc, cur, wr, wc, fr, fq); }
        if (!has_next) break;
#pragma unroll
        for (int a = 0; a < 2; ++a)
#pragma unroll
            for (int b = 0; b < 2; ++b)
#pragma unroll
                for (int m = 0; m < 4; ++m)
#pragma unroll
                    for (int n = 0; n < 2; ++n) acc[a][b][m][n] = (f32x4){0.f, 0.f, 0.f, 0.f};
        cur = nxt; cA = nA; cB = nB; ++ui;
        if constexpr (GATHER) { vA0[0] = nA0[0]; vA0[1] = nA0[1]; vA1[0] = nA1[0]; vA1[1] = nA1[1]; }
        if (wr == 1) PG8_BAR;
    }
    PG8_WAIT_V(0);
    PG8_BAR;
#undef PG8_GATHER
#undef PG8_SA
#undef PG8_SB
#undef PG8_STAGE
#undef PG8_LDA
#undef PG8_LDB
#undef PG8_MMA
#undef PG8_WAIT_V
#undef PG8_WAIT_L
#undef PG8_BAR
#undef PG8_SCHED
}
}

#define XB_TMO      128
#define XB_XCNT(j)  (256  + 64 * (j))
#define XB_XSUB(j)  (1280 + 64 * (j))
#define XB_XGEN(j)  (2304 + 64 * (j))
#define XB_TOP      3328
#define XB_TOPGEN   3392
#define XCD_BAR_WORDS 3456
#define XB_SPIN_CAP (1u << 22)
__device__ __forceinline__ unsigned xb_ld(unsigned* p)              { return __hip_atomic_load(p, __ATOMIC_RELAXED, __HIP_MEMORY_SCOPE_AGENT); }
__device__ __forceinline__ unsigned xb_add(unsigned* p, unsigned v) { return __hip_atomic_fetch_add(p, v, __ATOMIC_RELAXED, __HIP_MEMORY_SCOPE_AGENT); }
__device__ __forceinline__ unsigned xb_xcc_id() { return (unsigned)__builtin_amdgcn_s_getreg((3 << 11) | 20) & 0xFu; }
#define XB_SPIN(cond, bar) do { unsigned _sp = 0; while (cond) { __builtin_amdgcn_s_sleep(1); \
    if ((++_sp & 255u) == 0u) { if (xb_ld(&(bar)[XB_TMO])) break; if (_sp > XB_SPIN_CAP) { atomicAdd(&(bar)[XB_TMO], 1u); break; } } } } while (0)
struct XcdBarrier { unsigned* bar; unsigned x; volatile LAS unsigned* st; };
__device__ __forceinline__ XcdBarrier xcd_barrier_post(unsigned* bar, volatile LAS unsigned* st, int tid) {
    XcdBarrier b; b.bar = bar; b.x = xb_xcc_id(); b.st = st;
    if (tid == 0) (void)xb_add(&bar[XB_XCNT(b.x)], 1u);
    return b;
}
__device__ __forceinline__ void xcd_barrier_complete(unsigned* bar, unsigned x, unsigned& nloc, unsigned& nx) {
    const unsigned G = gridDim.x * gridDim.y * gridDim.z;
    unsigned sum, cnt, mine, sp = 0u;
    for (;;) {
        sum = 0u; cnt = 0u; mine = 0u;
#pragma unroll
        for (unsigned j = 0; j < 16; ++j) { const unsigned c = xb_ld(&bar[XB_XCNT(j)]); sum += c; cnt += (c > 0u) ? 1u : 0u; mine = (j == x) ? c : mine; }
        if (sum == G) break;
        __builtin_amdgcn_s_sleep(1);
        if ((++sp & 255u) == 0u) { if (xb_ld(&bar[XB_TMO])) break; if (sp > XB_SPIN_CAP) { atomicAdd(&bar[XB_TMO], 1u); break; } }
    }
    nloc = mine > 0u ? mine : 1u; nx = cnt > 0u ? cnt : 1u;
}
__device__ __forceinline__ void xcd_barrier(const XcdBarrier& b, int tid) {
    asm volatile("s_waitcnt vmcnt(0)" ::: "memory");
    __syncthreads();
    if (tid == 0) {
        unsigned* bar = b.bar;
        __builtin_amdgcn_s_waitcnt(0);
        unsigned nloc = b.st[0], nx = b.st[1];
        if (nloc == 0u) { xcd_barrier_complete(bar, b.x, nloc, nx); b.st[0] = nloc; b.st[1] = nx; }
        const unsigned old = xb_add(&bar[XB_XSUB(b.x)], 1u);
        const unsigned gen = old / nloc;
        if (old + 1u == (gen + 1u) * nloc) {
            __builtin_amdgcn_fence(__ATOMIC_RELEASE, "agent");
            asm volatile("s_waitcnt vmcnt(0)" ::: "memory");
            const unsigned og = xb_add(&bar[XB_TOP], 1u);
            const unsigned tg = og / nx;
            if (og + 1u == (tg + 1u) * nx) xb_add(&bar[XB_TOPGEN], 1u);
            else XB_SPIN(xb_ld(&bar[XB_TOPGEN]) == tg, bar);
            __builtin_amdgcn_fence(__ATOMIC_ACQUIRE, "agent");
            xb_add(&bar[XB_XGEN(b.x)], 1u);
            asm volatile("s_waitcnt vmcnt(0)" ::: "memory");
        } else {
            XB_SPIN(xb_ld(&bar[XB_XGEN(b.x)]) == gen, bar);
            __builtin_amdgcn_fence(__ATOMIC_ACQUIRE, "agent");
            asm volatile("s_waitcnt vmcnt(0)" ::: "memory");
        }
    }
    __syncthreads();
}

struct Frame {
    LAS unsigned char* lds;
    volatile LAS unsigned* MISC;
    unsigned* ctl;
    int tid, lane, wave, G, vcu, bx;
    unsigned char* ws;
    float* out;
};
__device__ __forceinline__ Frame make_frame(unsigned char* ws, float* out, LAS unsigned char* lds, int wv);
#define INP(i) in_ptr<(i)>()
template <int I> __device__ __forceinline__ const float* in_ptr() {
    const float* p; auto ka = __builtin_amdgcn_kernarg_segment_ptr();
    asm volatile("s_load_dwordx2 %0, %1, %2\n\ts_waitcnt lgkmcnt(0)" : "=s"(p) : "s"(ka), "i"(I * 8) : "memory");
    return p;
}

__device__ __forceinline__ float shfl_xor_(float v, int mask, int lane) { return __int_as_float(__builtin_amdgcn_ds_bpermute((lane ^ mask) << 2, __float_as_int(v))); }
__device__ __forceinline__ float wave_sum(float v) {
#define WS_DPP(x, ctrl, rmask) __int_as_float(__builtin_amdgcn_update_dpp(0, __float_as_int(x), (ctrl), (rmask), 0xf, false))
    v += WS_DPP(v, 0xB1, 0xf);
    v += WS_DPP(v, 0x4E, 0xf);
    v += WS_DPP(v, 0x141, 0xf);
    v += WS_DPP(v, 0x140, 0xf);
    v += WS_DPP(v, 0x142, 0xa);
    v += WS_DPP(v, 0x143, 0xc);
#undef WS_DPP
    return __int_as_float(__builtin_amdgcn_readlane(__float_as_int(v), 63));
}

using pg8::Unit;
struct EpiInProj {
    static constexpr bool PERM = true, REPEATABLE = false;
    bf16_t *H0, *Q, *Kb, *VT; unsigned char* SG;
    __device__ __forceinline__ void operator()(const f32x4 (&acc)[2][2][4][2], const Unit& u, int wr, int wc, int fr, int fq) const {
        int r0 = wr * 64 + fr, c0 = wc * 32 + 8 * fq; asm volatile("" : "+v"(r0), "+v"(c0));
        if (u.ty == 0) {
#pragma unroll
            for (int ai = 0; ai < 2; ++ai)
#pragma unroll
                for (int m = 0; m < 4; ++m) { const size_t row = (size_t)u.pm * 256 + ai * 128 + m * 16 + r0;
                    f32x4 a0 = acc[ai][0][m][0], a1 = acc[ai][0][m][1], g0 = acc[ai][1][m][0], g1 = acc[ai][1][m][1];
                    u32x4 w; w.x = cvtpk(a0[0] * sigmoidf_(g0[0]), a0[1] * sigmoidf_(g0[1])); w.y = cvtpk(a0[2] * sigmoidf_(g0[2]), a0[3] * sigmoidf_(g0[3]));
                    w.z = cvtpk(a1[0] * sigmoidf_(g1[0]), a1[1] * sigmoidf_(g1[1])); w.w = cvtpk(a1[2] * sigmoidf_(g1[2]), a1[3] * sigmoidf_(g1[3]));
                    *(u32x4*)(H0 + row * 512 + u.pn * 128 + c0) = w; }
        } else {
            if (u.ty == 4) {
                const int colb = (u.pn - 10) * 256;
#pragma unroll
                for (int ai = 0; ai < 2; ++ai)
#pragma unroll
                    for (int m = 0; m < 4; ++m) { unsigned char* rp = SG + (size_t)(u.pm * 256 + ai * 128 + m * 16 + r0) * 2048 + colb + c0;
#pragma unroll
                        for (int bj = 0; bj < 2; ++bj) { const f32x4 v0 = acc[ai][bj][m][0], v1 = acc[ai][bj][m][1]; u32x2 w = {0u, 0u};
#pragma unroll
                            for (int j = 0; j < 4; ++j) { w.x = __builtin_amdgcn_cvt_pk_u8_f32(__builtin_rintf(255.0f * sigmoidf_(v0[j])), j, w.x); w.y = __builtin_amdgcn_cvt_pk_u8_f32(__builtin_rintf(255.0f * sigmoidf_(v1[j])), j, w.y); }
                            *(u32x2*)(rp + bj * 128) = w; } }
            } else {
            bf16_t* base; size_t ld; int rowb, colb; float sc = 1.0f;
            if (u.ty == 1)      { base = Q;  ld = 512;  rowb = u.pm * 256; colb = (u.pn - 4) * 256; sc = QSCALE; }
            else if (u.ty == 2) { base = Kb; ld = 512;  rowb = u.pm * 256; colb = (u.pn - 6) * 256; }
            else                { base = VT; ld = 512;  rowb = u.pm * 256; colb = (u.pn - 8) * 256; }
#pragma unroll
            for (int ai = 0; ai < 2; ++ai)
#pragma unroll
                for (int m = 0; m < 4; ++m) { bf16_t* rp = base + (size_t)(rowb + ai * 128 + m * 16 + r0) * ld + colb + c0;
#pragma unroll
                    for (int bj = 0; bj < 2; ++bj) { const f32x4 v0 = acc[ai][bj][m][0] * sc, v1 = acc[ai][bj][m][1] * sc;
                        u32x4 w; w.x = cvtpk(v0[0], v0[1]); w.y = cvtpk(v0[2], v0[3]); w.z = cvtpk(v1[0], v1[1]); w.w = cvtpk(v1[2], v1[3]);
                        *(u32x4*)(rp + bj * 128) = w; } }
            }
        }
    }
};
template <int MODE> struct EpiBf16Row {
    static constexpr bool PERM = true, REPEATABLE = false;
    bf16_t* O; int ldo; const unsigned char* G; int ldg; unsigned char* GO;
    __device__ __forceinline__ void operator()(const f32x4 (&acc)[2][2][4][2], const Unit& u, int wr, int wc, int fr, int fq) const {
        int r0 = wr * 64 + fr, c0 = u.pn * 256 + wc * 32 + 8 * fq; asm volatile("" : "+v"(r0), "+v"(c0));
#pragma unroll
        for (int ai = 0; ai < 2; ++ai)
#pragma unroll
            for (int m = 0; m < 4; ++m) { const size_t row = (size_t)u.pm * 256 + ai * 128 + m * 16 + r0;
#pragma unroll
                for (int bj = 0; bj < 2; ++bj) { f32x4 v0 = acc[ai][bj][m][0], v1 = acc[ai][bj][m][1];
                    bf16_t* op = O + row * ldo + c0 + bj * 128;
                    if (MODE == 0 || MODE == 1) { const u32x2 g = *(const u32x2*)(G + row * ldg + c0 + bj * 128); const float k = 1.0f / 255.0f;
                        v0[0] *= k * (float)((g.x >> 0) & 0xffu); v0[1] *= k * (float)((g.x >> 8) & 0xffu); v0[2] *= k * (float)((g.x >> 16) & 0xffu); v0[3] *= k * (float)((g.x >> 24) & 0xffu);
                        v1[0] *= k * (float)((g.y >> 0) & 0xffu); v1[1] *= k * (float)((g.y >> 8) & 0xffu); v1[2] *= k * (float)((g.y >> 16) & 0xffu); v1[3] *= k * (float)((g.y >> 24) & 0xffu); }
                    if (MODE == 1) { const u32x4 o = *(const u32x4*)op;
                        v0[0] += bf_lo(o.x); v0[1] += bf_hi(o.x); v0[2] += bf_lo(o.y); v0[3] += bf_hi(o.y); v1[0] += bf_lo(o.z); v1[1] += bf_hi(o.z); v1[2] += bf_lo(o.w); v1[3] += bf_hi(o.w); }
                    if (MODE == 2) { u32x2 w8 = {0u, 0u};
#pragma unroll
                        for (int j = 0; j < 4; ++j) { w8.x = __builtin_amdgcn_cvt_pk_u8_f32(__builtin_rintf(255.0f * sigmoidf_(v0[j])), j, w8.x); w8.y = __builtin_amdgcn_cvt_pk_u8_f32(__builtin_rintf(255.0f * sigmoidf_(v1[j])), j, w8.y); }
                        *(u32x2*)(GO + row * 1024 + c0 + bj * 128) = w8; continue; }
                    u32x4 w; w.x = cvtpk(v0[0], v0[1]); w.y = cvtpk(v0[2], v0[3]); w.z = cvtpk(v1[0], v1[1]); w.w = cvtpk(v1[2], v1[3]);
                    *(u32x4*)op = w; } }
    }
};
struct EpiSwiGLU {
    static constexpr bool PERM = true, REPEATABLE = true;
    bf16_t* H;
    __device__ __forceinline__ void operator()(const f32x4 (&acc)[2][2][4][2], const Unit& u, int wr, int wc, int fr, int fq) const {
        int r0 = wr * 64 + fr, c0 = u.pn * 128 + wc * 32 + 8 * fq; asm volatile("" : "+v"(r0), "+v"(c0));
#pragma unroll
        for (int ai = 0; ai < 2; ++ai)
#pragma unroll
            for (int m = 0; m < 4; ++m) { const size_t row = (size_t)u.pm * 256 + ai * 128 + m * 16 + r0;
                const f32x4 g0 = acc[ai][0][m][0], g1 = acc[ai][0][m][1], u0 = acc[ai][1][m][0], u1 = acc[ai][1][m][1];
                float h0[4], h1[4];
#pragma unroll
                for (int j = 0; j < 4; ++j) { h0[j] = g0[j] * sigmoidf_(g0[j]) * u0[j]; h1[j] = g1[j] * sigmoidf_(g1[j]) * u1[j]; }
                u32x4 w; w.x = cvtpk(h0[0], h0[1]); w.y = cvtpk(h0[2], h0[3]); w.z = cvtpk(h1[0], h1[1]); w.w = cvtpk(h1[2], h1[3]);
                *(u32x4*)(H + row * FF + c0) = w; }
    }
};
template <int MODE> struct EpiResF32 {
    static constexpr bool PERM = true, REPEATABLE = false;
    const float* Xin; unsigned short* Y; const bf16_t* P; const float* ST; const float* G; const float* B;
    __device__ __forceinline__ void operator()(const f32x4 (&acc)[2][2][4][2], const Unit& u, int wr, int wc, int fr, int fq) const {
        int r0 = wr * 64 + fr, c0 = u.pn * 256 + wc * 32 + 8 * fq; asm volatile("" : "+v"(r0), "+v"(c0));
        f32x4 gv[2][2], bv[2][2];
        if (!Xin) {
#pragma unroll
            for (int bj = 0; bj < 2; ++bj)
#pragma unroll
                for (int n = 0; n < 2; ++n) { gv[bj][n] = *(const f32x4*)(G + c0 + bj * 128 + n * 4); bv[bj][n] = *(const f32x4*)(B + c0 + bj * 128 + n * 4); }
        }
#pragma unroll
        for (int ai = 0; ai < 2; ++ai)
#pragma unroll
            for (int m = 0; m < 4; ++m) { const size_t row = (size_t)u.pm * 256 + ai * 128 + m * 16 + r0; const size_t off = row * D + c0;
                f32x2 st = {0.f, 1.f}; if (!Xin) st = *(const f32x2*)(ST + row * 2);
#pragma unroll
                for (int bj = 0; bj < 2; ++bj) { const size_t o = off + bj * 128;
                    f32x4 x0, x1;
                    if (Xin) { x0 = *(const f32x4*)(Xin + o); x1 = *(const f32x4*)(Xin + o + 4); }
                    else { const u32x4 yh = *(const u32x4*)(Y + o);
                        x0[0] = h_lo(yh.x); x0[1] = h_hi(yh.x); x0[2] = h_lo(yh.y); x0[3] = h_hi(yh.y); x1[0] = h_lo(yh.z); x1[1] = h_hi(yh.z); x1[2] = h_lo(yh.w); x1[3] = h_hi(yh.w);
                        x0 = (x0 - st[0]) * st[1] * gv[bj][0] + bv[bj][0]; x1 = (x1 - st[0]) * st[1] * gv[bj][1] + bv[bj][1]; }
                    f32x4 v0 = acc[ai][bj][m][0] + x0 * ALPHA, v1 = acc[ai][bj][m][1] + x1 * ALPHA;
                    if (MODE == 1) { const u32x4 p = *(const u32x4*)(P + o);
                        v0[0] += bf_lo(p.x); v0[1] += bf_hi(p.x); v0[2] += bf_lo(p.y); v0[3] += bf_hi(p.y); v1[0] += bf_lo(p.z); v1[1] += bf_hi(p.z); v1[2] += bf_lo(p.w); v1[3] += bf_hi(p.w); }
                    u32x4 w; w.x = pkh(v0[0], v0[1]); w.y = pkh(v0[2], v0[3]); w.z = pkh(v1[0], v1[1]); w.w = pkh(v1[2], v1[3]);
                    *(u32x4*)(Y + o) = w; } }
    }
};
struct EpiMoeDown {
    static constexpr bool PERM = true, REPEATABLE = false;
    bf16_t* Ys; const int* rdst; const float* rgate;
    __device__ __forceinline__ void operator()(const f32x4 (&acc)[2][2][4][2], const Unit& u, int wr, int wc, int fr, int fq) const {
        int r0 = wr * 64 + fr, c0 = u.pn * 256 + wc * 32 + 8 * fq; asm volatile("" : "+v"(r0), "+v"(c0));
#pragma unroll
        for (int ai = 0; ai < 2; ++ai)
#pragma unroll
            for (int m = 0; m < 4; ++m) { const int prow = u.pm * 256 + ai * 128 + m * 16 + r0; const int dst = rdst[prow]; const float gt = rgate[prow];
                if (dst >= 0) {
#pragma unroll
                    for (int bj = 0; bj < 2; ++bj) { const f32x4 v0 = acc[ai][bj][m][0] * gt, v1 = acc[ai][bj][m][1] * gt;
                        u32x4 w; w.x = cvtpk(v0[0], v0[1]); w.y = cvtpk(v0[2], v0[3]); w.z = cvtpk(v1[0], v1[1]); w.w = cvtpk(v1[2], v1[3]);
                        *(u32x4*)(Ys + (size_t)dst * D + c0 + bj * 128) = w; } } }
    }
};

struct SchedGrid {
    const char* A; const char* B; int nM, nN, G, c; size_t tstep;
    __device__ __forceinline__ bool next(int i, Unit& u) const { int pm, pn; if (!pg8::static_order(i, G, c, nM, nN, pm, pn)) return false; u.pm = pm; u.pn = pn; u.ty = 0; u.a = A + (size_t)pm * tstep; u.b = B + (size_t)pn * tstep; return true; }
};
struct SchedInProj {
    const char* X; const char* W; int G, c; size_t tstep;
    __device__ __forceinline__ bool next(int i, Unit& u) const { int pm, pn; if (!pg8::static_order(i, G, c, M / 256, 18, pm, pn)) return false; u.pm = pm; u.pn = pn;
        u.ty = pn < 4 ? 0 : pn < 6 ? 1 : pn < 8 ? 2 : pn < 10 ? 3 : 4;
        const char* xp = X + (size_t)pm * tstep; const char* wp = W + (size_t)pn * tstep;
        u.a = xp; u.b = wp; return true; }
};
struct SchedMoe {
    const char* A; const char* B; int npan, nN, G, c; size_t tstepA, tstepB; int pstart[NE + 1]; bool gather;
    __device__ __forceinline__ bool next(int i, Unit& u) const { int pm, pn; if (!pg8::static_order(i, G, c, npan, nN, pm, pn)) return false; u.pm = pm; u.pn = pn; u.ty = 0;
        int e = 0;
#pragma unroll
        for (int j = 1; j < NE; ++j) e += (pm >= pstart[j]) ? 1 : 0;
        u.a = gather ? A : A + (size_t)pm * tstepA; u.b = B + ((size_t)e * nN + pn) * tstepB; return true; }
};

__device__ __forceinline__ void tr_load(f32x4 (&v)[8], const float* W, int ldw, int k0, int c0, int lane) {
    const int lr = lane >> 3, lc = (lane & 7) * 4;
#pragma unroll
    for (int i = 0; i < 8; ++i) v[i] = *(const f32x4*)(W + (size_t)(k0 + 8 * i + lr) * ldw + c0 + lc);
}
__device__ __forceinline__ void tr_store(const f32x4 (&v)[8], int k0, bf16_t* WT, int K, int nrow0, LAS float* scr, int lane) {
    const int lr = lane >> 3, lc = (lane & 7) * 4;
#pragma unroll
    for (int i = 0; i < 8; ++i) { LAS float* d = scr + (8 * i + lr) * 33 + lc; d[0] = v[i][0]; d[1] = v[i][1]; d[2] = v[i][2]; d[3] = v[i][3]; }
    LDS_WAIT(); asm volatile("" ::: "memory");
    const int c = lane & 7;
#pragma unroll
    for (int j = 0; j < 4; ++j) { const int n = (lane >> 3) + 8 * j; const LAS float* s = scr + (8 * c) * 33 + n;
        u32x4 o; o.x = cvtpk(s[0 * 33], s[1 * 33]); o.y = cvtpk(s[2 * 33], s[3 * 33]); o.z = cvtpk(s[4 * 33], s[5 * 33]); o.w = cvtpk(s[6 * 33], s[7 * 33]);
        *(u32x4*)(WT + (size_t)(nrow0 + n) * K + k0 + 8 * c) = o; }
    LDS_WAIT(); asm volatile("" ::: "memory");
}
struct Job { const float* s0; const float* s1; bf16_t* dst; int ld, K, N, fam; };
__device__ __forceinline__ void run_job(Frame& F, const Job& jb, int rot) {
    LAS float* scr = (LAS float*)(F.lds + F.wave * 16384);
    const int NGW = F.G * NWAVES; int gw = (F.vcu * NWAVES + F.wave + rot) % NGW;
    const int nblk = jb.N / 32, nitems = (jb.K / 64) * nblk;
#define TR_DECODE(it_, src_, c0_, n0_, k0_) const int kb_ = (it_) / nblk, nb_ = (it_) - kb_ * nblk; n0_ = nb_ * 32; k0_ = kb_ * 64; src_ = jb.s0; c0_ = n0_; \
        if (jb.fam == 0) { if (n0_ < 1024) { const int t = n0_ >> 8, w = n0_ & 255; c0_ = (w < 128) ? 128 * t + w : 512 + 128 * t + (w - 128); } } \
        else if (jb.fam == 2) { const int t = n0_ >> 8, w = n0_ & 255; src_ = (w < 128) ? jb.s0 : jb.s1; c0_ = 128 * t + (w & 127); }
    f32x4 va[8], vb[8]; int n0a = 0, k0a = 0, n0b = 0, k0b = 0;
    if (gw < nitems) { const float* src; int c0; TR_DECODE(gw, src, c0, n0a, k0a) tr_load(va, src, jb.ld, k0a, c0, F.lane); }
    for (int it = gw; it < nitems; it += 2 * NGW) {
        const bool hb = it + NGW < nitems;
        if (hb) { const float* src; int c0; TR_DECODE(it + NGW, src, c0, n0b, k0b) tr_load(vb, src, jb.ld, k0b, c0, F.lane); }
        tr_store(va, k0a, jb.dst, jb.K, n0a, scr, F.lane);
        if (it + 2 * NGW < nitems) { const float* src; int c0; TR_DECODE(it + 2 * NGW, src, c0, n0a, k0a) tr_load(va, src, jb.ld, k0a, c0, F.lane); }
        if (hb) tr_store(vb, k0b, jb.dst, jb.K, n0b, scr, F.lane);
    }
#undef TR_DECODE
}
__device__ __forceinline__ Job base_job(Frame& F, int j) {
    Job jb; jb.s1 = nullptr; jb.fam = 1;
    if (j < 24) { const int l = j / 6, k = j - l * 6;
        if (k == 0)      { jb.s0 = INP(3) + (size_t)l * D * NIN;  jb.ld = NIN; jb.K = D;    jb.N = NIN; jb.dst = (bf16_t*)(F.ws + WS_WIN + l * SZ_WIN); jb.fam = 0; }
        else if (k == 1) { jb.s0 = INP(8) + (size_t)l * CW * D;   jb.ld = D;   jb.K = CW;   jb.N = D;   jb.dst = (bf16_t*)(F.ws + WS_WC + l * SZ_WC); }
        else if (k == 2) { jb.s0 = INP(9) + (size_t)l * AW * D;   jb.ld = D;   jb.K = AW;   jb.N = D;   jb.dst = (bf16_t*)(F.ws + WS_WA + l * SZ_WA); }
        else if (k == 3) { jb.s0 = INP(10) + (size_t)l * D * D;   jb.ld = D;   jb.K = D;    jb.N = D;   jb.dst = (bf16_t*)(F.ws + WS_WOUT + l * SZ_WOUT); }
        else if (k == 4) { jb.s0 = INP(13) + (size_t)l * D * D;   jb.ld = D;   jb.K = D;    jb.N = D;   jb.dst = (bf16_t*)(F.ws + WS_WPG + l * SZ_WPG); }
        else             { jb.s0 = INP(14) + (size_t)l * PLED * D; jb.ld = D;  jb.K = PLED; jb.N = D;   jb.dst = (bf16_t*)(F.ws + WS_WPP + l * SZ_WPP); }
    } else { const int i = (j - 24) >> 1, k = (j - 24) & 1;
        if (k == 0) { jb.s0 = INP(17) + (size_t)i * D * FF; jb.s1 = INP(18) + (size_t)i * D * FF; jb.ld = FF; jb.K = D; jb.N = 2 * FF; jb.dst = (bf16_t*)(F.ws + WS_WGU + i * SZ_WGU); jb.fam = 2; }
        else        { jb.s0 = INP(19) + (size_t)i * FF * D; jb.ld = D; jb.K = FF; jb.N = D; jb.dst = (bf16_t*)(F.ws + WS_WD + i * SZ_WD); }
    }
    return jb;
}
__device__ __forceinline__ Job expert_job(Frame& F, int mi, int j) {
    Job jb; const int e = j >> 1, k = j & 1; const size_t eo = (size_t)(mi * NE + e) * D * FF;
    if (k == 0) { jb.s0 = INP(21) + eo; jb.s1 = INP(22) + eo; jb.ld = FF; jb.K = D; jb.N = 2 * FF; jb.dst = (bf16_t*)(F.ws + WS_EWGU + e * SZ_WGU); jb.fam = 2; }
    else        { jb.s0 = INP(23) + eo; jb.s1 = nullptr;       jb.ld = D;  jb.K = FF; jb.N = D;     jb.dst = (bf16_t*)(F.ws + WS_EWD + e * SZ_WD);   jb.fam = 1; }
    return jb;
}
__device__ __forceinline__ void cvt_rows(Frame& F, const float* src, bf16_t* dst, size_t n, int part = -1, int nparts = 0) {
    if (part < 0) { part = F.vcu; nparts = F.G; }
    const size_t nch = n / 8, stride = (size_t)nparts * NTHR;
    for (size_t i0 = (size_t)part * NTHR + F.tid; i0 < nch; i0 += 4 * stride) {
        f32x4 a[4], b[4];
#pragma unroll
        for (int u = 0; u < 4; ++u) { const size_t i = i0 + u * stride; if (i < nch) { a[u] = *(const f32x4*)(src + i * 8); b[u] = *(const f32x4*)(src + i * 8 + 4); } }
#pragma unroll
        for (int u = 0; u < 4; ++u) { const size_t i = i0 + u * stride; if (i < nch) { u32x4 w; w.x = cvtpk(a[u][0], a[u][1]); w.y = cvtpk(a[u][2], a[u][3]); w.z = cvtpk(b[u][0], b[u][1]); w.w = cvtpk(b[u][2], b[u][3]); *(u32x4*)(dst + i * 8) = w; } }
    }
}
__device__ __forceinline__ void prologue_phase(Frame& F) {
    for (int j = 0; j < 28; ++j) { const Job jb = base_job(F, j); run_job(F, jb, (j * 397) & 2047); }
    for (int j = 0; j < 16; ++j) { const Job jb = expert_job(F, 0, j); run_job(F, jb, (j * 397 + 100) & 2047); }
    cvt_rows(F, INP(0), (bf16_t*)(F.ws + WS_XB), (size_t)M * D);
}

__device__ __forceinline__ void thin_phase(Frame& F, int l) {
    const int tid = F.tid, lane = F.lane, wave = F.wave;
    {   const bf16_t* Kb = (const bf16_t*)(F.ws + WS_K); float* KM = (float*)(F.ws + WS_KM); LAS float* ps = (LAS float*)F.lds;
        const int GH = F.G / 2;
        if (F.vcu >= GH) cvt_rows(F, INP(1) + (size_t)l * M * PLED, (bf16_t*)(F.ws + WS_PB), (size_t)M * PLED, F.vcu - GH, F.G - GH);
        else for (int u = F.vcu; u < M / 256; u += GH) {
            float s[8] = {0.f, 0.f, 0.f, 0.f, 0.f, 0.f, 0.f, 0.f};
#pragma unroll 1
            for (int i0 = 0; i0 < 32; i0 += 16) { u32x4 kv[16];
#pragma unroll
                for (int i = 0; i < 16; ++i) kv[i] = *(const u32x4*)(Kb + ((size_t)u * 256 + wave + 8 * (i0 + i)) * 512 + lane * 8);
#pragma unroll
                for (int i = 0; i < 16; ++i) { const u32x4 v = kv[i];
                    s[0] += bf_lo(v.x); s[1] += bf_hi(v.x); s[2] += bf_lo(v.y); s[3] += bf_hi(v.y); s[4] += bf_lo(v.z); s[5] += bf_hi(v.z); s[6] += bf_lo(v.w); s[7] += bf_hi(v.w); } }
            __syncthreads();
#pragma unroll
            for (int j = 0; j < 8; ++j) ps[wave * 512 + lane * 8 + j] = s[j];
            __syncthreads();
            float t = 0.f;
#pragma unroll
            for (int w = 0; w < 8; ++w) t += ps[w * 512 + tid];
            KM[(size_t)u * 512 + tid] = t * (1.0f / 256.0f);
        }
        __syncthreads();
    }
    {   const bf16_t* H0 = (const bf16_t*)(F.ws + WS_H0); bf16_t* HC = (bf16_t*)(F.ws + WS_HC);
        LAS float* wl = (LAS float*)F.lds; LAS bf16_t* xt = (LAS bf16_t*)(F.lds + 63488);
        const float* cw = INP(4) + (size_t)l * CKW * CW;
        { f32x4 wv8[8];
#pragma unroll
          for (int k = 0; k < 8; ++k) { const int i = tid + k * NTHR; if (i < CKW * CW / 4) wv8[k] = ((const f32x4*)cw)[i]; }
#pragma unroll
          for (int k = 0; k < 8; ++k) { const int i = tid + k * NTHR; if (i < CKW * CW / 4) { const int j_ = i >> 7, q_ = i & 127; ((LAS f32x4*)wl)[(j_ * 2 + (q_ & 1)) * 64 + (q_ >> 1)] = wv8[k]; } } }
        const f32x4 cb0 = *(const f32x4*)(INP(5) + l * CW + lane * 8), cb1 = *(const f32x4*)(INP(5) + l * CW + lane * 8 + 4);
        const f32x4 lg0 = *(const f32x4*)(INP(6) + l * CW + lane * 8), lg1 = *(const f32x4*)(INP(6) + l * CW + lane * 8 + 4);
        const f32x4 lb0 = *(const f32x4*)(INP(7) + l * CW + lane * 8), lb1 = *(const f32x4*)(INP(7) + l * CW + lane * 8 + 4);
        u32x4 xv8[8];
#define CONV_LOAD(u_) do { const int b_ = (u_) / (SEQ / 32), t0_ = ((u_) % (SEQ / 32)) * 32; _Pragma("unroll") for (int k = 0; k < 8; ++k) { const int i = tid + k * NTHR, row = i >> 6, ch = i & 63, t = t0_ - 30 + row; \
            xv8[k] = (u32x4){0u, 0u, 0u, 0u}; if (i < 62 * 64 && t >= 0) xv8[k] = *(const u32x4*)(H0 + ((size_t)(b_ * SEQ + t)) * 512 + ch * 8); } } while (0)
        if (F.vcu < BATCH * (SEQ / 32)) CONV_LOAD(F.vcu);
        for (int u = F.vcu; u < BATCH * (SEQ / 32); u += F.G) {
            const int b = u / (SEQ / 32), t0 = (u % (SEQ / 32)) * 32;
            __syncthreads();
#pragma unroll
            for (int k = 0; k < 8; ++k) { const int i = tid + k * NTHR, row = i >> 6, ch = i & 63; if (i < 62 * 64) *(LAS u32x4*)(xt + row * 512 + ch * 8) = xv8[k]; }
            __syncthreads();
            if (u + F.G < BATCH * (SEQ / 32)) CONV_LOAD(u + F.G);
            float acc[4][8];
#pragma unroll
            for (int tt = 0; tt < 4; ++tt)
#pragma unroll
                for (int c = 0; c < 8; ++c) acc[tt][c] = 0.f;
#pragma unroll 4
            for (int j = 0; j < CKW; ++j) {
                const f32x4 w0 = *(const LAS f32x4*)(wl + (j * 2) * 256 + lane * 4), w1 = *(const LAS f32x4*)(wl + (j * 2 + 1) * 256 + lane * 4);
#pragma unroll
                for (int tt = 0; tt < 4; ++tt) { const u32x4 xv = *(const LAS u32x4*)(xt + (wave * 4 + tt + j) * 512 + lane * 8);
                    acc[tt][0] += w0[0] * bf_lo(xv.x); acc[tt][1] += w0[1] * bf_hi(xv.x); acc[tt][2] += w0[2] * bf_lo(xv.y); acc[tt][3] += w0[3] * bf_hi(xv.y);
                    acc[tt][4] += w1[0] * bf_lo(xv.z); acc[tt][5] += w1[1] * bf_hi(xv.z); acc[tt][6] += w1[2] * bf_lo(xv.w); acc[tt][7] += w1[3] * bf_hi(xv.w); }
            }
#pragma unroll
            for (int tt = 0; tt < 4; ++tt) {
                float v[8]; float s = 0.f;
#pragma unroll
                for (int c = 0; c < 8; ++c) { v[c] = acc[tt][c] + (c < 4 ? cb0[c] : cb1[c - 4]); s += v[c]; }
                const float mean = wave_sum(s) * (1.0f / CW); float q = 0.f;
#pragma unroll
                for (int c = 0; c < 8; ++c) { v[c] -= mean; q += v[c] * v[c]; }
                const float rstd = 1.0f / sqrtf(wave_sum(q) * (1.0f / CW) + LN_EPS);
#pragma unroll
                for (int c = 0; c < 8; ++c) { const float y = v[c] * rstd * (c < 4 ? lg0[c] : lg1[c - 4]) + (c < 4 ? lb0[c] : lb1[c - 4]); v[c] = y * sigmoidf_(y); }
                u32x4 w; w.x = cvtpk(v[0], v[1]); w.y = cvtpk(v[2], v[3]); w.z = cvtpk(v[4], v[5]); w.w = cvtpk(v[6], v[7]);
                *(u32x4*)(HC + ((size_t)(b * SEQ + t0 + wave * 4 + tt)) * 512 + lane * 8) = w;
            }
        }
#undef CONV_LOAD
        __syncthreads();
    }
    if (l == 2) { for (int j = 0; j < 16; ++j) { const Job jb = expert_job(F, 1, j); run_job(F, jb, (j * 397) & 2047); } }
}

template <int MODE> __device__ __forceinline__ void ln_phase(Frame& F, int l, bool dummy) {
    const int tid = F.tid, lane = F.lane, wave = F.wave; const bool moe = (l & 1) != 0; const bool route = (MODE == 1) && moe && !dummy; const int mi = l >> 1;
    unsigned short* YB = (unsigned short*)(F.ws + WS_YB); bf16_t* XB = (bf16_t*)(F.ws + WS_XB);
    const float* gp = (MODE == 1 ? INP(11) : INP(15)) + l * D; const float* bp = (MODE == 1 ? INP(12) : INP(16)) + l * D;
    f32x4 g[4], bb[4], g1[4], b1v[4];
#pragma unroll
    for (int j = 0; j < 4; ++j) { g[j] = *(const f32x4*)(gp + 4 * lane + 256 * j); bb[j] = *(const f32x4*)(bp + 4 * lane + 256 * j); }
    if (MODE == 2 && moe) { const float* g1p = INP(11) + l * D; const float* b1p = INP(12) + l * D;
#pragma unroll
        for (int j = 0; j < 4; ++j) { g1[j] = *(const f32x4*)(g1p + 4 * lane + 256 * j); b1v[j] = *(const f32x4*)(b1p + 4 * lane + 256 * j); } }
    float* ST = (float*)(F.ws + WS_ST);
    LAS float* wr = (LAS float*)F.lds;
    LAS float* rt = (LAS float*)(F.lds + 32768);
    LAS int* lcnt = (LAS int*)(F.lds + 32768 + 2048);
    LAS int* lrk = (LAS int*)(F.lds + 32768 + 2048 + 64);
    if (route) { const float* rw = INP(20) + (size_t)mi * D * NE;
        f32x4 rv[4];
#pragma unroll
        for (int q = 0; q < 4; ++q) rv[q] = ((const f32x4*)rw)[tid + q * NTHR];
#pragma unroll
        for (int q = 0; q < 4; ++q) { const int i = tid + q * NTHR, kk = i >> 1, hf = i & 1, j_ = kk >> 8, ln_ = (kk & 255) >> 2, kp_ = kk & 3; ((LAS f32x4*)wr)[((j_ * 4 + kp_) * 2 + hf) * 64 + ln_] = rv[q]; }
        if (tid < 8) lcnt[tid] = 0; __syncthreads(); }
    for (int c = F.vcu; c < M / 128; c += F.G) {
        const bf16_t* Pp = (const bf16_t*)(F.ws + WS_PLE); const bf16_t* Ysp = (const bf16_t*)F.out;
        u32x2 nvv[2][4], npp[2][4], nyy0[2][4], nyy1[2][4]; f32x2 nstt[2];
#define LN_LOAD(S_, rw) do { _Pragma("unroll") for (int j = 0; j < 4; ++j) { nvv[S_][j] = *(const u32x2*)(YB + (rw) * D + 4 * lane + 256 * j); \
            if (MODE == 2 && moe) { if (j == 0) nstt[S_] = *(const f32x2*)(ST + (rw) * 2); npp[S_][j] = *(const u32x2*)(Pp + (rw) * D + 4 * lane + 256 * j); nyy0[S_][j] = *(const u32x2*)(Ysp + (2 * (rw)) * D + 4 * lane + 256 * j); nyy1[S_][j] = *(const u32x2*)(Ysp + (2 * (rw) + 1) * D + 4 * lane + 256 * j); } } } while (0)
        LN_LOAD(0, (size_t)c * 8 + wave); LN_LOAD(1, (size_t)(M / 16) + (size_t)c * 8 + wave);
        auto ln_row = [&](auto SC_, const int i) {
            constexpr int S_ = decltype(SC_)::value;
            const int rl = wave + 8 * i; const size_t row = (size_t)i * (M / 16) + (size_t)c * 8 + wave;
            f32x4 v[4]; float s = 0.f;
#pragma unroll
            for (int j = 0; j < 4; ++j) { const u32x2 nv = nvv[S_][j]; v[j][0] = h_lo(nv.x); v[j][1] = h_hi(nv.x); v[j][2] = h_lo(nv.y); v[j][3] = h_hi(nv.y); }
            if (MODE == 2 && moe) { const f32x2 nst = nstt[S_];
#pragma unroll
                for (int j = 0; j < 4; ++j) { const u32x2 p = npp[S_][j], y0 = nyy0[S_][j], y1 = nyy1[S_][j];
                    v[j] = (v[j] - nst[0]) * nst[1] * g1[j] + b1v[j];
                    v[j][0] = v[j][0] * ALPHA + bf_lo(p.x) + bf_lo(y0.x) + bf_lo(y1.x); v[j][1] = v[j][1] * ALPHA + bf_hi(p.x) + bf_hi(y0.x) + bf_hi(y1.x);
                    v[j][2] = v[j][2] * ALPHA + bf_lo(p.y) + bf_lo(y0.y) + bf_lo(y1.y); v[j][3] = v[j][3] * ALPHA + bf_hi(p.y) + bf_hi(y0.y) + bf_hi(y1.y); }
            }
            if (MODE == 2 && moe && l != DEPTH - 1) {
#pragma unroll
                for (int j = 0; j < 4; ++j) { u32x2 w; w.x = pkh(v[j][0], v[j][1]); w.y = pkh(v[j][2], v[j][3]); *(u32x2*)(YB + row * D + 4 * lane + 256 * j) = w;
                    v[j][0] = h_lo(w.x); v[j][1] = h_hi(w.x); v[j][2] = h_lo(w.y); v[j][3] = h_hi(w.y); } }
            if (i + 2 < 16) LN_LOAD(S_, row + 2 * (size_t)(M / 16));
#pragma unroll
            for (int j = 0; j < 4; ++j) s += (v[j][0] + v[j][1]) + (v[j][2] + v[j][3]);
            const float mean = wave_sum(s) * (1.0f / D); float q = 0.f;
#pragma unroll
            for (int j = 0; j < 4; ++j) { v[j] = v[j] - mean; q += (v[j][0] * v[j][0] + v[j][1] * v[j][1]) + (v[j][2] * v[j][2] + v[j][3] * v[j][3]); }
            const float rstd = 1.0f / sqrtf(wave_sum(q) * (1.0f / D) + LN_EPS);
            const bool last = (MODE == 2) && (l == DEPTH - 1); bf16_t* ob = XB; (void)dummy;
            if (lane == 0) *(f32x2*)(ST + row * 2) = (f32x2){mean, rstd};
#pragma unroll
            for (int j = 0; j < 4; ++j) { v[j] = v[j] * rstd * g[j] + bb[j]; if (last) *(f32x4*)(F.out + row * D + 4 * lane + 256 * j) = v[j];
                u32x2 w; w.x = cvtpk(v[j][0], v[j][1]); w.y = cvtpk(v[j][2], v[j][3]); if (!last) *(u32x2*)(ob + row * D + 4 * lane + 256 * j) = w; }
            if (route) {
                float lg[NE];
#pragma unroll
                for (int e = 0; e < NE; ++e) lg[e] = 0.f;
#pragma unroll
                for (int j = 0; j < 4; ++j)
#pragma unroll
                    for (int k = 0; k < 4; ++k) { const f32x4 w0 = *(const LAS f32x4*)(wr + (((j * 4 + k) * 2 + 0) * 64 + lane) * 4), w1 = *(const LAS f32x4*)(wr + (((j * 4 + k) * 2 + 1) * 64 + lane) * 4); const float xv = v[j][k];
                        lg[0] += xv * w0[0]; lg[1] += xv * w0[1]; lg[2] += xv * w0[2]; lg[3] += xv * w0[3]; lg[4] += xv * w1[0]; lg[5] += xv * w1[1]; lg[6] += xv * w1[2]; lg[7] += xv * w1[3]; }
#pragma unroll
                for (int e = 0; e < NE; ++e) lg[e] = wave_sum(lg[e]);
                float b1 = lg[0]; int i1 = 0;
#pragma unroll
                for (int e = 1; e < NE; ++e) if (lg[e] > b1) { b1 = lg[e]; i1 = e; }
                float b2 = -INFINITY; int i2 = 0;
#pragma unroll
                for (int e = 0; e < NE; ++e) if (e != i1 && lg[e] > b2) { b2 = lg[e]; i2 = e; }
                const float p1 = 1.0f / (1.0f + __expf(b2 - b1));
                if (lane == 0) { rt[rl * 4 + 0] = __int_as_float(i1); rt[rl * 4 + 1] = __int_as_float(i2); rt[rl * 4 + 2] = p1; rt[rl * 4 + 3] = 1.0f - p1; }
            }
        };
        for (int i = 0; i < 16; i += 2) { ln_row(std::integral_constant<int, 0>{}, i); ln_row(std::integral_constant<int, 1>{}, i + 1); }
#undef LN_LOAD
        if (route) {
            __syncthreads();
            int e1 = 0, e2 = 0;
            if (tid < 128) { e1 = __float_as_int(rt[tid * 4 + 0]); e2 = __float_as_int(rt[tid * 4 + 1]); lrk[tid * 2 + 0] = atomicAdd((int*)&lcnt[e1], 1); lrk[tid * 2 + 1] = atomicAdd((int*)&lcnt[e2], 1); }
            __syncthreads();
            if (tid < 8) { const int n = lcnt[tid]; lcnt[8 + tid] = (int)__hip_atomic_fetch_add(F.ctl + CW_GCNT + (mi * NE + tid) * 64, (unsigned)n, RLX_AGENT); }
            __syncthreads();
            if (tid < 128) { int* ro = (int*)(F.ws + WS_ROUTE) + ((size_t)(tid >> 3) * (M / 16) + (size_t)c * 8 + (tid & 7)) * 8;
                ro[0] = e1; ro[1] = e2; ro[2] = lcnt[8 + e1] + lrk[tid * 2 + 0]; ro[3] = lcnt[8 + e2] + lrk[tid * 2 + 1]; ((float*)ro)[4] = rt[tid * 4 + 2]; ((float*)ro)[5] = rt[tid * 4 + 3]; }
            __syncthreads();
            if (tid < 8) lcnt[tid] = 0;
            __syncthreads();
        }
    }
}
__device__ __forceinline__ void moe_starts(Frame& F, int mi, int (&pstart)[NE + 1]) {
    int acc = 0;
#pragma unroll
    for (int e = 0; e < NE; ++e) { pstart[e] = acc; const int n = (int)__hip_atomic_load(F.ctl + CW_GCNT + (mi * NE + e) * 64, RLX_AGENT); acc += (n + 255) >> 8; }
    pstart[NE] = acc;
}
__device__ __forceinline__ void route_build(Frame& F, int mi) {
    int pstart[NE + 1]; moe_starts(F, mi, pstart);
    int* rtok = (int*)(F.ws + WS_RTOK); int* rdst = (int*)(F.ws + WS_RDST); float* rgate = (float*)(F.ws + WS_RGATE);
    for (int t = F.vcu * NTHR + F.tid; t < M; t += F.G * NTHR) { const int* ro = (const int*)(F.ws + WS_ROUTE) + (size_t)t * 8;
        int e1 = ro[0], e2 = ro[1], r1 = ro[2], r2 = ro[3]; const float p1 = ((const float*)ro)[4], p2 = ((const float*)ro)[5];
        int s1 = 0, s2 = 0;
#pragma unroll
        for (int e = 0; e < NE; ++e) { s1 = (e == e1) ? pstart[e] : s1; s2 = (e == e2) ? pstart[e] : s2; }
        const int q1 = s1 * 256 + r1, q2 = s2 * 256 + r2;
        rtok[q1] = t; rdst[q1] = 2 * t; rgate[q1] = p1; rtok[q2] = t; rdst[q2] = 2 * t + 1; rgate[q2] = p2; }
    if (F.vcu < NE) { const int e = F.vcu; const int n = (int)__hip_atomic_load(F.ctl + CW_GCNT + (mi * NE + e) * 64, RLX_AGENT);
        for (int q = pstart[e] * 256 + n + F.tid; q < pstart[e + 1] * 256; q += NTHR) { rtok[q] = 0; rdst[q] = -1; rgate[q] = 0.f; } }
}

__device__ __forceinline__ int crow(int r, int hi) { return (r & 3) + 8 * (r >> 2) + 4 * hi; }
__device__ __forceinline__ float pl32_max(float m) { auto rr = __builtin_amdgcn_permlane32_swap(__float_as_uint(m), __float_as_uint(m), false, false); return fmaxf(__uint_as_float(rr[0]), __uint_as_float(rr[1])); }
__device__ __forceinline__ float pl32_sum(float m) { auto rr = __builtin_amdgcn_permlane32_swap(__float_as_uint(m), __float_as_uint(m), false, false); return __uint_as_float(rr[0]) + __uint_as_float(rr[1]); }
__device__ __forceinline__ int rel_bucket_dev(int n) {
    if (n < 16) return n;
    const int large = 16 + (int)(__log2f((float)n * (1.0f / 16.0f)) * (16.0f / 3.0f));
    return large < 31 ? large : 31;
}
constexpr int AT_TILE = 8192, AT_SLOT = 2 * AT_TILE, AT_K = 0, AT_V = 3 * AT_SLOT, AT_LUT = 6 * AT_SLOT, AT_WSF = AT_LUT + 512, AT_END = AT_WSF + NWAVES * 256, AT_OST = 0;
static_assert(AT_END <= RING_BYTES, "attention LDS");
constexpr float AT_THR = 8.0f;
typedef short v4i16_t __attribute__((ext_vector_type(4)));
__device__ __forceinline__ float max3f_(float a, float b, float c) { return __builtin_fmaxf(__builtin_fmaxf(a, b), c); }
__device__ __forceinline__ void at_qk(f32x16& p0, f32x16& p1, const LAS unsigned char* kb, const bf16x8 (&qf)[4], float cinit) {
#pragma unroll
    for (int x = 0; x < 16; ++x) { p0[x] = cinit; p1[x] = cinit; }
#pragma unroll
    for (int d0 = 0; d0 < 4; ++d0) {
        const bf16x8 a0 = *(const LAS bf16x8*)(kb + d0 * 2048), a1 = *(const LAS bf16x8*)(kb + d0 * 2048 + 512);
        p0 = __builtin_amdgcn_mfma_f32_32x32x16_bf16(a0, qf[d0], p0, 0, 0, 0);
        p1 = __builtin_amdgcn_mfma_f32_32x32x16_bf16(a1, qf[d0], p1, 0, 0, 0);
    }
}
__device__ __forceinline__ void attn_phase(Frame& F) {
    const int tid = F.tid, lane = F.lane, wid = F.wave, r = lane & 31, hh = lane >> 5;
    const bf16_t* Q = (const bf16_t*)(F.ws + WS_Q); const bf16_t* Kb = (const bf16_t*)(F.ws + WS_K); const bf16_t* Vb = (const bf16_t*)(F.ws + WS_VT);
    const float* KM = (const float*)(F.ws + WS_KM); bf16_t* HA = (bf16_t*)(F.ws + WS_HA); const float* rel_bias = INP(2);
    LAS unsigned char* L = F.lds; LAS float* lut = (LAS float*)(L + AT_LUT); LAS float* wsf = (LAS float*)(L + AT_WSF) + wid * 64; LAS bf16_t* ost = (LAS bf16_t*)(L + AT_OST) + wid * 2048;
    const int kdo = lane * 512 + wid * 8;
    const int vdo = (16 * (wid & 3) + (lane >> 2)) * 512 + (wid >> 2) * 32 + (lane & 3) * 8;
    const int kro = hh * 1024 + r * 16;
    const int vro = ((lane >> 4) & 1) * 32 + (lane & 3) * 8 + (4 * hh + ((lane & 15) >> 2)) * 64;
    for (int n = F.vcu; n < BATCH * NH * NBLK; n += F.G) {
        const int ii = n >> 8, w = n & 255, bh = w >> 2, s4 = w & 3; const int qb = (ii == 0) ? s4 : (ii == 1) ? 7 - s4 : (ii == 2) ? 8 + s4 : 15 - s4;
        const int b = bh >> 3, h = bh & 7;
        const int q0 = qb * 256 + wid * 32;
        const bf16_t* Kh = Kb + (size_t)b * SEQ * 512 + h * 64; const bf16_t* Vh = Vb + (size_t)b * SEQ * 512 + h * 64;
        const int NS = 2 * (qb + 1);
#define AT_KP(i) (((i) < 2) ? qb * 256 + (i) * 128 : ((i) - 2) * 128)
#define AT_DMA(i) do { const int kp_ = AT_KP(i); const int sl_ = ((i) % 3) * AT_SLOT; _Pragma("unroll") for (int t_ = 0; t_ < 2; ++t_) { \
            __builtin_amdgcn_global_load_lds((const unsigned*)(Kh + (size_t)(kp_ + 64 * t_) * 512 + kdo), (LAS unsigned*)(L + AT_K + sl_ + t_ * AT_TILE + wid * 1024), 16, 0, 0); \
            __builtin_amdgcn_global_load_lds((const unsigned*)(Vh + (size_t)(kp_ + 64 * t_) * 512 + vdo), (LAS unsigned*)(L + AT_V + sl_ + t_ * AT_TILE + wid * 1024), 16, 0, 0); } } while (0)
        asm volatile("s_waitcnt vmcnt(0)" ::: "memory");
        __syncthreads();
        if (tid < 128) lut[tid] = rel_bias[rel_bucket_dev(tid) * NH + h] * LOG2E;
        AT_DMA(0); AT_DMA(1);
        bf16x8 qf[4];
#pragma unroll
        for (int d0 = 0; d0 < 4; ++d0) qf[d0] = *(const bf16x8*)(Q + ((size_t)(b * SEQ + q0 + r)) * 512 + h * 64 + d0 * 16 + hh * 8);
        unsigned selmask = 0u;
        if (qb > 0) {
            f32x16 sc;
#pragma unroll
            for (int i = 0; i < 16; ++i) sc[i] = 0.f;
#pragma unroll
            for (int d0 = 0; d0 < 4; ++d0) {
                f32x4 k0 = {0.f, 0.f, 0.f, 0.f}, k1 = {0.f, 0.f, 0.f, 0.f};
                if (r < 16) { const float* kp = KM + ((size_t)(b * NBLK + r)) * 512 + h * 64 + d0 * 16 + hh * 8; k0 = *(const f32x4*)kp; k1 = *(const f32x4*)(kp + 4); }
                u32x4 hi4, lo4;
                hi4.x = cvtpk(k0[0], k0[1]); hi4.y = cvtpk(k0[2], k0[3]); hi4.z = cvtpk(k1[0], k1[1]); hi4.w = cvtpk(k1[2], k1[3]);
                lo4.x = cvtpk(k0[0] - bf_lo(hi4.x), k0[1] - bf_hi(hi4.x)); lo4.y = cvtpk(k0[2] - bf_lo(hi4.y), k0[3] - bf_hi(hi4.y));
                lo4.z = cvtpk(k1[0] - bf_lo(hi4.z), k1[1] - bf_hi(hi4.z)); lo4.w = cvtpk(k1[2] - bf_lo(hi4.w), k1[3] - bf_hi(hi4.w));
                sc = __builtin_amdgcn_mfma_f32_32x32x16_bf16(__builtin_bit_cast(bf16x8, hi4), qf[d0], sc, 0, 0, 0);
                sc = __builtin_amdgcn_mfma_f32_32x32x16_bf16(__builtin_bit_cast(bf16x8, lo4), qf[d0], sc, 0, 0, 0);
            }
            float full[16];
#pragma unroll
            for (int g = 0; g < 8; ++g) { const float mine = sc[g], other = shfl_xor_(mine, 32, lane);
                full[crow(g, 0)] = hh ? other : mine; full[crow(g, 1)] = hh ? mine : other; }
#pragma unroll
            for (int p = 0; p < 3; ++p) { float best = -INFINITY; int bi = -1;
#pragma unroll
                for (int j = 0; j < 16; ++j) { const bool ok = (j < qb) && !((selmask >> j) & 1u) && (full[j] > best); best = ok ? full[j] : best; bi = ok ? j : bi; }
                if (bi >= 0) selmask |= 1u << bi; }
        }
        float mref = 0.f, l_run = 0.f; f32x16 o0, o1; bool first = true;
#pragma unroll
        for (int i = 0; i < 16; ++i) { o0[i] = 0.f; o1[i] = 0.f; }
        const float bconst = rel_bias[31 * NH + h] * LOG2E;
        for (int i = 0; i < NS; ++i) {
            if (i + 1 < NS) asm volatile("s_waitcnt vmcnt(4) lgkmcnt(0)" ::: "memory"); else asm volatile("s_waitcnt vmcnt(0) lgkmcnt(0)" ::: "memory");
            __builtin_amdgcn_s_barrier(); asm volatile("" ::: "memory");
            if (i + 2 < NS) AT_DMA(i + 2);
            const int sl = (i % 3) * AT_SLOT; const bool own = i < 2; const int kpA = AT_KP(i), kpB = kpA + 64; const int jblk = (i - 2) >> 1;
            const bool sel = own ? true : (((selmask >> jblk) & 1u) != 0u);
            const bool doA = own ? !(i * 128 > wid * 32 + 31) : __any(sel), doB = own ? !(i * 128 + 64 > wid * 32 + 31) : doA;
            if (doA && ATTN_PROBE != 1) {
                const bool lutA = own || (q0 - (kpA + 63) < 113), lutB = own || (q0 - (kpB + 63) < 113);
                const float cc = sel ? bconst - mref : -INFINITY;
                f32x16 a0, a1, b0, b1;
                at_qk(a0, a1, L + AT_K + sl + kro, qf, lutA ? -mref : cc);
                if (doB) at_qk(b0, b1, L + AT_K + sl + AT_TILE + kro, qf, lutB ? -mref : cc);
                else {
#pragma unroll
                    for (int x = 0; x < 16; ++x) { b0[x] = -INFINITY; b1[x] = -INFINITY; } }
#define AT_BIAS(P0, P1, KP) do { const int qpos = q0 + r; \
                    _Pragma("unroll") for (int x = 0; x < 16; ++x) { const int d0_ = qpos - ((KP) + crow(x, hh)), d1_ = d0_ - 32; \
                        float e0 = lut[d0_ < 0 ? 0 : (d0_ > 127 ? 127 : d0_)], e1 = lut[d1_ < 0 ? 0 : (d1_ > 127 ? 127 : d1_)]; asm volatile("" : "+v"(e0), "+v"(e1));     \
                        P0[x] = (d0_ < 0 || !sel) ? -INFINITY : P0[x] + e0; P1[x] = (d1_ < 0 || !sel) ? -INFINITY : P1[x] + e1; } } while (0)
                if (lutA) AT_BIAS(a0, a1, kpA);
                if (doB && lutB) AT_BIAS(b0, b1, kpB);
#undef AT_BIAS
                float mt0 = __builtin_fmaxf(a0[0], a1[0]), mt1 = __builtin_fmaxf(b0[0], b1[0]);
#pragma unroll
                for (int x = 1; x < 16; ++x) { mt0 = max3f_(mt0, a0[x], a1[x]); mt1 = max3f_(mt1, b0[x], b1[x]); }
                const float mt = pl32_max(__builtin_fmaxf(mt0, mt1));
                if (__any(first ? true : (mt > AT_THR))) {
                    const float dl = first ? mt : __builtin_fmaxf(mt, 0.f); const float alpha = first ? 0.f : __builtin_amdgcn_exp2f(-dl);
                    mref += dl; l_run *= alpha;
                    if (hh == 0) wsf[r] = alpha;
#pragma unroll
                    for (int x = 0; x < 16; ++x) { const float a_ = wsf[crow(x, hh)]; o0[x] *= a_; o1[x] *= a_; a0[x] -= dl; a1[x] -= dl; b0[x] -= dl; b1[x] -= dl; }
                    first = false;
                }
                float ls0 = 0.f, ls1 = 0.f, ls2 = 0.f, ls3 = 0.f;
#pragma unroll
                for (int x = 0; x < 16; ++x) { a0[x] = __builtin_amdgcn_exp2f(a0[x]); a1[x] = __builtin_amdgcn_exp2f(a1[x]); b0[x] = __builtin_amdgcn_exp2f(b0[x]); b1[x] = __builtin_amdgcn_exp2f(b1[x]);
                    ls0 += a0[x]; ls1 += a1[x]; ls2 += b0[x]; ls3 += b1[x]; }
                l_run += (ls0 + ls1) + (ls2 + ls3);
                const LAS unsigned char* va = L + AT_V + sl + vro; const LAS unsigned char* vbp = va + AT_TILE;
#define AT_PACK(P, B) (u32x4){cvtpk(P[B], P[B + 1]), cvtpk(P[B + 2], P[B + 3]), cvtpk(P[B + 4], P[B + 5]), cvtpk(P[B + 6], P[B + 7])}
#define AT_VFRAG(ptr) ({ const v4i16_t lo_ = __builtin_amdgcn_ds_read_tr16_b64_v4i16((LAS v4i16_t*)(ptr)), hi_ = __builtin_amdgcn_ds_read_tr16_b64_v4i16((LAS v4i16_t*)((ptr) + 512)); \
                    (bf16x8){lo_[0], lo_[1], lo_[2], lo_[3], hi_[0], hi_[1], hi_[2], hi_[3]}; })
#pragma unroll
                for (int ks = 0; ks < 4; ++ks) {
                    const u32x4 pa = (ks == 0) ? AT_PACK(a0, 0) : (ks == 1) ? AT_PACK(a0, 8) : (ks == 2) ? AT_PACK(a1, 0) : AT_PACK(a1, 8);
                    const bf16x8 fa = AT_VFRAG(va + ks * 1024), fb = AT_VFRAG(va + 4096 + ks * 1024);
                    o0 = __builtin_amdgcn_mfma_f32_32x32x16_bf16(__builtin_bit_cast(bf16x8, pa), fa, o0, 0, 0, 0);
                    o1 = __builtin_amdgcn_mfma_f32_32x32x16_bf16(__builtin_bit_cast(bf16x8, pa), fb, o1, 0, 0, 0);
                    if (doB) {
                        const u32x4 pb = (ks == 0) ? AT_PACK(b0, 0) : (ks == 1) ? AT_PACK(b0, 8) : (ks == 2) ? AT_PACK(b1, 0) : AT_PACK(b1, 8);
                        const bf16x8 fc = AT_VFRAG(vbp + ks * 1024), fd = AT_VFRAG(vbp + 4096 + ks * 1024);
                        o0 = __builtin_amdgcn_mfma_f32_32x32x16_bf16(__builtin_bit_cast(bf16x8, pb), fc, o0, 0, 0, 0);
                        o1 = __builtin_amdgcn_mfma_f32_32x32x16_bf16(__builtin_bit_cast(bf16x8, pb), fd, o1, 0, 0, 0);
                    }
                }
#undef AT_PACK
#undef AT_VFRAG
            }
        }
        const float lt = (ATTN_PROBE == 1) ? 1.0f : pl32_sum(l_run);
        if (hh == 0) wsf[r] = 1.0f / lt;
        asm volatile("s_waitcnt lgkmcnt(0)" ::: "memory"); __builtin_amdgcn_s_barrier(); asm volatile("" ::: "memory");
#pragma unroll
        for (int x = 0; x < 16; ++x) { const int qq = crow(x, hh); const float a = wsf[qq];
            ost[qq * 64 + r] = (bf16_t)(cvtpk(o0[x] * a, 0.f) & 0xffffu); ost[qq * 64 + 32 + r] = (bf16_t)(cvtpk(o1[x] * a, 0.f) & 0xffffu); }
        bf16_t* Ow = HA + ((size_t)(b * SEQ + q0)) * 512 + h * 64;
#pragma unroll
        for (int i = 0; i < 4; ++i) { const int row = i * 8 + (lane >> 3), ch = lane & 7; const u32x4 v = *(const LAS u32x4*)(ost + row * 64 + ch * 8); *(u32x4*)(Ow + (size_t)row * 512 + ch * 8) = v; }
#undef AT_KP
#undef AT_DMA
    }
    __syncthreads();
}
namespace attn_ex {
using bf16=__hip_bfloat16;
using bf16x8=__attribute__((ext_vector_type(8)))short;
using s16x4=__attribute__((ext_vector_type(4)))short;
using f32x16=__attribute__((ext_vector_type(16)))float;
using u32x4=__attribute__((ext_vector_type(4)))unsigned;
constexpr int BATCH=8,NHEAD=8,SEQ=4096,D=64,DM=NHEAD*D;
constexpr int NW=8,QBLK=32,QB=QBLK*NW,KVBLK=64,NQB=SEQ/QB;
constexpr int ATTN_PITCH=DM, ATTN_UNIT_ROWS=QB;
__device__ __forceinline__ int crow(int r,int hi){return (r&3)+8*(r>>2)+4*hi;}
#define SBAR() __builtin_amdgcn_sched_barrier(0)
__device__ __forceinline__ void cmask(f32x16&p0,f32x16&p1,int jb,int qrel,int hi){
  const float NEG=-INFINITY; int kb=64*jb+4*hi;
  #pragma unroll
  for(int r=0;r<16;++r){int kv=kb+(r&3)+8*(r>>2); if(kv>qrel)p0[r]=NEG; if(kv+32>qrel)p1[r]=NEG;}
}


__device__ __forceinline__ void lutmask(f32x16&p0,f32x16&p1,int kp,int qpos,bool sel,int hi,const __attribute__((address_space(3))) float*lut){
  const float NEG=-INFINITY;
  #pragma unroll
  for(int r=0;r<16;++r){ const int d0=qpos-(kp+crow(r,hi)), d1=d0-32;
    float e0=lut[d0<0?0:(d0>127?127:d0)], e1=lut[d1<0?0:(d1>127?127:d1)]; asm volatile("":"+v"(e0),"+v"(e1));
    p0[r]=(d0<0||!sel)?NEG:p0[r]+e0; p1[r]=(d1<0||!sel)?NEG:p1[r]+e1; }
}
constexpr int NSLOT=3, SLOTB=8192;
constexpr int LDS_K=0, LDS_V=NSLOT*SLOTB, LDS_WS=2*NSLOT*SLOTB, LDS_OST=LDS_WS+NW*64*4, LDS_LUT=LDS_OST+NW*4096, LDS_BYTES=LDS_LUT+512;
constexpr float C2=0.125f*1.4426950408889634f;
__device__ __forceinline__ void glds16(const void*gsrc,unsigned lds_dst){unsigned keep;
  asm volatile("s_mov_b32 %0, m0\n\ts_mov_b32 m0, %2\n\ts_nop 0\n\tglobal_load_lds_dwordx4 %1, off\n\ts_mov_b32 m0, %0":"=&s"(keep):"v"(gsrc),"s"(lds_dst):"memory");}
__device__ __forceinline__ float max3f(float a,float b,float c){float r;asm("v_max3_f32 %0, %1, %2, %3":"=v"(r):"v"(a),"v"(b),"v"(c));return r;}
__device__ __forceinline__ float max2f(float a,float b){float r;asm("v_max_f32_e32 %0, %1, %2":"=v"(r):"v"(a),"v"(b));return r;}
__device__ __forceinline__ float fadd_s(float a,float b){float r;asm("v_add_f32_e32 %0, %1, %2":"=v"(r):"v"(a),"v"(b));return r;}
__device__ __forceinline__ float fsub_s(float a,float b){float r;asm("v_sub_f32_e32 %0, %1, %2":"=v"(r):"v"(a),"v"(b));return r;}
typedef float f32x2_t __attribute__((ext_vector_type(2))); typedef __bf16 bf16x2_t __attribute__((ext_vector_type(2)));
__device__ __forceinline__ unsigned cvtpk_s(float lo,float hi){f32x2_t v={lo,hi};bf16x2_t b=__builtin_convertvector(v,bf16x2_t);return __builtin_bit_cast(unsigned,b);}
#define WAIT_BAR(N) asm volatile("s_waitcnt vmcnt(" #N ") lgkmcnt(0)\n\ts_barrier":::"memory")

__device__ __forceinline__ void qkt(f32x16&p0,f32x16&p1,const char*Kslot,const bf16x8*qr,const f32x16&negm,int r32,int hi){
  const char*kb=Kslot+hi*1024+r32*16;
  #pragma unroll
  for(int d0=0;d0<4;++d0){
    const bf16x8 b0=*reinterpret_cast<const bf16x8*>(kb+d0*2048);
    const bf16x8 b1=*reinterpret_cast<const bf16x8*>(kb+d0*2048+512);
    if(d0==0){p0=__builtin_amdgcn_mfma_f32_32x32x16_bf16(b0,qr[0],negm,0,0,0);p1=__builtin_amdgcn_mfma_f32_32x32x16_bf16(b1,qr[0],negm,0,0,0);}
    else{p0=__builtin_amdgcn_mfma_f32_32x32x16_bf16(b0,qr[d0],p0,0,0,0);p1=__builtin_amdgcn_mfma_f32_32x32x16_bf16(b1,qr[d0],p1,0,0,0);}}
}
typedef __attribute__((address_space(3))) const char* lds_cptr;
typedef short v4i16_t __attribute__((ext_vector_type(4)));
__device__ __forceinline__ void kload8(bf16x8*kf,lds_cptr kp){
  kf[0]=*(const __attribute__((address_space(3))) bf16x8*)(kp);      kf[1]=*(const __attribute__((address_space(3))) bf16x8*)(kp+512);
  kf[2]=*(const __attribute__((address_space(3))) bf16x8*)(kp+2048); kf[3]=*(const __attribute__((address_space(3))) bf16x8*)(kp+2560);
  kf[4]=*(const __attribute__((address_space(3))) bf16x8*)(kp+4096); kf[5]=*(const __attribute__((address_space(3))) bf16x8*)(kp+4608);
  kf[6]=*(const __attribute__((address_space(3))) bf16x8*)(kp+6144); kf[7]=*(const __attribute__((address_space(3))) bf16x8*)(kp+6656);
}
__device__ __forceinline__ void kload2(bf16x8*kf,lds_cptr kp,int j){ kf[2*j]=*(const __attribute__((address_space(3))) bf16x8*)(kp+j*2048); kf[2*j+1]=*(const __attribute__((address_space(3))) bf16x8*)(kp+j*2048+512); }
__device__ __forceinline__ s16x4 vtr(lds_cptr p){ return __builtin_bit_cast(s16x4,__builtin_amdgcn_ds_read_tr16_b64_v4i16((__attribute__((address_space(3))) v4i16_t*)p)); }
__device__ __forceinline__ float rowmax(const f32x16&p0,const f32x16&p1){
  float a=max3f(p0[0],p0[1],p1[0]),b=max3f(p0[2],p0[3],p1[1]);a=max3f(a,p1[2],p1[3]);
  #pragma unroll
  for(int r=4;r<16;r+=4){a=max3f(a,p0[r],p0[r+1]);b=max3f(b,p0[r+2],p0[r+3]);a=max3f(a,p1[r],p1[r+1]);b=max3f(b,p1[r+2],p1[r+3]);}
  const float m=max2f(a,b);
  auto rr=__builtin_amdgcn_permlane32_swap(__float_as_uint(m),__float_as_uint(m),false,false);
  return max2f(__uint_as_float(rr[0]),__uint_as_float(rr[1]));
}
__device__ __forceinline__ void pv(f32x16*o,int vb,bf16x8 pa0,bf16x8 pa1,bf16x8 pa2,bf16x8 pa3){
  #pragma unroll
  for(int d0=0;d0<2;++d0){s16x4 lo[4],hi[4];
    #pragma unroll
    for(int ks=0;ks<4;++ks){
      asm volatile("ds_read_b64_tr_b16 %0,%1 offset:%c2":"=&v"(lo[ks]):"v"(vb),"i"(d0*4096+ks*1024):"memory");
      asm volatile("ds_read_b64_tr_b16 %0,%1 offset:%c2":"=&v"(hi[ks]):"v"(vb),"i"(d0*4096+ks*1024+512):"memory");}
    asm volatile("s_waitcnt lgkmcnt(0)":::"memory");SBAR();
    #define PK(k) (bf16x8){lo[k][0],lo[k][1],lo[k][2],lo[k][3],hi[k][0],hi[k][1],hi[k][2],hi[k][3]}
    o[d0]=__builtin_amdgcn_mfma_f32_32x32x16_bf16(pa0,PK(0),o[d0],0,0,0);
    o[d0]=__builtin_amdgcn_mfma_f32_32x32x16_bf16(pa1,PK(1),o[d0],0,0,0);
    o[d0]=__builtin_amdgcn_mfma_f32_32x32x16_bf16(pa2,PK(2),o[d0],0,0,0);
    o[d0]=__builtin_amdgcn_mfma_f32_32x32x16_bf16(pa3,PK(3),o[d0],0,0,0);
    #undef PK
  }
}

#ifndef ATTN_STORE16
#define ATTN_STORE16(p,v) (*(u32x4*)(p)=(v))
#endif
template<int THRL> __device__ __forceinline__ void attn_unit(int b,int h,int qb,const bf16*Q,const bf16*__restrict__ K,const bf16*__restrict__ V,bf16*O,char*shm,const float*KMp,const float*rel_bias,const int tid){
  const int lane=tid&63,r32=lane&31,hi=lane>>5; const int wid=__builtin_amdgcn_readfirstlane(tid>>6);
  const long rowbase=(long)b*SEQ; const int q0=qb*QB;
  const bf16*Qw=Q+(rowbase+q0+wid*QBLK)*DM+h*D;
  const bf16*Kh=K+rowbase*DM+h*D,*Vh=V+rowbase*DM+h*D;
  const unsigned lds0=(unsigned)(uintptr_t)shm;
  float*wsf=(float*)(shm+LDS_WS)+wid*64;
  const bf16*ksrc=Kh+(long)lane*DM+wid*8;
  const bf16*vsrc=Vh+(long)(16*(wid&3)+(lane>>2))*DM+(wid>>2)*32+(lane&3)*8;
  const unsigned kdst=lds0+LDS_K+wid*1024, vdst=lds0+LDS_V+wid*1024;
  #define TPOS(t) (((t)<4)?(q0+64*(t)):(64*((t)-4)))
  #define DMA_K(t,slot) glds16(ksrc+(long)TPOS(t)*DM,(unsigned)__builtin_amdgcn_readfirstlane(kdst+(slot)))
  #define DMA_V(t,slot) glds16(vsrc+(long)TPOS(t)*DM,(unsigned)__builtin_amdgcn_readfirstlane(vdst+(slot)))
  const int vb0=(int)(lds0+LDS_V)+((lane>>4)&1)*32+(lane&3)*8+(4*hi+((lane&15)>>2))*64;
  const char*Kbase=shm+LDS_K; bf16x8 kf[8];
  const lds_cptr shm3=(lds_cptr)shm; const lds_cptr kp0=shm3+LDS_K+hi*1024+r32*16; const lds_cptr vp0=shm3+LDS_V+((lane>>4)&1)*32+(lane&3)*8+(4*hi+((lane&15)>>2))*64;
  const int NT=(q0+QB)/KVBLK;
  const __attribute__((address_space(3))) float*lutp=(const __attribute__((address_space(3))) float*)((lds_cptr)shm+LDS_LUT);
  if(tid<128)((__attribute__((address_space(3))) float*)((__attribute__((address_space(3))) char*)shm+LDS_LUT))[tid]=rel_bias[rel_bucket_dev(tid)*NHEAD+h]*1.4426950408889634f;
  DMA_K(0,0);DMA_V(0,0);DMA_K(1,SLOTB);
  bf16x8 qr[4];
  #pragma unroll
  for(int d0=0;d0<4;++d0)qr[d0]=*reinterpret_cast<const bf16x8*>(&Qw[(long)r32*DM+d0*16+hi*8]);
  unsigned selmask=0u;
  if(qb>0){ f32x16 sc=f32x16{};
    #pragma unroll
    for(int d0=0;d0<4;++d0){ f32x4 k0={0.f,0.f,0.f,0.f},k1={0.f,0.f,0.f,0.f};
      if(r32<16){const float*kp=KMp+((size_t)(b*16+r32))*512+h*64+d0*16+hi*8;k0=*(const f32x4*)kp;k1=*(const f32x4*)(kp+4);}
      u32x4 hi4,lo4; hi4.x=cvtpk_s(k0[0],k0[1]);hi4.y=cvtpk_s(k0[2],k0[3]);hi4.z=cvtpk_s(k1[0],k1[1]);hi4.w=cvtpk_s(k1[2],k1[3]);
      #define BLO(w) __uint_as_float((w)<<16)
      #define BHI(w) __uint_as_float((w)&0xffff0000u)
      lo4.x=cvtpk_s(k0[0]-BLO(hi4.x),k0[1]-BHI(hi4.x));lo4.y=cvtpk_s(k0[2]-BLO(hi4.y),k0[3]-BHI(hi4.y));lo4.z=cvtpk_s(k1[0]-BLO(hi4.z),k1[1]-BHI(hi4.z));lo4.w=cvtpk_s(k1[2]-BLO(hi4.w),k1[3]-BHI(hi4.w));
      #undef BLO
      #undef BHI
      sc=__builtin_amdgcn_mfma_f32_32x32x16_bf16(__builtin_bit_cast(bf16x8,hi4),qr[d0],sc,0,0,0);
      sc=__builtin_amdgcn_mfma_f32_32x32x16_bf16(__builtin_bit_cast(bf16x8,lo4),qr[d0],sc,0,0,0); }
    float full[16];
    #pragma unroll
    for(int g=0;g<8;++g){const float mine=sc[g],other=shfl_xor_(mine,32,lane);full[crow(g,0)]=hi?other:mine;full[crow(g,1)]=hi?mine:other;}
    #pragma unroll
    for(int p=0;p<3;++p){float best=-INFINITY;int bi=-1;
      #pragma unroll
      for(int j=0;j<16;++j){const bool ok=(j<qb)&&!((selmask>>j)&1u)&&(full[j]>best);best=ok?full[j]:best;bi=ok?j:bi;}
      if(bi>=0)selmask|=1u<<bi;} }
  const float bconst=rel_bias[31*NHEAD+h]*1.4426950408889634f;
  #define TSEL(t) (((t)<4)?true:(((selmask>>(((t)-4)>>2))&1u)!=0u))
  #define TCLS(t) (((t)<4) ? ((64*(t)>32*wid+31) ? 2 : ((32*wid-64*(t)-63>=113) ? 1 : 0)) : (((t)>=NT-4) ? ((256+32*wid-64*((t)-(NT-4))-63>=113) ? 1 : 0) : 1))
  #define TLUT(t) (TCLS(t)==0)
  #define SETNEG(t) do{ const int cl_=TCLS(t); const float nm_=(cl_==0)?-mhat:((cl_==2)?-INFINITY:((TSEL(t)?bconst:-INFINITY)-mhat)); _Pragma("unroll") for(int r=0;r<16;++r)negm[r]=nm_; asm volatile("":"+v"(negm)); }while(0)
  float mhat=0.f,l_reg=0.f;f32x16 o[2];o[0]=f32x16{};o[1]=f32x16{};f32x16 negm=f32x16{};asm volatile("":"+v"(negm));
  const int qrel=wid*QBLK+r32;
  #define CMASK(P0,P1,t) do{ if(TLUT(t)) lutmask(P0,P1,TPOS(t),q0+qrel,TSEL(t),hi,lutp); }while(0)
  bool resc=false;
  #define START(P0,P1) do{ const float rm=rowmax(P0,P1); resc=false; \
    { const float dl=rm; mhat=fadd_s(mhat,dl); \
      _Pragma("unroll") for(int r=0;r<16;++r){P0[r]=fsub_s(P0[r],dl);P1[r]=fsub_s(P1[r],dl);} \
      _Pragma("unroll") for(int r=0;r<16;++r)negm[r]=-mhat; asm volatile("":"+v"(negm)); } \
    _Pragma("unroll") for(int r=0;r<16;++r)P0[r]=__builtin_amdgcn_exp2f(P0[r]); }while(0)
  #define RESC() do{ if(resc){ asm volatile("s_waitcnt lgkmcnt(0)":::"memory"); \
      _Pragma("unroll") for(int d_=0;d_<2;++d_) _Pragma("unroll") for(int r=0;r<16;++r)o[d_][r]*=wsf[crow(r,hi)]; } }while(0)
  f32x16 pA0,pA1,pB0,pB1;
  int sl_prev=0,sl_cur=0,sl_next=SLOTB;
  #define ROT() do{sl_prev=sl_cur;sl_cur=sl_next;sl_next=(sl_next==(NSLOT-1)*SLOTB)?0:sl_next+SLOTB;}while(0)
  DMA_K(2,2*SLOTB);
  WAIT_BAR(3);
  SETNEG(0); qkt(pA0,pA1,Kbase,qr,negm,r32,hi);asm volatile("s_nop 15\n\ts_nop 7":"+v"(pA0),"+v"(pA1));CMASK(pA0,pA1,0);
  START(pA0,pA1);
  _Pragma("unroll") for(int r=0;r<16;++r)pA1[r]=__builtin_amdgcn_exp2f(pA1[r]);
  WAIT_BAR(0);
  DMA_K(3,0);DMA_V(1,SLOTB);
  ROT();
  kload8(kf,kp0+sl_cur);
  WAIT_BAR(2);
  s16x4 vlo[8],vhi[8]; u32x4 pw0,pw1,pw2,pw3;
  #define PKW(P,B) cvtpk_s(P[B],P[B+1])
  #define PAF(k) __builtin_bit_cast(bf16x8,pw##k)
  #define VFR(i) (bf16x8){vlo[i][0],vlo[i][1],vlo[i][2],vlo[i][3],vhi[i][0],vhi[i][1],vhi[i][2],vhi[i][3]}
  #define PIN(x) asm volatile("":"+v"(x))
  #define MX3(a,b,c) __builtin_fmaxf(__builtin_fmaxf((a),(b)),(c))
  #define GAPA(MF,A0,A1,A2,A3,W0,W1,PW) do{ MF; sacc+=A0; sacc+=A1; sacc+=A2; sacc+=A3; PIN(sacc); W0; W1; PIN(PW); SBAR(); }while(0)
  #define EX(v) __builtin_amdgcn_exp2f(v)
  #define GAPB(MF,X,B) do{ MF; X[B]=EX(X[B]); X[B+1]=EX(X[B+1]); X[B+2]=EX(X[B+2]); X[B+3]=EX(X[B+3]); PIN(X); SBAR(); }while(0)
  #define VRD(i) do{ vlo[i]=vtr(vp_+(((i)>>2)*4096+((i)&3)*1024)); vhi[i]=vtr(vp_+(((i)>>2)*4096+((i)&3)*1024+512)); }while(0)
  #define KRD(G,j) do{ if(G){ kload2(kf,kp0+sl_next,j); SBAR(); } }while(0)
  #define STEP(C0,C1,P0,P1,t,GK,GV,GL) do{ SETNEG(t); SBAR(); \
    const lds_cptr vp_=vp0+sl_prev; \
    VRD(0); SBAR(); float sacc=(P0[0]+P0[1]); \
    GAPA(C0=__builtin_amdgcn_mfma_f32_32x32x16_bf16(kf[0],qr[0],negm,0,0,0), P0[2],P0[3],P0[4],P0[5],     pw0[0]=PKW(P0,0), pw0[1]=PKW(P0,2), pw0); \
    VRD(4); SBAR(); GAPA(C1=__builtin_amdgcn_mfma_f32_32x32x16_bf16(kf[1],qr[0],negm,0,0,0), P0[6],P0[7],P0[8],P0[9],     pw0[2]=PKW(P0,4), pw0[3]=PKW(P0,6), pw0); \
    VRD(1); SBAR(); GAPA(C0=__builtin_amdgcn_mfma_f32_32x32x16_bf16(kf[2],qr[1],C0,0,0,0),   P0[10],P0[11],P0[12],P0[13], pw1[0]=PKW(P0,8), pw1[1]=PKW(P0,10), pw1); \
    VRD(5); SBAR(); GAPA(C1=__builtin_amdgcn_mfma_f32_32x32x16_bf16(kf[3],qr[1],C1,0,0,0),   P0[14],P0[15],P1[0],P1[1],   pw1[2]=PKW(P0,12),pw1[3]=PKW(P0,14), pw1); \
    VRD(2); SBAR(); GAPA(C0=__builtin_amdgcn_mfma_f32_32x32x16_bf16(kf[4],qr[2],C0,0,0,0),   P1[2],P1[3],P1[4],P1[5],     pw2[0]=PKW(P1,0), pw2[1]=PKW(P1,2), pw2); \
    VRD(6); SBAR(); GAPA(C1=__builtin_amdgcn_mfma_f32_32x32x16_bf16(kf[5],qr[2],C1,0,0,0),   P1[6],P1[7],P1[8],P1[9],     pw2[2]=PKW(P1,4), pw2[3]=PKW(P1,6), pw2); \
    VRD(3); SBAR(); GAPA(C0=__builtin_amdgcn_mfma_f32_32x32x16_bf16(kf[6],qr[3],C0,0,0,0),   P1[10],P1[11],P1[12],P1[13], pw3[0]=PKW(P1,8), pw3[1]=PKW(P1,10), pw3); \
    VRD(7); SBAR(); GAPA(C1=__builtin_amdgcn_mfma_f32_32x32x16_bf16(kf[7],qr[3],C1,0,0,0),   P1[14],P1[15],0.f,0.f,       pw3[2]=PKW(P1,12),pw3[3]=PKW(P1,14), pw3); \
    l_reg+=sacc; \
    if(GK){DMA_K((t)+3,sl_cur);} if(GV){DMA_V((t)+1,sl_next);} \
    CMASK(C0,C1,t); \
    { float a=MX3(C0[0],C0[1],C1[0]),b=MX3(C0[2],C0[3],C1[1]); a=MX3(a,C1[2],C1[3]); \
      _Pragma("unroll") for(int r=4;r<16;r+=4){a=MX3(a,C0[r],C0[r+1]);b=MX3(b,C0[r+2],C0[r+3]);a=MX3(a,C1[r],C1[r+1]);b=MX3(b,C1[r+2],C1[r+3]);} \
      float rm=__builtin_fmaxf(a,b); { auto rr=__builtin_amdgcn_permlane32_swap(__float_as_uint(rm),__float_as_uint(rm),false,false); rm=__builtin_fmaxf(__uint_as_float(rr[0]),__uint_as_float(rr[1])); } \
      resc=false; \
      if(__builtin_expect(__any(rm>(float)THRL),0)){ const float dl=__builtin_fmaxf(rm,0.f); mhat+=dl; \
        _Pragma("unroll") for(int r=0;r<16;++r){C0[r]-=dl;C1[r]-=dl;} \
        _Pragma("unroll") for(int r=0;r<16;++r)negm[r]=-mhat; asm volatile("":"+v"(negm)); \
        const float f=__builtin_amdgcn_exp2f(-dl); l_reg*=f; if(hi==0)wsf[r32]=f; resc=true; } } \
    SBAR(); \
    GAPB(o[0]=__builtin_amdgcn_mfma_f32_32x32x16_bf16(PAF(0),VFR(0),o[0],0,0,0), C0,0); \
    GAPB(o[1]=__builtin_amdgcn_mfma_f32_32x32x16_bf16(PAF(0),VFR(4),o[1],0,0,0), C0,4); \
    KRD(GL,0); GAPB(o[0]=__builtin_amdgcn_mfma_f32_32x32x16_bf16(PAF(1),VFR(1),o[0],0,0,0), C0,8); \
    KRD(GL,1); GAPB(o[1]=__builtin_amdgcn_mfma_f32_32x32x16_bf16(PAF(1),VFR(5),o[1],0,0,0), C0,12); \
    KRD(GL,2); GAPB(o[0]=__builtin_amdgcn_mfma_f32_32x32x16_bf16(PAF(2),VFR(2),o[0],0,0,0), C1,0); \
    KRD(GL,3); GAPB(o[1]=__builtin_amdgcn_mfma_f32_32x32x16_bf16(PAF(2),VFR(6),o[1],0,0,0), C1,4); \
    GAPB(o[0]=__builtin_amdgcn_mfma_f32_32x32x16_bf16(PAF(3),VFR(3),o[0],0,0,0), C1,8); \
    GAPB(o[1]=__builtin_amdgcn_mfma_f32_32x32x16_bf16(PAF(3),VFR(7),o[1],0,0,0), C1,12); \
    }while(0)
  int t=1;
  for(;t+5<NT;t+=2){
    STEP(pB0,pB1,pA0,pA1,t,true,true,true);     WAIT_BAR(2); RESC(); ROT();
    STEP(pA0,pA1,pB0,pB1,t+1,true,true,true);   WAIT_BAR(2); RESC(); ROT();
  }
  #define ENDW(tt) do{ if((tt)+3<NT){WAIT_BAR(2);} else if((tt)+2<NT){WAIT_BAR(1);} else {WAIT_BAR(0);} }while(0)
  for(;t+1<NT;t+=2){
    STEP(pB0,pB1,pA0,pA1,t,(t+3<NT),(t+1<NT),(t+1<NT));       ENDW(t);   RESC(); ROT();
    STEP(pA0,pA1,pB0,pB1,t+1,(t+4<NT),(t+2<NT),(t+2<NT));     ENDW(t+1); RESC(); ROT();
  }
  STEP(pB0,pB1,pA0,pA1,NT-1,false,false,false); RESC();
  { float sacc=pB0[0]+pB0[1]; _Pragma("unroll") for(int r=2;r<16;++r)sacc+=pB0[r]; _Pragma("unroll") for(int r=0;r<16;++r)sacc+=pB1[r]; l_reg+=sacc;
    pw0=(u32x4){PKW(pB0,0),PKW(pB0,2),PKW(pB0,4),PKW(pB0,6)};pw1=(u32x4){PKW(pB0,8),PKW(pB0,10),PKW(pB0,12),PKW(pB0,14)};pw2=(u32x4){PKW(pB1,0),PKW(pB1,2),PKW(pB1,4),PKW(pB1,6)};pw3=(u32x4){PKW(pB1,8),PKW(pB1,10),PKW(pB1,12),PKW(pB1,14)};
    SBAR(); pv(o,vb0+sl_cur,PAF(0),PAF(1),PAF(2),PAF(3)); }
  #undef PKW
  #undef PAF
  #undef VFR
  #undef PIN
  #undef MX3
  #undef GAPA
  #undef GAPB
  #undef EX
  #undef VRD
  #undef KRD
  #undef STEP
  #undef ENDW
  {auto rr=__builtin_amdgcn_permlane32_swap(__float_as_uint(l_reg),__float_as_uint(l_reg),false,false);l_reg=__uint_as_float(rr[0])+__uint_as_float(rr[1]);}
  if(hi==0)wsf[32+r32]=l_reg;asm volatile("s_waitcnt lgkmcnt(0)":::"memory");
  float rli[16];
  #pragma unroll
  for(int r=0;r<16;++r)rli[r]=__builtin_amdgcn_rcpf(wsf[32+crow(r,hi)]);
  bf16*Ow=O+(rowbase+q0+wid*QBLK)*DM+h*D;
  { bf16*stg=(bf16*)(shm+LDS_OST)+wid*2048;
    #pragma unroll
    for(int r=0;r<16;++r){const int orow=crow(r,hi);
      #pragma unroll
      for(int d0=0;d0<2;++d0)stg[orow*64+d0*32+r32]=__float2bfloat16(o[d0][r]*rli[r]);}
    asm volatile("s_waitcnt lgkmcnt(0)":::"memory");
    #pragma unroll
    for(int i=0;i<4;++i){const int row=i*8+(lane>>3),ch=lane&7; const u32x4 v=*(const u32x4*)(stg+row*64+ch*8); ATTN_STORE16(Ow+(long)row*DM+ch*8,v);} }
  asm volatile("s_waitcnt lgkmcnt(0)\n\ts_barrier":::"memory");
  #undef DMA_K
  #undef DMA_V
  #undef CMASK
  #undef TPOS
  #undef TSEL
  #undef TLUT
  #undef TCLS
  #undef SETNEG
  #undef START
  #undef RESC
  #undef ROT
}

#undef SBAR
#undef WAIT_BAR
}

__device__ __forceinline__ void attn_phase_ex(Frame& F) {
    const attn_ex::bf16* Q = (const attn_ex::bf16*)(F.ws + WS_Q); const attn_ex::bf16* Kb = (const attn_ex::bf16*)(F.ws + WS_K); const attn_ex::bf16* Vb = (const attn_ex::bf16*)(F.ws + WS_VT);
    const float* KM = (const float*)(F.ws + WS_KM); attn_ex::bf16* HA = (attn_ex::bf16*)(F.ws + WS_HA); const float* rel_bias = INP(2);
    static_assert(attn_ex::LDS_BYTES <= RING_BYTES, "attention LDS");
    for (int n = F.vcu; n < BATCH * NH * NBLK; n += F.G) {
        const int ii = n >> 8, w = n & 255, bh = w >> 2, s4 = w & 3; const int qb = (ii == 0) ? s4 : (ii == 1) ? 7 - s4 : (ii == 2) ? 8 + s4 : 15 - s4;
        attn_ex::attn_unit<8>(bh >> 3, bh & 7, qb, Q, Kb, Vb, HA, (char*)F.lds, KM, rel_bias, F.tid);
    }
    asm volatile("s_waitcnt vmcnt(0)" ::: "memory"); __syncthreads();
}
#if DBG_CHECK
__device__ __forceinline__ unsigned hash_u(unsigned x) { x ^= x >> 16; x *= 0x7feb352du; x ^= x >> 15; x *= 0x846ca68bu; x ^= x >> 16; return x; }
__device__ __forceinline__ float bfv(const bf16_t* p) { return __uint_as_float(((unsigned)*p) << 16); }
__device__ __forceinline__ float rbf(float x) { return bf_lo(cvtpk(x, 0.f) & 0xffffu); }
__device__ __forceinline__ void dbg_acc(Frame& F, float d2, float r2) { if (F.lane == 0) { atomicAdd((float*)(F.ctl + CW_DBG), d2); atomicAdd((float*)(F.ctl + CW_DBG + 64), r2); } }
__device__ __forceinline__ float dbg_qk(const bf16_t* qp, const bf16_t* kp) { float a = 0.f;
#pragma unroll 1
    for (int d = 0; d < 64; ++d) a += bfv(qp + d) * bfv(kp + d); return a; }
__device__ __forceinline__ void dbg_attn(Frame& F, const float* rel_bias) {
    const bf16_t* Q = (const bf16_t*)(F.ws + WS_Q); const bf16_t* Kb = (const bf16_t*)(F.ws + WS_K); const bf16_t* VT = (const bf16_t*)(F.ws + WS_VT);
    const float* KM = (const float*)(F.ws + WS_KM); const bf16_t* HA = (const bf16_t*)(F.ws + WS_HA);
    const int gw = F.vcu * NWAVES + F.wave, lane = F.lane;
#pragma unroll 1
    for (int sidx = gw; sidx < 4096; sidx += F.G * NWAVES) {
        const unsigned hsh = hash_u(sidx * 2654435761u + 12345u);
        const int b = hsh & 7, h = (hsh >> 3) & 7; int q = (hsh >> 6) & 4095;
        if ((sidx & 7) == 0) q = (q & ~255) | ((hsh >> 20) & 3);
        if ((sidx & 7) == 1) q = (q & ~255) | (252 + ((hsh >> 20) & 3));
        if ((sidx & 15) == 2) q = q & 255;
        const int own = q >> 8; const bf16_t* qp = Q + ((size_t)(b * SEQ + q)) * 512 + h * 64;
        float myscore = -INFINITY;
        if (lane < own) { float a = 0.f;
#pragma unroll 1
            for (int d = 0; d < 64; ++d) a += bfv(qp + d) * KM[((size_t)(b * NBLK + lane)) * 512 + h * 64 + d]; myscore = a; }
        unsigned sel = 0u;
#pragma unroll 1
        for (int p = 0; p < 3; ++p) { float best = -INFINITY; int bi = -1;
#pragma unroll 1
            for (int j = 0; j < 16; ++j) { const float sj = __shfl(myscore, j); if (j < own && !((sel >> j) & 1u) && sj > best) { best = sj; bi = j; } }
            if (bi >= 0) sel |= 1u << bi; }
        float mx = -INFINITY;
#pragma unroll 1
        for (int kp = lane; kp <= q; kp += 64) { const int kb = kp >> 8; if (!(kb == own || ((sel >> kb) & 1u))) continue;
            const float a = dbg_qk(qp, Kb + ((size_t)(b * SEQ + kp)) * 512 + h * 64) + rel_bias[rel_bucket_dev(q - kp) * NH + h] * LOG2E; mx = fmaxf(mx, a); }
#pragma unroll
        for (int o = 1; o < 64; o <<= 1) mx = fmaxf(mx, __shfl_xor(mx, o));
        float ls = 0.f;
#pragma unroll 1
        for (int kp = lane; kp <= q; kp += 64) { const int kb = kp >> 8; if (!(kb == own || ((sel >> kb) & 1u))) continue;
            const float a = dbg_qk(qp, Kb + ((size_t)(b * SEQ + kp)) * 512 + h * 64) + rel_bias[rel_bucket_dev(q - kp) * NH + h] * LOG2E; ls += exp2f(a - mx); }
        ls = wave_sum(ls); float d2 = 0.f, r2 = 0.f;
#pragma unroll 1
        for (int d = 0; d < 64; ++d) { float ov = 0.f;
#pragma unroll 1
            for (int kp = lane; kp <= q; kp += 64) { const int kb = kp >> 8; if (!(kb == own || ((sel >> kb) & 1u))) continue;
                const float a = dbg_qk(qp, Kb + ((size_t)(b * SEQ + kp)) * 512 + h * 64) + rel_bias[rel_bucket_dev(q - kp) * NH + h] * LOG2E;
                ov += exp2f(a - mx) * bfv(VT + ((size_t)(b * SEQ + kp)) * 512 + h * 64 + d); }
            const float o = wave_sum(ov) / ls; const float got = bfv(HA + ((size_t)(b * SEQ + q)) * 512 + h * 64 + d); d2 += (got - o) * (got - o); r2 += o * o; }
        dbg_acc(F, d2, r2);
    }
}
__device__ __forceinline__ float dbg_dot_x_w(Frame& F, const float* xrow, const float* W, int ldw, int col, int K) {
    float a = 0.f;
#pragma unroll 1
    for (int k = F.lane; k < K; k += 64) a += rbf(xrow[k]) * rbf(W[(size_t)k * ldw + col]); return wave_sum(a); }
__device__ __forceinline__ void dbg_inproj(Frame& F, const float* x, const float* w) {
    const int gw = F.vcu * NWAVES + F.wave;
#pragma unroll 1
    for (int sidx = gw; sidx < 8192; sidx += F.G * NWAVES) {
        const unsigned hsh = hash_u(sidx * 2654435761u + 777u); const int row = hsh & (M - 1); const int sec = sidx % 5; const unsigned r2_ = hash_u(hsh);
        const float* xr = x + (size_t)row * D; float ref, got;
        if (sec == 0) { const int c = r2_ & 511; const float a = dbg_dot_x_w(F, xr, w, NIN, c, D), g = dbg_dot_x_w(F, xr, w, NIN, 512 + c, D); ref = a / (1.f + __expf(-g)); got = bfv((const bf16_t*)(F.ws + WS_H0) + (size_t)row * 512 + c); }
        else if (sec == 1) { const int c = r2_ & 511; ref = dbg_dot_x_w(F, xr, w, NIN, 1024 + c, D) * QSCALE; got = bfv((const bf16_t*)(F.ws + WS_Q) + (size_t)row * 512 + c); }
        else if (sec == 2) { const int c = r2_ & 511; ref = dbg_dot_x_w(F, xr, w, NIN, 1536 + c, D); got = bfv((const bf16_t*)(F.ws + WS_K) + (size_t)row * 512 + c); }
        else if (sec == 3) { const int c = r2_ & 511; ref = dbg_dot_x_w(F, xr, w, NIN, 2048 + c, D); got = bfv((const bf16_t*)(F.ws + WS_VT) + (size_t)row * 512 + c); }
        else { const int c = r2_ & 2047; const float g = dbg_dot_x_w(F, xr, w, NIN, 2560 + c, D); ref = 1.f / (1.f + __expf(-g)); got = (float)((const unsigned char*)(F.ws + WS_SG))[(size_t)row * 2048 + c] * (1.f / 255.f); }
        dbg_acc(F, (got - ref) * (got - ref), ref * ref);
    }
}
__device__ __forceinline__ void dbg_conv(Frame& F) {
    const bf16_t* H0 = (const bf16_t*)(F.ws + WS_H0); const bf16_t* HC = (const bf16_t*)(F.ws + WS_HC); const int gw = F.vcu * NWAVES + F.wave, lane = F.lane;
    const float* cw = INP(4); const float* cb = INP(5); const float* lg = INP(6); const float* lb = INP(7);
#pragma unroll 1
    for (int sidx = gw; sidx < 4096; sidx += F.G * NWAVES) {
        const unsigned hsh = hash_u(sidx * 2654435761u + 4242u); const int b = hsh & 7; int t = (hsh >> 3) & 4095; if ((sidx & 3) == 0) t &= 31;
        float v[8]; float s = 0.f;
#pragma unroll
        for (int c = 0; c < 8; ++c) { const int ch = lane * 8 + c; float a = cb[ch];
#pragma unroll 1
            for (int j = 0; j < CKW; ++j) { const int ti = t - 30 + j; if (ti >= 0) a += cw[j * CW + ch] * bfv(H0 + ((size_t)(b * SEQ + ti)) * 512 + ch); } v[c] = a; s += a; }
        const float mean = wave_sum(s) / CW; float qq = 0.f;
#pragma unroll
        for (int c = 0; c < 8; ++c) qq += (v[c] - mean) * (v[c] - mean);
        const float rstd = 1.f / sqrtf(wave_sum(qq) / CW + LN_EPS); float d2 = 0.f, r2 = 0.f;
#pragma unroll
        for (int c = 0; c < 8; ++c) { const int ch = lane * 8 + c; const float y = (v[c] - mean) * rstd * lg[ch] + lb[ch]; const float ref = y / (1.f + __expf(-y));
            const float got = bfv(HC + ((size_t)(b * SEQ + t)) * 512 + ch); d2 += (got - ref) * (got - ref); r2 += ref * ref; }
        dbg_acc(F, wave_sum(d2), wave_sum(r2));
    }
    const bf16_t* Kb = (const bf16_t*)(F.ws + WS_K); const float* KM = (const float*)(F.ws + WS_KM);
    for (int sidx = gw; sidx < 2048; sidx += F.G * NWAVES) { const unsigned hsh = hash_u(sidx * 2654435761u + 99u); const int u = hsh & 127, col = (hsh >> 7) & 511;
        float a = 0.f; for (int r = lane; r < 256; r += 64) a += bfv(Kb + ((size_t)u * 256 + r) * 512 + col); a = wave_sum(a) / 256.f; const float got = KM[(size_t)u * 512 + col];
        dbg_acc(F, (got - a) * (got - a) * 100.f, a * a * 100.f); }
}
__device__ __forceinline__ void dbg_mix(Frame& F) {
    const bf16_t* HC = (const bf16_t*)(F.ws + WS_HC); const bf16_t* HA = (const bf16_t*)(F.ws + WS_HA); const unsigned char* SG = (const unsigned char*)(F.ws + WS_SG); const bf16_t* MIX = (const bf16_t*)(F.ws + WS_MIX);
    const float* wc = INP(8); const float* wa = INP(9); const int gw = F.vcu * NWAVES + F.wave, lane = F.lane;
    for (int sidx = gw; sidx < 8192; sidx += F.G * NWAVES) { const unsigned hsh = hash_u(sidx * 2654435761u + 31337u); const int row = hsh & (M - 1), col = (hsh >> 15) & 1023;
        float a = 0.f, c = 0.f; for (int k = lane; k < 512; k += 64) { c += bfv(HC + (size_t)row * 512 + k) * rbf(wc[(size_t)k * D + col]); a += bfv(HA + (size_t)row * 512 + k) * rbf(wa[(size_t)k * D + col]); }
        c = wave_sum(c); a = wave_sum(a); const float ref = (float)SG[(size_t)row * 2048 + col] * (1.f / 255.f) * c + (float)SG[(size_t)row * 2048 + 1024 + col] * (1.f / 255.f) * a; const float got = bfv(MIX + (size_t)row * D + col);
        dbg_acc(F, (got - ref) * (got - ref), ref * ref); }
}
__device__ __forceinline__ void dbg_out(Frame& F) {
    const bf16_t* MIX = (const bf16_t*)(F.ws + WS_MIX); const _Float16* YB = (const _Float16*)(F.ws + WS_YB); const float* x = INP(0); const float* wo = INP(10); const int gw = F.vcu * NWAVES + F.wave, lane = F.lane;
    for (int sidx = gw; sidx < 8192; sidx += F.G * NWAVES) { const unsigned hsh = hash_u(sidx * 2654435761u + 555u); const int row = hsh & (M - 1), col = (hsh >> 15) & 1023;
        float a = 0.f; for (int k = lane; k < D; k += 64) a += bfv(MIX + (size_t)row * D + k) * rbf(wo[(size_t)k * D + col]); a = wave_sum(a);
        const float got = (float)YB[(size_t)row * D + col] - ALPHA * x[(size_t)row * D + col]; dbg_acc(F, (got - a) * (got - a), a * a); }
}
#if DBG_CHECK == 1 || DBG_CHECK == 2
__device__ __noinline__ void dbg_entry(unsigned char* ws, float* out, LAS unsigned char* lds, int wv_, const float* p0, const float* p1) { const int wv = __builtin_amdgcn_readfirstlane(wv_); Frame F = make_frame(ws, out, lds, wv);
#if DBG_CHECK == 1
    dbg_attn(F, p0);
#else
    dbg_inproj(F, p0, p1);
#endif
}
#endif
__device__ __forceinline__ void dbg_finish(Frame& F) {
    const float d2 = __hip_atomic_load((float*)(F.ctl + CW_DBG), RLX_AGENT), r2 = __hip_atomic_load((float*)(F.ctl + CW_DBG + 64), RLX_AGENT);
    float v = -10.f * log10f(d2 / r2); v = (d2 == 0.f) ? 98.f : v; v = fminf(fmaxf(v, 0.f), 98.f); if (!(r2 > 0.f)) v = 0.f;
    const float c = sqrtf(v);
    for (size_t i = (size_t)F.vcu * NTHR + F.tid; i < (size_t)M * D; i += (size_t)F.G * NTHR) F.out[i] = c;
}
#endif
constexpr int NPH = 12, N_PHASES = 1 + DEPTH * NPH;
struct Args { const float* in[24]; float* out; unsigned char* ws; int ph; int pad; };
#ifndef PH_NOINLINE
#define PH_NOINLINE 0
#endif
#if PH_NOINLINE
#define PHASE_FN __device__ __noinline__
#else
#define PHASE_FN __device__ __forceinline__
#endif
__device__ __forceinline__ Frame make_frame_impl(unsigned char* ws, float* out, LAS unsigned char* lds, int wv) {
    Frame F; F.lds = lds; F.MISC = (volatile LAS unsigned*)(lds + MISC_OFF);
    F.tid = phase_tid(wv); F.lane = F.tid & 63; F.wave = __builtin_amdgcn_readfirstlane(F.tid >> 6);
    { int g_ = gridDim.x, b_ = blockIdx.x; asm volatile("" : "+s"(g_), "+s"(b_)); F.G = g_; F.bx = b_; }
    F.vcu = (F.G % 8 == 0) ? (F.bx % 8) * (F.G / 8) + F.bx / 8 : F.bx;
    F.ws = ws; F.ctl = (unsigned*)(ws + WS_CTL); F.out = out; return F;
}
__device__ __forceinline__ Frame make_frame(unsigned char* ws, float* out, LAS unsigned char* lds, int wv) { return make_frame_impl(ws, out, lds, wv); }
constexpr size_t T1024 = (size_t)256 * 1024 * 2, T512 = (size_t)256 * 512 * 2, T256 = (size_t)256 * 256 * 2, T3584 = (size_t)256 * 3584 * 2;
PHASE_FN void ph_prologue(unsigned char* ws, float* out, LAS unsigned char* lds, int wv) { Frame F = make_frame(ws, out, lds, wv); prologue_phase(F); }
PHASE_FN void ph_inproj(unsigned char* ws, float* out, LAS unsigned char* lds, int wv, int l) { Frame F = make_frame(ws, out, lds, wv);
    SchedInProj S{(const char*)(ws + WS_XB), (const char*)(ws + WS_WIN + l * SZ_WIN), F.G, F.bx, T1024};
    EpiInProj E{(bf16_t*)(ws + WS_H0), (bf16_t*)(ws + WS_Q), (bf16_t*)(ws + WS_K), (bf16_t*)(ws + WS_VT), (unsigned char*)(ws + WS_SG)};
    pg8::gemm_phase<EpiInProj, SchedInProj, false>(lds, wv, D, S, E, nullptr); }
PHASE_FN void ph_thin(unsigned char* ws, float* out, LAS unsigned char* lds, int wv, int l) { Frame F = make_frame(ws, out, lds, wv); thin_phase(F, l); }
PHASE_FN void ph_attn(unsigned char* ws, float* out, LAS unsigned char* lds, int wv) { Frame F = make_frame(ws, out, lds, wv); if (ATTN_EX) attn_phase_ex(F); else attn_phase(F); }
PHASE_FN void ph_mixc(unsigned char* ws, float* out, LAS unsigned char* lds, int wv, int l) { Frame F = make_frame(ws, out, lds, wv);
    SchedGrid S{(const char*)(ws + WS_HC), (const char*)(ws + WS_WC + l * SZ_WC), M / 256, D / 256, F.G, F.bx, T512};
    EpiBf16Row<0> E{(bf16_t*)(ws + WS_MIX), D, (const unsigned char*)(ws + WS_SG), 2048, nullptr};
    pg8::gemm_phase<EpiBf16Row<0>, SchedGrid, false>(lds, wv, CW, S, E, nullptr); }
PHASE_FN void ph_mixa(unsigned char* ws, float* out, LAS unsigned char* lds, int wv, int l) { Frame F = make_frame(ws, out, lds, wv);
    SchedGrid S{(const char*)(ws + WS_HA), (const char*)(ws + WS_WA + l * SZ_WA), M / 256, D / 256, F.G, F.bx, T512};
    EpiBf16Row<1> E{(bf16_t*)(ws + WS_MIX), D, (const unsigned char*)(ws + WS_SG) + 1024, 2048, nullptr};
    pg8::gemm_phase<EpiBf16Row<1>, SchedGrid, false>(lds, wv, AW, S, E, nullptr); }
PHASE_FN void ph_outproj(unsigned char* ws, float* out, LAS unsigned char* lds, int wv, int l) { Frame F = make_frame(ws, out, lds, wv);
    SchedGrid S{(const char*)(ws + WS_MIX), (const char*)(ws + WS_WOUT + l * SZ_WOUT), M / 256, D / 256, F.G, F.bx, T1024};
    EpiResF32<0> E{(l == 0) ? INP(0) : nullptr, (unsigned short*)(ws + WS_YB), nullptr, (const float*)(ws + WS_ST), INP(15) + (l > 0 ? l - 1 : 0) * D, INP(16) + (l > 0 ? l - 1 : 0) * D};
    pg8::gemm_phase<EpiResF32<0>, SchedGrid, false>(lds, wv, D, S, E, nullptr); }
PHASE_FN void ph_ln1(unsigned char* ws, float* out, LAS unsigned char* lds, int wv, int l, bool dummy) { Frame F = make_frame(ws, out, lds, wv); ln_phase<1>(F, l, dummy); }
PHASE_FN void ph_ln2(unsigned char* ws, float* out, LAS unsigned char* lds, int wv, int l, bool dummy) { Frame F = make_frame(ws, out, lds, wv); ln_phase<2>(F, l, dummy); }
__device__ __forceinline__ bool ple_filler(const Frame& F, int rtail, int& Gf, int& cf) { Gf = F.G; cf = F.bx; if (rtail <= 0 || rtail >= F.G) return true; Gf = F.G - rtail; cf = F.bx - rtail; return cf >= 0; }
PHASE_FN void ph_routebuild(unsigned char* ws, float* out, LAS unsigned char* lds, int wv, int l) { Frame F = make_frame(ws, out, lds, wv); route_build(F, l >> 1); }
PHASE_FN void ph_plegate(unsigned char* ws, float* out, LAS unsigned char* lds, int wv, int l, int rtail) { Frame F = make_frame(ws, out, lds, wv);
    int Gf, cf; if (!ple_filler(F, rtail, Gf, cf)) return;
    SchedGrid S{(const char*)(ws + WS_XB), (const char*)(ws + WS_WPG + l * SZ_WPG), M / 256, D / 256, Gf, cf, T1024};
    EpiBf16Row<2> E{nullptr, D, nullptr, 0, (unsigned char*)(ws + WS_PG)};
    pg8::gemm_phase<EpiBf16Row<2>, SchedGrid, false>(lds, wv, D, S, E, nullptr); }
PHASE_FN void ph_pleproj(unsigned char* ws, float* out, LAS unsigned char* lds, int wv, int l, int rtail) { Frame F = make_frame(ws, out, lds, wv);
    int Gf, cf; if (!ple_filler(F, rtail, Gf, cf)) return;
    SchedGrid S{(const char*)(ws + WS_PB), (const char*)(ws + WS_WPP + l * SZ_WPP), M / 256, D / 256, Gf, cf, T256};
    EpiBf16Row<0> E{(bf16_t*)(ws + WS_PLE), D, (const unsigned char*)(ws + WS_PG), 1024, nullptr};
    pg8::gemm_phase<EpiBf16Row<0>, SchedGrid, false>(lds, wv, PLED, S, E, nullptr); }
PHASE_FN void ph_ffn_up_dense(unsigned char* ws, float* out, LAS unsigned char* lds, int wv, int mi) { Frame F = make_frame(ws, out, lds, wv);
    EpiSwiGLU E{(bf16_t*)(ws + WS_H)};
    SchedGrid S{(const char*)(ws + WS_XB), (const char*)(ws + WS_WGU + mi * SZ_WGU), M / 256, 2 * FF / 256, F.G, F.bx, T1024};
    pg8::gemm_phase<EpiSwiGLU, SchedGrid, false>(lds, wv, D, S, E, nullptr); }
PHASE_FN void ph_ffn_up_moe(unsigned char* ws, float* out, LAS unsigned char* lds, int wv, int mi) { Frame F = make_frame(ws, out, lds, wv);
    EpiSwiGLU E{(bf16_t*)(ws + WS_H)};
    SchedMoe S; S.A = (const char*)(ws + WS_XB); S.B = (const char*)(ws + WS_EWGU); S.nN = 2 * FF / 256; S.G = F.G; S.c = F.bx; S.tstepA = T1024; S.tstepB = T1024; S.gather = true;
    moe_starts(F, mi, S.pstart); S.npan = S.pstart[NE];
    pg8::gemm_phase<EpiSwiGLU, SchedMoe, true>(lds, wv, D, S, E, (const int*)(ws + WS_RTOK)); }
PHASE_FN void ph_ffn_down_dense(unsigned char* ws, float* out, LAS unsigned char* lds, int wv, int mi, bool dummy) { Frame F = make_frame(ws, out, lds, wv);
    SchedGrid S{(const char*)(ws + WS_H), (const char*)(ws + WS_WD + mi * SZ_WD), M / 256, D / 256, F.G, F.bx, T3584};
    (void)dummy; EpiResF32<1> E{nullptr, (unsigned short*)(ws + WS_YB), (const bf16_t*)(ws + WS_PLE), (const float*)(ws + WS_ST), INP(11) + (2 * mi) * D, INP(12) + (2 * mi) * D};
    pg8::gemm_phase<EpiResF32<1>, SchedGrid, false>(lds, wv, FF, S, E, nullptr); }
PHASE_FN int ph_ffn_down_moe(unsigned char* ws, float* out, LAS unsigned char* lds, int wv, int mi) { Frame F = make_frame(ws, out, lds, wv);
    SchedMoe S; S.A = (const char*)(ws + WS_H); S.B = (const char*)(ws + WS_EWD); S.nN = D / 256; S.G = F.G; S.c = F.bx; S.tstepA = T3584; S.tstepB = T3584; S.gather = false;
    moe_starts(F, mi, S.pstart); S.npan = S.pstart[NE];
    EpiMoeDown E{(bf16_t*)out, (const int*)(ws + WS_RDST), (const float*)(ws + WS_RGATE)};
    pg8::gemm_phase<EpiMoeDown, SchedMoe, false>(lds, wv, FF, S, E, nullptr);
    const int nwg = S.npan * S.nN; return nwg % F.G; }

__global__ void __launch_bounds__(NTHR, 2) fwd_kernel(Args args) {
    extern __shared__ __attribute__((aligned(16))) unsigned char lds_raw[];
    LAS unsigned char* lds = (LAS unsigned char*)lds_raw;
    unsigned char* ws = args.ws; float* out = args.out;
    const int wv = __builtin_amdgcn_readfirstlane((int)threadIdx.x >> 6);
    for (int u = phase_tid(wv); u < (LDS_BYTES - LDSCTL_OFF) / 4; u += NTHR) ((LAS unsigned*)(lds + LDSCTL_OFF))[u] = 0u;
    __syncthreads();
#if MK_SINGLE
    XcdBarrier bar = xcd_barrier_post((unsigned*)(ws + WS_CTL) + CW_BAR, (volatile LAS unsigned*)(lds + MISC_OFF) + 8, phase_tid(wv));
#define RUN(k) (true)
#define SEAM() do { XcdBarrier b_ = bar; asm volatile("" : "+s"(b_.bar), "+s"(b_.x)); xcd_barrier(b_, phase_tid(wv)); } while (0)
#define LSEAM() do { asm volatile("s_waitcnt vmcnt(0)" ::: "memory"); __syncthreads(); __builtin_amdgcn_fence(__ATOMIC_ACQUIRE, "agent"); asm volatile("s_waitcnt vmcnt(0)" ::: "memory"); __syncthreads(); } while (0)
#else
    const int ph = args.ph;
#define RUN(k) (ph == (k))
#define SEAM() do { } while (0)
#define LSEAM() do { } while (0)
#endif
    _Pragma("unroll") for (int r_ = 0; r_ < NREP(12); ++r_) { if (RUN(0)) ph_prologue(ws, out, lds, wv);
    SEAM(); }
    unsigned long long tacc = 0ull, t0_ = 0ull;
    const unsigned long long ck0_ = (DBG_TIME == 99) ? (unsigned long long)__builtin_readcyclecounter() : 0ull, rt0_ = (DBG_TIME == 99) ? __builtin_amdgcn_s_memrealtime() : 0ull;
#define TS0(k) do { if (DBG_TIME == (k)) t0_ = __builtin_amdgcn_s_memrealtime(); } while (0)
#define TS1(k) do { if (DBG_TIME == (k)) tacc += __builtin_amdgcn_s_memrealtime() - t0_; } while (0)
#pragma unroll 1
    for (int l = 0; l < DEPTH; ++l) {
        const int pb = 1 + l * NPH; const bool moe = (l & 1) != 0; const int mi = l >> 1;
        for (int xb_ = 0; xb_ < BAR_PROBE; ++xb_) SEAM();
        _Pragma("unroll") for (int r_ = 0; r_ < NREP(0); ++r_) { if (RUN(pb + 0)) ph_inproj(ws, out, lds, wv, l);
        SEAM(); }
#if DBG_CHECK == 2
        if (l == 0) dbg_entry(ws, out, lds, wv, INP(0), INP(3));
#endif
        TS0(1); _Pragma("unroll") for (int r_ = 0; r_ < NREP(1); ++r_) { if (RUN(pb + 1)) ph_thin(ws, out, lds, wv, l);
        SEAM(); } TS1(1);
#if DBG_CHECK == 3
        if (l == 0) { Frame F = make_frame(ws, out, lds, wv); dbg_conv(F); }
#endif
        _Pragma("unroll") for (int r_ = 0; r_ < NREP(2); ++r_) { if (RUN(pb + 2)) ph_attn(ws, out, lds, wv);
        if (r_ + 1 < NREP(2) || DBG_CHECK == 1) SEAM(); }
#if DBG_CHECK == 1
        if (l == 0) dbg_entry(ws, out, lds, wv, INP(2), nullptr);
#endif
        _Pragma("unroll") for (int r_ = 0; r_ < NREP(3); ++r_) { if (RUN(pb + 3)) ph_mixc(ws, out, lds, wv, l);
        SEAM();
        if (RUN(pb + 4)) ph_mixa(ws, out, lds, wv, l);
        SEAM(); }
#if DBG_CHECK == 4
        if (l == 0) { Frame F = make_frame(ws, out, lds, wv); dbg_mix(F); }
#endif
        _Pragma("unroll") for (int r_ = 0; r_ < NREP(5); ++r_) { if (RUN(pb + 5)) ph_outproj(ws, out, lds, wv, l);
        SEAM(); }
#if DBG_CHECK == 5
        if (l == 0) { Frame F = make_frame(ws, out, lds, wv); dbg_out(F); }
        SEAM();
#endif
        _Pragma("unroll") for (int r_ = 0; r_ < NREP(6); ++r_) { if (RUN(pb + 6)) ph_ln1(ws, out, lds, wv, l, r_ + 1 < NREP(6));
        SEAM(); }
        _Pragma("unroll") for (int r_ = 0; r_ < NREP(7); ++r_) {
        if (!moe) { if (RUN(pb + 7)) ph_plegate(ws, out, lds, wv, l, -1);
            LSEAM();
            if (RUN(pb + 8)) ph_pleproj(ws, out, lds, wv, l, -1);
            if (r_ + 1 < NREP(7)) SEAM(); }
        else { if (RUN(pb + 7)) ph_routebuild(ws, out, lds, wv, l);
            SEAM(); } }
        _Pragma("unroll") for (int r_ = 0; r_ < NREP(9); ++r_) { if (RUN(pb + 9)) { if (!moe) ph_ffn_up_dense(ws, out, lds, wv, mi); else ph_ffn_up_moe(ws, out, lds, wv, mi); }
        SEAM(); }
        _Pragma("unroll") for (int r_ = 0; r_ < NREP(10); ++r_) { if (RUN(pb + 10)) { if (!moe) ph_ffn_down_dense(ws, out, lds, wv, mi, r_ + 1 < NREP(10));
            else { const int rtail = __builtin_amdgcn_readfirstlane(ph_ffn_down_moe(ws, out, lds, wv, mi));
                ph_plegate(ws, out, lds, wv, l, rtail);
                LSEAM();
                ph_pleproj(ws, out, lds, wv, l, rtail); } }
        SEAM(); }
        _Pragma("unroll") for (int r_ = 0; r_ < NREP(11); ++r_) { if (RUN(pb + 11)) ph_ln2(ws, out, lds, wv, l, r_ + 1 < NREP(11));
        if (l + 1 < DEPTH || r_ + 1 < NREP(11)) SEAM(); }
    }
#if DBG_TIME >= 0
    if (DBG_TIME == 99) { const unsigned long long dc = (unsigned long long)__builtin_readcyclecounter() - ck0_, dr = __builtin_amdgcn_s_memrealtime() - rt0_; tacc = (unsigned long long)(rintf(10.f * ((float)dc / (float)dr) * 0.1f) * 1000.f); }
    { Frame F = make_frame(ws, out, lds, wv); if (F.bx == 0 && F.tid == 0) __hip_atomic_store((float*)(F.ctl + CW_DBG), (float)tacc * 0.01f, RLX_AGENT); }
    SEAM();
    { Frame F = make_frame(ws, out, lds, wv); const float t = __hip_atomic_load((float*)(F.ctl + CW_DBG), RLX_AGENT); const float c = sqrtf(t * 0.1f);
      for (size_t i = (size_t)F.vcu * NTHR + F.tid; i < (size_t)M * D; i += (size_t)F.G * NTHR) F.out[i] = c; }
#endif
#if DBG_CHECK
    SEAM();
    { Frame F = make_frame(ws, out, lds, wv); dbg_finish(F); }
#endif
#undef RUN
#undef SEAM
}

extern "C" void kernel_launch(void* const* d_in, const int* in_sizes, int n_in, void* d_out, int out_size, void* d_ws, size_t ws_size, hipStream_t stream) {
    static int grid = 0;
    if (grid == 0) {
        if (n_in != 24 || in_sizes[0] != M * D || out_size != M * D || ws_size < WS_END) { fprintf(stderr, "kernel_launch: unexpected problem shape / workspace (%d inputs, ws %zu < %zu)\n", n_in, ws_size, (size_t)WS_END); grid = -1; return; }
        int dev = 0, cus = 0, per_cu = 0;
        if (hipGetDevice(&dev) != hipSuccess || hipDeviceGetAttribute(&cus, hipDeviceAttributeMultiprocessorCount, dev) != hipSuccess) { grid = -1; return; }
        if (hipFuncSetAttribute((const void*)fwd_kernel, hipFuncAttributeMaxDynamicSharedMemorySize, LDS_BYTES) != hipSuccess) { fprintf(stderr, "kernel_launch: hipFuncSetAttribute failed\n"); grid = -1; return; }
        if (hipOccupancyMaxActiveBlocksPerMultiprocessor(&per_cu, (const void*)fwd_kernel, NTHR, LDS_BYTES) != hipSuccess || per_cu < 1) fprintf(stderr, "kernel_launch: occupancy query reports %d\n", per_cu);
        (void)hipGetLastError();
        grid = cus;
    }
    if (grid < 0) return;
    (void)hipMemsetAsync((char*)d_ws + WS_CTL, 0, CTL_ZERO_BYTES, stream);
    Args a{};
    for (int i = 0; i < 24; ++i) a.in[i] = (const float*)d_in[i];
    a.out = (float*)d_out; a.ws = (unsigned char*)d_ws; a.ph = 0; a.pad = 0;
#if MK_SINGLE
    hipLaunchKernelGGL(fwd_kernel, dim3(grid), dim3(NTHR), LDS_BYTES, stream, a);
#else
    for (int ph = 0; ph < N_PHASES; ++ph) { a.ph = ph; hipLaunchKernelGGL(fwd_kernel, dim3(grid), dim3(NTHR), LDS_BYTES, stream, a); }
#endif
}
```
